# Optimizing an MI355X kernel written in HIP

```python
import math
import jax, jax.numpy as jnp
from jax import lax
import numpy as np

D_MODEL = 1024
BATCH = 16
SEQ = 4096
DEPTH = 2

W_LRU = D_MODEL // 2
LRU_BLOCKS = 8
LRU_C = 8.0
CONV_K = 4

SSM_HEAD_DIM = 64
SSM_D_INNER = D_MODEL
SSM_HEADS = SSM_D_INNER // SSM_HEAD_DIM
SSM_GROUPS = 2
SSM_STATE = 128
SSM_CHUNK = 128
SSM_CONV_CH = SSM_D_INNER + 2 * SSM_GROUPS * SSM_STATE

ATTN_HEAD_DIM = 64
ATTN_Q_HEADS = (D_MODEL // 2) // ATTN_HEAD_DIM
ATTN_KV_HEADS = 2
WINDOW = 128
ATTN_BLOCK = WINDOW

MIX_WIDTH = W_LRU + SSM_D_INNER + ATTN_Q_HEADS * ATTN_HEAD_DIM

_SEG = (W_LRU, W_LRU,
        SSM_D_INNER, SSM_CONV_CH, SSM_HEADS,
        ATTN_Q_HEADS * ATTN_HEAD_DIM,
        ATTN_KV_HEADS * ATTN_HEAD_DIM,
        ATTN_KV_HEADS * ATTN_HEAD_DIM)
IN_COLS = sum(_SEG)
SPLIT_POINTS = tuple(int(v) for v in np.cumsum(_SEG)[:-1])

PEER_HEADS = 8
PEER_NKEYS = 128
PEER_EXPERTS = PEER_NKEYS * PEER_NKEYS
PEER_DKEY = 128
PEER_TOPK = 16
PEER_CHUNK = 128

DN_ALPHA = (2 * DEPTH) ** 0.25
DN_BETA = (8 * DEPTH) ** -0.25
LN_EPS = 1e-5

kernel_name = "hymba_style_rglru_ssd_swa_peer_deepnorm"


def layer_norm(x, g, b):
    xf = x.astype(jnp.float32)
    mu = jnp.mean(xf, axis=-1, keepdims=True)
    var = jnp.mean(jnp.square(xf - mu), axis=-1, keepdims=True)
    return ((xf - mu) * lax.rsqrt(var + LN_EPS) * g + b).astype(x.dtype)


def causal_dwconv(x, w, b):
    k = w.shape[0]
    s = x.shape[1]
    xp = jnp.pad(x, ((0, 0), (k - 1, 0), (0, 0)))
    out = b + w[0] * xp[:, 0:s]
    for i in range(1, k):
        out = out + w[i] * xp[:, i:i + s]
    return out


def rg_lru(x, w_a, b_a, w_x, b_x, lam):
    bsz, s, w = x.shape
    xb = x.reshape(bsz, s, LRU_BLOCKS, w // LRU_BLOCKS)
    r = jax.nn.sigmoid((jnp.einsum('bsnc,ncd->bsnd', xb, w_a).reshape(bsz, s, w) + b_a).astype(jnp.float32))
    i = jax.nn.sigmoid((jnp.einsum('bsnc,ncd->bsnd', xb, w_x).reshape(bsz, s, w) + b_x).astype(jnp.float32))
    log_a = -LRU_C * r * jax.nn.softplus(-lam.astype(jnp.float32))
    a = jnp.exp(log_a)
    u = jnp.sqrt(-jnp.expm1(2.0 * log_a)) * (i * x.astype(jnp.float32))

    def combine(left, right):
        a_l, h_l = left
        a_r, h_r = right
        return a_l * a_r, a_r * h_l + h_r

    _, h = lax.associative_scan(combine, (a, u), axis=1)
    return h.astype(x.dtype)


def ssd_scan(xh, dt, a, bmat, cmat):
    f32 = jnp.float32
    bsz, s, h, p = xh.shape
    g, n = bmat.shape[2], bmat.shape[3]
    hg = h // g
    nc, l = s // SSM_CHUNK, SSM_CHUNK
    x = (xh.astype(f32) * dt[..., None]).reshape(bsz, nc, l, g, hg, p)
    da = (dt * a).reshape(bsz, nc, l, g, hg).transpose(0, 3, 4, 1, 2)
    bc = bmat.astype(f32).reshape(bsz, nc, l, g, n)
    cc = cmat.astype(f32).reshape(bsz, nc, l, g, n)
    a_cs = jnp.cumsum(da, axis=-1)
    causal = jnp.tril(jnp.ones((l, l), dtype=bool))
    seg = a_cs[..., :, None] - a_cs[..., None, :]
    decay = jnp.exp(jnp.where(causal, seg, -jnp.inf))
    cb = jnp.einsum('bclgn,bcsgn->bgcls', cc, bc)
    y_diag = jnp.einsum('bghcls,bcsghp->bclghp', cb[:, :, None] * decay, x)
    decay_states = jnp.exp(a_cs[..., -1:] - a_cs).transpose(0, 3, 4, 1, 2)
    states = jnp.einsum('bclgn,bclghp->bcghpn', bc, x * decay_states[..., None])
    chunk_decay = jnp.exp(a_cs[..., -1])

    def step(carry, inp):
        st, dec = inp
        return carry * dec[..., None, None] + st, carry

    init = jnp.zeros((bsz, g, hg, p, n), f32)
    _, prev = lax.scan(step, init, (jnp.moveaxis(states, 1, 0), jnp.moveaxis(chunk_decay, 3, 0)))
    prev = jnp.moveaxis(prev, 0, 1)
    out_decay = jnp.exp(a_cs).transpose(0, 3, 4, 1, 2)
    y_off = jnp.einsum('bclgn,bcghpn->bclghp', cc, prev) * out_decay[..., None]
    return (y_diag + y_off).reshape(bsz, s, h, p)


def mamba2_group(z, xbc, dt_raw, conv_w, conv_b, dt_bias, a_log, d_skip, norm_g):
    f32 = jnp.float32
    bsz, s, _ = z.shape
    xbc = jax.nn.silu(causal_dwconv(xbc, conv_w, conv_b))
    xs, bm, cm = jnp.split(xbc, [SSM_D_INNER, SSM_D_INNER + SSM_GROUPS * SSM_STATE], axis=-1)
    dt = jax.nn.softplus(dt_raw.astype(f32) + dt_bias.astype(f32))
    a = -jnp.exp(a_log.astype(f32))
    xh = xs.reshape(bsz, s, SSM_HEADS, SSM_HEAD_DIM)
    y = ssd_scan(xh, dt, a,
                 bm.reshape(bsz, s, SSM_GROUPS, SSM_STATE),
                 cm.reshape(bsz, s, SSM_GROUPS, SSM_STATE))
    y = y + d_skip.astype(f32)[:, None] * xh.astype(f32)
    y = y.reshape(bsz, s, SSM_D_INNER) * jax.nn.silu(z.astype(f32))
    yg = y.reshape(bsz, s, SSM_GROUPS, SSM_D_INNER // SSM_GROUPS)
    yg = yg * lax.rsqrt(jnp.mean(jnp.square(yg), axis=-1, keepdims=True) + LN_EPS)
    return (yg.reshape(bsz, s, SSM_D_INNER) * norm_g).astype(z.dtype)


def sliding_window_attention(q, k, v, sinks):
    f32 = jnp.float32
    bsz, s, _ = q.shape
    nb = s // ATTN_BLOCK
    rep = ATTN_Q_HEADS // ATTN_KV_HEADS
    qb = q.reshape(bsz, nb, ATTN_BLOCK, ATTN_KV_HEADS, rep, ATTN_HEAD_DIM)
    kb = k.reshape(bsz, nb, ATTN_BLOCK, ATTN_KV_HEADS, ATTN_HEAD_DIM)
    vb = v.reshape(bsz, nb, ATTN_BLOCK, ATTN_KV_HEADS, ATTN_HEAD_DIM)

    def with_prev(t):
        prev = jnp.pad(t, ((0, 0), (1, 0), (0, 0), (0, 0), (0, 0)))[:, :-1]
        return jnp.concatenate([prev, t], axis=2)

    kk, vv = with_prev(kb), with_prev(vb)
    logits = jnp.einsum('bnqhrd,bnkhd->bnhrqk', qb, kk).astype(f32) * (ATTN_HEAD_DIM ** -0.5)
    qi = jnp.arange(ATTN_BLOCK)[:, None]
    kj = jnp.arange(2 * ATTN_BLOCK)[None, :]
    rel = qi + ATTN_BLOCK - kj
    band = (rel >= 0) & (rel < WINDOW)
    blk = jnp.arange(nb)[:, None, None]
    valid = band[None] & ((blk > 0) | (kj[None] >= ATTN_BLOCK))
    logits = jnp.where(valid[None, :, None, None], logits, -jnp.inf)
    sink = sinks.astype(f32).reshape(ATTN_KV_HEADS, rep)[None, None, :, :, None, None]
    m = jnp.maximum(jnp.max(logits, axis=-1, keepdims=True), sink)
    p = jnp.exp(logits - m)
    probs = p / (jnp.sum(p, axis=-1, keepdims=True) + jnp.exp(sink - m))
    out = jnp.einsum('bnhrqk,bnkhd->bnqhrd', probs.astype(v.dtype), vv)
    return out.reshape(bsz, s, ATTN_Q_HEADS * ATTN_HEAD_DIM)


def peer_ffn(x, wq, keys, u, v):
    bsz, s, d = x.shape
    xt = x.reshape(-1, PEER_CHUNK, d)
    half = PEER_DKEY // 2

    def chunk(xc):
        c = xc.shape[0]
        q = (xc @ wq).reshape(c, PEER_HEADS, 2, half)
        sc = jnp.einsum('thid,ikd->thik', q, keys).astype(jnp.float32)
        top_s, top_i = lax.top_k(sc, PEER_TOPK)
        cand_s = top_s[:, :, 0, :, None] + top_s[:, :, 1, None, :]
        cand_i = top_i[:, :, 0, :, None] * PEER_NKEYS + top_i[:, :, 1, None, :]
        best_s, best_pos = lax.top_k(cand_s.reshape(c, PEER_HEADS, -1), PEER_TOPK)
        idx = jnp.take_along_axis(cand_i.reshape(c, PEER_HEADS, -1), best_pos, axis=-1)
        gate = jax.nn.softmax(best_s, axis=-1)
        ue = u[idx]
        ve = v[idx]
        act = jax.nn.gelu(jnp.einsum('td,thkd->thk', xc, ue).astype(jnp.float32), approximate=False)
        return jnp.einsum('thk,thkd->td', (gate * act).astype(xc.dtype), ve)

    return lax.map(chunk, xt).reshape(bsz, s, d)


def setup_inputs(seed: int = 0) -> dict:
    key = jax.random.key(seed)
    ks = jax.random.split(key, 32)
    f32 = jnp.float32

    def nrm(k, shape, scale):
        return jax.random.normal(k, shape, f32) * scale

    bw = W_LRU // LRU_BLOCKS
    a0 = jax.random.uniform(ks[10], (DEPTH, W_LRU), f32, 0.9, 0.999)
    a_base = a0 ** (1.0 / LRU_C)
    dt0 = jnp.exp(jax.random.uniform(ks[13], (DEPTH, SSM_HEADS), f32, math.log(1e-3), math.log(1e-1)))
    return {
        "x": nrm(ks[0], (BATCH, SEQ, D_MODEL), 1.0),
        "emb_ln_g": 1.0 + nrm(ks[1], (D_MODEL,), 0.02),
        "emb_ln_b": nrm(ks[2], (D_MODEL,), 0.02),
        "w_in": nrm(ks[3], (DEPTH, D_MODEL, IN_COLS), D_MODEL ** -0.5),
        "rg_conv_w": nrm(ks[4], (DEPTH, CONV_K, W_LRU), CONV_K ** -0.5),
        "rg_conv_b": nrm(ks[5], (DEPTH, W_LRU), 0.02),
        "rg_wa": nrm(ks[6], (DEPTH, LRU_BLOCKS, bw, bw), bw ** -0.5),
        "rg_ba": nrm(ks[7], (DEPTH, W_LRU), 0.02),
        "rg_wx": nrm(ks[8], (DEPTH, LRU_BLOCKS, bw, bw), bw ** -0.5),
        "rg_bx": nrm(ks[9], (DEPTH, W_LRU), 0.02),
        "rg_lambda": jnp.log(a_base) - jnp.log1p(-a_base),
        "ssm_conv_w": nrm(ks[11], (DEPTH, CONV_K, SSM_CONV_CH), CONV_K ** -0.5),
        "ssm_conv_b": nrm(ks[12], (DEPTH, SSM_CONV_CH), 0.02),
        "ssm_dt_bias": dt0 + jnp.log(-jnp.expm1(-dt0)),
        "ssm_a_log": jnp.log(jax.random.uniform(ks[14], (DEPTH, SSM_HEADS), f32, 1.0, 16.0)),
        "ssm_d": 1.0 + nrm(ks[15], (DEPTH, SSM_HEADS), 0.02),
        "ssm_norm_g": 1.0 + nrm(ks[16], (DEPTH, SSM_D_INNER), 0.02),
        "attn_sinks": nrm(ks[17], (DEPTH, ATTN_Q_HEADS), 1.0),
        "w_out": nrm(ks[18], (DEPTH, MIX_WIDTH, D_MODEL), DN_BETA * MIX_WIDTH ** -0.5),
        "ln1_g": 1.0 + nrm(ks[19], (DEPTH, D_MODEL), 0.02),
        "ln1_b": nrm(ks[20], (DEPTH, D_MODEL), 0.02),
        "peer_wq": nrm(ks[21], (DEPTH, D_MODEL, PEER_HEADS * PEER_DKEY), D_MODEL ** -0.5),
        "peer_keys": nrm(ks[22], (DEPTH, 2, PEER_NKEYS, PEER_DKEY // 2), (PEER_DKEY // 2) ** -0.5),
        "peer_u": nrm(ks[23], (DEPTH, PEER_EXPERTS, D_MODEL), D_MODEL ** -0.5),
        "peer_v": nrm(ks[24], (DEPTH, PEER_EXPERTS, D_MODEL), DN_BETA * PEER_HEADS ** -0.5),
        "ln2_g": 1.0 + nrm(ks[25], (DEPTH, D_MODEL), 0.02),
        "ln2_b": nrm(ks[26], (DEPTH, D_MODEL), 0.02),
    }


def reference(x, emb_ln_g, emb_ln_b, w_in, rg_conv_w, rg_conv_b, rg_wa, rg_ba, rg_wx, rg_bx,
              rg_lambda, ssm_conv_w, ssm_conv_b, ssm_dt_bias, ssm_a_log, ssm_d, ssm_norm_g,
              attn_sinks, w_out, ln1_g, ln1_b, peer_wq, peer_keys, peer_u, peer_v, ln2_g, ln2_b):
    h = layer_norm(x, emb_ln_g, emb_ln_b)
    for l in range(DEPTH):
        proj = h @ w_in[l]
        rg_x, rg_gate, z, xbc, dt_raw, q, k, v = jnp.split(proj, SPLIT_POINTS, axis=-1)
        y_a = jax.nn.gelu(rg_gate) * rg_lru(causal_dwconv(rg_x, rg_conv_w[l], rg_conv_b[l]),
                                            rg_wa[l], rg_ba[l], rg_wx[l], rg_bx[l], rg_lambda[l])
        y_b = mamba2_group(z, xbc, dt_raw, ssm_conv_w[l], ssm_conv_b[l], ssm_dt_bias[l],
                           ssm_a_log[l], ssm_d[l], ssm_norm_g[l])
        y_c = sliding_window_attention(q, k, v, attn_sinks[l])
        mix = jnp.concatenate([y_a.astype(h.dtype), y_b, y_c.astype(h.dtype)], axis=-1) @ w_out[l]
        h = layer_norm(DN_ALPHA * h + mix, ln1_g[l], ln1_b[l])
        ffn = peer_ffn(h, peer_wq[l], peer_keys[l], peer_u[l], peer_v[l])
        h = layer_norm(DN_ALPHA * h + ffn, ln2_g[l], ln2_b[l])
    return h
```

```cpp
#include <hip/hip_runtime.h>
#include <hip/hip_cooperative_groups.h>
#include <cstdio>
#include <cstdint>
namespace cg = cooperative_groups;
#ifndef PH_HI
#define PH_HI N_PHASES
#endif
#ifndef MIX_MASK
#define MIX_MASK 7
#endif

#define LAS __attribute__((address_space(3)))
typedef unsigned short bf16_t;
typedef short bf16x8 __attribute__((ext_vector_type(8)));
typedef float f32x4 __attribute__((ext_vector_type(4)));
typedef float f32x2 __attribute__((ext_vector_type(2)));
typedef unsigned u32x4 __attribute__((ext_vector_type(4)));
typedef unsigned u32x2 __attribute__((ext_vector_type(2)));
using bf16x2v = __attribute__((ext_vector_type(2))) __bf16;

constexpr int T_TOK = 65536, DM = 1024, SEQ = 4096, NBATCH = 16, DEPTH = 2;
constexpr int PROJ_LD = 4368;
constexpr int C_RGX = 0, C_GATE = 512, C_Z = 1024, C_XBC = 2048, C_DT = 3584, C_Q = 3600, C_K = 4112, C_V = 4240;
constexpr int N_IN = 4352;
constexpr int MIXW = 2048;
constexpr float DN_ALPHA = 1.41421356237f;
constexpr float LN_EPS = 1e-5f;
constexpr int NTHREADS = 512;
constexpr int LDS_BYTES = 147456;

constexpr size_t WS_CTL  = 0;
constexpr size_t WS_WIN  = 65536;
constexpr size_t WS_WDT  = WS_WIN  + (size_t)2 * N_IN * 1024 * 2;
constexpr size_t WS_WOUT = WS_WDT  + (size_t)2 * 16 * 1024 * 2;
constexpr size_t WS_WQ   = WS_WOUT + (size_t)2 * 1024 * 2048 * 2;
constexpr size_t WS_KEYS = WS_WQ   + (size_t)2 * 1024 * 1024 * 2;
constexpr size_t WS_WA   = WS_KEYS + (size_t)2 * 2 * 128 * 64 * 2;
constexpr size_t WS_WX   = WS_WA   + (size_t)2 * 8 * 64 * 64 * 2;
constexpr size_t WS_U    = WS_WX   + (size_t)2 * 8 * 64 * 64 * 2;
constexpr size_t WS_V    = WS_U    + (size_t)2 * 16384 * 1024 * 2;
constexpr size_t WS_HB   = WS_V    + (size_t)2 * 16384 * 1024 * 2;
constexpr size_t WS_DT   = WS_HB   + (size_t)T_TOK * 1024 * 2;
constexpr size_t WS_SSQ  = WS_DT   + (size_t)T_TOK * 16 * 4;
constexpr size_t WS_PROJ = WS_SSQ  + (size_t)T_TOK * 16 * 4;
constexpr size_t WS_END  = WS_PROJ + (size_t)T_TOK * PROJ_LD * 2;
constexpr size_t WS_QP   = WS_PROJ;
constexpr size_t WS_IDX  = WS_QP  + (size_t)T_TOK * 1024 * 2;
constexpr size_t WS_GATE = WS_IDX + (size_t)T_TOK * 128 * 4;

struct Params {
    const float* x; const float* emb_g; const float* emb_b; const float* w_in; const float* rg_conv_w; const float* rg_conv_b;
    const float* rg_wa; const float* rg_ba; const float* rg_wx; const float* rg_bx; const float* rg_lambda;
    const float* ssm_conv_w; const float* ssm_conv_b; const float* ssm_dt_bias; const float* ssm_a_log; const float* ssm_d; const float* ssm_norm_g;
    const float* attn_sinks; const float* w_out; const float* ln1_g; const float* ln1_b;
    const float* peer_wq; const float* peer_keys; const float* peer_u; const float* peer_v; const float* ln2_g; const float* ln2_b;
    float* out; unsigned char* ws; int ph_lo, ph_hi;
};

typedef __bf16 bf16x2n __attribute__((ext_vector_type(2)));
__device__ __forceinline__ unsigned cvt_pk_bf16(float lo, float hi) { const f32x2 v = {lo, hi}; const bf16x2n r = __builtin_convertvector(v, bf16x2n); return __builtin_bit_cast(unsigned, r); }
__device__ __forceinline__ bf16_t f2bf(float f) { return (bf16_t)(cvt_pk_bf16(f, 0.f) & 0xffffu); }
__device__ __forceinline__ float bf2f(bf16_t b) { return __uint_as_float(((unsigned)b) << 16); }
__device__ __forceinline__ float bflo(unsigned w) { return __uint_as_float(w << 16); }
__device__ __forceinline__ float bfhi(unsigned w) { return __uint_as_float(w & 0xffff0000u); }
__device__ __forceinline__ float sigmoidf_(float x) { return 1.f / (1.f + __expf(-x)); }
__device__ __forceinline__ float siluf_(float x) { return x / (1.f + __expf(-x)); }
__device__ __forceinline__ float softplusf_(float x) { return x > 20.f ? x : log1pf(__expf(x)); }
__device__ __forceinline__ float gelu_tanhf_(float x) { const float u = 0.7978845608028654f * (x + 0.044715f * x * x * x); const float t = 1.f - 2.f / (__expf(2.f * u) + 1.f); return 0.5f * x * (1.f + t); }
__device__ __forceinline__ float gelu_erff_(float x) { return 0.5f * x * (1.f + erff(x * 0.70710678118654752f)); }
__device__ __forceinline__ float wave_sum(float v) {
#pragma unroll
    for (int o = 32; o > 0; o >>= 1) v += __shfl_xor(v, o);
    return v;
}
__device__ __forceinline__ float dot2bf(unsigned a, unsigned b, float acc) { return __builtin_amdgcn_fdot2_f32_bf16(__builtin_bit_cast(bf16x2v, a), __builtin_bit_cast(bf16x2v, b), acc, false); }
__device__ __forceinline__ unsigned umax_(unsigned a, unsigned b) { return a > b ? a : b; }
__device__ __forceinline__ unsigned umin_(unsigned a, unsigned b) { return a < b ? a : b; }
__device__ __forceinline__ int otid() { int t = (int)threadIdx.x; asm volatile("" : "+v"(t)); return t; }
__device__ __forceinline__ int obid() { int b = (int)blockIdx.x; asm volatile("" : "+s"(b)); return b; }
#define MFMA16(a, b, c) __builtin_amdgcn_mfma_f32_16x16x32_bf16((a), (b), (c), 0, 0, 0)

namespace pg8 {
constexpr int BM = 256, BK = 64, HALF = 128, HTB = HALF * BK * 2, STAGE_BYTES = 8 * HTB, NXCD = 8, WGM = 8;
__device__ __forceinline__ int lds_byte(int r, int c) { const int st = (r >> 4) * 2 + (c >> 5), rr = r & 15, cc = c & 31, ob = rr * 64 + cc * 2; return st * 1024 + (ob ^ (((ob >> 9) & 1) << 5)); }
__device__ __forceinline__ void stage_rc(int b, int& R, int& C) { const int st = b / 1024, sb = b % 1024, swz = sb ^ (((sb >> 9) & 1) << 5); R = (st >> 1) * 16 + swz / 64; C = (st & 1) * 32 + (swz % 64) / 2; }
__device__ __forceinline__ int perm32(int rho) { const int n = rho >> 4, i = rho & 15; return 8 * (i >> 2) + 4 * n + (i & 3); }
struct Unit { int pm, pn; };
struct Gemm { const bf16_t* A; const bf16_t* Bt; int M, N, K, lda, ksplit, kextra; };
struct StaticOrder {
    int nM, nN, nwg, G, c;
    __device__ void init(int M, int N, int G_, int c_) { nM = M / BM; nN = N / BM; nwg = nM * nN; G = G_; c = c_; }
    __device__ bool next(int i, Unit& u) const {
        const long L = (long)i * G + c; if (L >= nwg) return false;
        int wgid = (int)L; { const int q = nwg / NXCD, r = nwg % NXCD, xcd = wgid % NXCD, off = wgid / NXCD; wgid = (xcd < r ? xcd * (q + 1) : r * (q + 1) + (xcd - r) * q) + off; }
        const int nig = WGM * nN, gid = wgid / nig, fm = gid * WGM, gsz = (nM - fm) < WGM ? (nM - fm) : WGM;
        u.pm = fm + ((wgid % nig) % gsz); u.pn = (wgid % nig) / gsz; return true;
    }
};
struct EpiBf16 {
    static constexpr bool PERM = true;
    bf16_t* O; int ldc; int split_cols; size_t split_stride;
    __device__ __forceinline__ void operator()(const f32x4 (&acc)[2][2][4][2], const Unit& u, int wr, int wc, int fr, int fq) const {
        const int row0 = u.pm * BM + wr * 64 + fr; int colt = u.pn * BM; bf16_t* base = O;
        if (split_cols) { const int t = colt / split_cols; base += (size_t)t * split_stride; colt -= t * split_cols; }
        const int col0 = colt + wc * 32 + 8 * fq;
#pragma unroll
        for (int ai = 0; ai < 2; ++ai)
#pragma unroll
            for (int m = 0; m < 4; ++m) { bf16_t* rowp = base + (size_t)(row0 + ai * HALF + m * 16) * ldc + col0;
#pragma unroll
                for (int bj = 0; bj < 2; ++bj) { const f32x4 v0 = acc[ai][bj][m][0], v1 = acc[ai][bj][m][1];
                    u32x4 w; w.x = cvt_pk_bf16(v0[0], v0[1]); w.y = cvt_pk_bf16(v0[2], v0[3]); w.z = cvt_pk_bf16(v1[0], v1[1]); w.w = cvt_pk_bf16(v1[2], v1[3]);
                    *(u32x4*)(rowp + bj * HALF) = w; } }
    }
};
struct EpiResF32 {
    static constexpr bool PERM = false;
    float* C; int ldc; float alpha;
    __device__ __forceinline__ void operator()(const f32x4 (&acc)[2][2][4][2], const Unit& u, int wr, int wc, int fr, int fq) const {
        const int row0 = u.pm * BM + wr * 64 + fr, col0 = u.pn * BM + wc * 32 + 4 * fq;
#pragma unroll
        for (int ai = 0; ai < 2; ++ai)
#pragma unroll
            for (int m = 0; m < 4; ++m) { float* rowp = C + (size_t)(row0 + ai * HALF + m * 16) * ldc + col0;
#pragma unroll
                for (int bj = 0; bj < 2; ++bj)
#pragma unroll
                    for (int n = 0; n < 2; ++n) { f32x4* p = (f32x4*)(rowp + bj * HALF + n * 16); const f32x4 h = *p; *p = h * alpha + acc[ai][bj][m][n]; } }
    }
};

struct Epi {
    int mode; EpiBf16 eb; EpiResF32 er;
};
__device__ __forceinline__ void gemm_phase(LAS unsigned char* lds, const Gemm g, const StaticOrder& S, const Epi& E) {
    const int tid = otid(), wid = __builtin_amdgcn_readfirstlane(tid >> 6), lane = tid & 63, wr = wid >> 2, wc = wid & 3, fr = lane & 15, fq = lane >> 4;
    const int K = g.K, nt = K / BK, lda = g.lda;
    unsigned voffA[2], voffB[2];
#pragma unroll
    for (int i = 0; i < 2; ++i) { int R, C; stage_rc(tid * 16 + i * 8192, R, C); const int Rb = (E.mode == 0) ? ((R & ~31) + perm32(R & 31)) : R;
        voffA[i] = (unsigned)(R * lda + C) * 2u; voffB[i] = (unsigned)(Rb * K + C) * 2u; }
    const size_t kstep = (size_t)(BK * 2);
    const size_t hstepA = (size_t)HALF * lda * 2, hstepB = (size_t)HALF * K * 2;
    const size_t tstepA = 2 * hstepA, tstepB = 2 * hstepB;
    const int ksplit = g.ksplit; const size_t kextra = (size_t)g.kextra;
#define PG8_AKOFF(t) ((size_t)(t) * kstep + (((t) >= ksplit) ? kextra : (size_t)0))
    const unsigned ldsw = (unsigned)wid * 1024u;
    const int aoff = lds_byte(wr * 64 + fr, fq * 8), boff = lds_byte(wc * 32 + fr, fq * 8);
#define PG8_SA(b, h) (((b) * 2 + (h)) * HTB)
#define PG8_SB(b, h) ((4 + (b) * 2 + (h)) * HTB)
#define PG8_STAGE(bufoff, gbase, voff) do { _Pragma("unroll") for (int _i = 0; _i < 2; ++_i) \
        __builtin_amdgcn_global_load_lds((const unsigned*)((const char*)(gbase) + (voff)[_i]), (LAS unsigned*)(lds + (bufoff) + ldsw + _i * 8192), 16, 0, 0); } while (0)
#define PG8_LDA(dst, b, h) do { _Pragma("unroll") for (int m = 0; m < 4; ++m) _Pragma("unroll") for (int k = 0; k < 2; ++k) dst[m][k] = *(const LAS bf16x8*)(lds + PG8_SA(b, h) + aoff + m * 2048 + k * 1024); } while (0)
#define PG8_LDB(dst, b, h) do { _Pragma("unroll") for (int n = 0; n < 2; ++n) _Pragma("unroll") for (int k = 0; k < 2; ++k) dst[n][k] = *(const LAS bf16x8*)(lds + PG8_SB(b, h) + boff + n * 2048 + k * 1024); } while (0)
#define PG8_MMA(ai, bj, At, Bt) do { __builtin_amdgcn_s_setprio(1); _Pragma("unroll") for (int m = 0; m < 4; ++m) _Pragma("unroll") for (int n = 0; n < 2; ++n) _Pragma("unroll") for (int k = 0; k < 2; ++k) \
        acc[ai][bj][m][n] = __builtin_amdgcn_mfma_f32_16x16x32_bf16(Bt[n][k], At[m][k], acc[ai][bj][m][n], 0, 0, 0); __builtin_amdgcn_s_setprio(0); } while (0)
#define PG8_WAIT_V(n) asm volatile("s_waitcnt vmcnt(" #n ")" ::: "memory")
#define PG8_WAIT_L(n) asm volatile("s_waitcnt lgkmcnt(" #n ")" ::: "memory")
#define PG8_BAR __builtin_amdgcn_s_barrier()
#define PG8_SCHED __builtin_amdgcn_sched_barrier(0)
    Unit cur, nxt; int ui = 0;
    if (!S.next(0, cur)) return;
    f32x4 acc[2][2][4][2];
#pragma unroll
    for (int a = 0; a < 2; ++a)
#pragma unroll
        for (int b = 0; b < 2; ++b)
#pragma unroll
            for (int m = 0; m < 4; ++m)
#pragma unroll
                for (int n = 0; n < 2; ++n) acc[a][b][m][n] = (f32x4){0.f, 0.f, 0.f, 0.f};
    bf16x8 At[4][2], B0[2][2], B1[2][2];
    const char* cA = (const char*)g.A + (size_t)cur.pm * tstepA; const char* cB = (const char*)g.Bt + (size_t)cur.pn * tstepB;
    PG8_STAGE(PG8_SB(0, 0), cB, voffB); PG8_STAGE(PG8_SA(0, 0), cA, voffA); PG8_STAGE(PG8_SB(0, 1), cB + hstepB, voffB); PG8_STAGE(PG8_SA(0, 1), cA + hstepA, voffA);
    if (wr == 1) PG8_BAR;
    PG8_WAIT_V(4); PG8_BAR;
    PG8_STAGE(PG8_SB(1, 0), cB + kstep, voffB); PG8_STAGE(PG8_SA(1, 0), cA + PG8_AKOFF(1), voffA); PG8_STAGE(PG8_SB(1, 1), cB + hstepB + kstep, voffB);
    PG8_WAIT_V(6); PG8_BAR;
    for (;;) {
        const bool has_next = S.next(ui + 1, nxt);
        const char* nA = has_next ? (const char*)g.A + (size_t)nxt.pm * tstepA : cA; const char* nB = has_next ? (const char*)g.Bt + (size_t)nxt.pn * tstepB : cB;
        for (int t = 0; t < nt; t += 2) {
            const bool last = (t == nt - 2);
            const char* a1 = cA + PG8_AKOFF(t + 1);
            const char* a2 = last ? nA : cA + PG8_AKOFF(t + 2); const char* b2 = last ? nB : cB + (size_t)(t + 2) * kstep;
            const char* a3 = last ? nA + PG8_AKOFF(1) : cA + PG8_AKOFF(t + 3); const char* b3 = b2 + kstep;
            PG8_LDB(B0, 0, 0); PG8_SCHED; PG8_LDA(At, 0, 0); PG8_STAGE(PG8_SA(1, 1), a1 + hstepA, voffA);
            PG8_WAIT_L(8); PG8_BAR; PG8_WAIT_L(0); PG8_MMA(0, 0, At, B0); PG8_BAR; PG8_SCHED;
            PG8_LDB(B1, 0, 1); PG8_STAGE(PG8_SB(0, 0), b2, voffB);
            PG8_BAR; PG8_WAIT_L(0); PG8_MMA(0, 1, At, B1); PG8_BAR;
            PG8_LDA(At, 0, 1); PG8_STAGE(PG8_SA(0, 0), a2, voffA);
            PG8_BAR; PG8_WAIT_L(0); PG8_MMA(1, 0, At, B0); PG8_BAR; PG8_SCHED;
            PG8_STAGE(PG8_SB(0, 1), b2 + hstepB, voffB);
            PG8_WAIT_V(6); PG8_BAR; PG8_MMA(1, 1, At, B1); PG8_BAR;
            PG8_LDB(B0, 1, 0); PG8_SCHED; PG8_LDA(At, 1, 0); PG8_STAGE(PG8_SA(0, 1), a2 + hstepA, voffA);
            PG8_WAIT_L(8); PG8_BAR; PG8_WAIT_L(0); PG8_MMA(0, 0, At, B0); PG8_BAR; PG8_SCHED;
            PG8_LDB(B1, 1, 1); PG8_STAGE(PG8_SB(1, 0), b3, voffB);
            PG8_BAR; PG8_WAIT_L(0); PG8_MMA(0, 1, At, B1); PG8_BAR;
            PG8_LDA(At, 1, 1); PG8_STAGE(PG8_SA(1, 0), a3, voffA);
            PG8_BAR; PG8_WAIT_L(0); PG8_MMA(1, 0, At, B0); PG8_BAR; PG8_SCHED;
            PG8_STAGE(PG8_SB(1, 1), b3 + hstepB, voffB);
            PG8_WAIT_V(6); PG8_BAR; PG8_MMA(1, 1, At, B1); PG8_BAR;
        }
        if (E.mode == 0) E.eb(acc, cur, wr, wc, fr, fq); else E.er(acc, cur, wr, wc, fr, fq);
        if (!has_next) break;
#pragma unroll
        for (int a = 0; a < 2; ++a)
#pragma unroll
            for (int b = 0; b < 2; ++b)
#pragma unroll
                for (int m = 0; m < 4; ++m)
#pragma unroll
                    for (int n = 0; n < 2; ++n) acc[a][b][m][n] = (f32x4){0.f, 0.f, 0.f, 0.f};
        cur = nxt; cA = nA; cB = nB; ++ui;
    }
    PG8_WAIT_V(0);
    if (wr == 0) PG8_BAR;
    PG8_BAR;
#undef PG8_AKOFF
#undef PG8_SA
#undef PG8_SB
#undef PG8_STAGE
#undef PG8_LDA
#undef PG8_LDB
#undef PG8_MMA
#undef PG8_WAIT_V
#undef PG8_WAIT_L
#undef PG8_BAR
#undef PG8_SCHED
}
}

__device__ __forceinline__ void tr_tile(LAS float* s, const float* src, int ld_src, int k0, int c0, bf16_t* dst, int ld_dst, int n0, const float* scale) {
    const int tid = otid();
    {
        const int r = tid >> 4, c4 = (tid & 15) * 4;
#pragma unroll
        for (int p = 0; p < 2; ++p) {
            const int rr = r + p * 32;
            f32x4 v = *(const f32x4*)(src + (size_t)(k0 + rr) * ld_src + c0 + c4);
            if (scale) { const float sc = scale[rr]; v = v * sc; }
            s[rr * 65 + c4 + 0] = v[0]; s[rr * 65 + c4 + 1] = v[1]; s[rr * 65 + c4 + 2] = v[2]; s[rr * 65 + c4 + 3] = v[3];
        }
    }
    __syncthreads();
    {
        const int n = tid >> 3, kq = (tid & 7) * 8;
        float v[8];
#pragma unroll
        for (int j = 0; j < 8; ++j) v[j] = s[(kq + j) * 65 + n];
        u32x4 w; w.x = cvt_pk_bf16(v[0], v[1]); w.y = cvt_pk_bf16(v[2], v[3]); w.z = cvt_pk_bf16(v[4], v[5]); w.w = cvt_pk_bf16(v[6], v[7]);
        *(u32x4*)(dst + (size_t)(n0 + n) * ld_dst + k0 + kq) = w;
    }
    __syncthreads();
}

__device__ __forceinline__ void convert_rows(const float* src, bf16_t* dst, size_t n_elems) {
    const size_t n8 = n_elems / 8;
    for (size_t i = (size_t)obid() * NTHREADS + otid(); i < n8; i += (size_t)gridDim.x * NTHREADS) {
        const f32x4 a = *(const f32x4*)(src + i * 8), b = *(const f32x4*)(src + i * 8 + 4);
        u32x4 w; w.x = cvt_pk_bf16(a[0], a[1]); w.y = cvt_pk_bf16(a[2], a[3]); w.z = cvt_pk_bf16(b[0], b[1]); w.w = cvt_pk_bf16(b[2], b[3]);
        *(u32x4*)(dst + i * 8) = w;
    }
}

__device__ __forceinline__ void ln_rows(const float* in, float* out, bf16_t* hb, const float* g, const float* bta) {
    const int lane = otid() & 63, wid = otid() >> 6;
    f32x4 gg[4], bb[4];
#pragma unroll
    for (int i = 0; i < 4; ++i) { gg[i] = ((const f32x4*)g)[lane + 64 * i]; bb[i] = ((const f32x4*)bta)[lane + 64 * i]; }
    for (int r = obid() * 8 + wid; r < T_TOK; r += gridDim.x * 8) {
        const f32x4* xr = (const f32x4*)(in + (size_t)r * DM);
        f32x4 v[4]; float s = 0.f;
#pragma unroll
        for (int i = 0; i < 4; ++i) { v[i] = xr[lane + 64 * i]; s += v[i][0] + v[i][1] + v[i][2] + v[i][3]; }
        s = wave_sum(s);
        const float mu = s * (1.f / DM);
        float q = 0.f;
#pragma unroll
        for (int i = 0; i < 4; ++i) { v[i] = v[i] - mu; q += v[i][0] * v[i][0] + v[i][1] * v[i][1] + v[i][2] * v[i][2] + v[i][3] * v[i][3]; }
        q = wave_sum(q);
        const float rs = rsqrtf(q * (1.f / DM) + LN_EPS);
        f32x4* orow = (f32x4*)(out + (size_t)r * DM);
        u32x2* hrow = (u32x2*)(hb + (size_t)r * DM);
#pragma unroll
        for (int i = 0; i < 4; ++i) {
            const f32x4 o = v[i] * rs * gg[i] + bb[i];
            orow[lane + 64 * i] = o;
            u32x2 w; w.x = cvt_pk_bf16(o[0], o[1]); w.y = cvt_pk_bf16(o[2], o[3]);
            hrow[lane + 64 * i] = w;
        }
    }
}

__device__ void phase_prep(const Params& P, LAS unsigned char* lds) {
    unsigned char* ws = P.ws;
    if (obid() == 0 && otid() < DEPTH) __hip_atomic_store((unsigned*)(ws + WS_CTL) + 64 * (1 + otid()), 0u, __ATOMIC_RELAXED, __HIP_MEMORY_SCOPE_AGENT);
    LAS float* s = (LAS float*)lds;
    const int n_win = 2 * 68 * 16, n_wout = 2 * 16 * 32, n_wq = 2 * 16 * 16, n_g = 2 * 8 * 2;
    const int total = n_win + n_wout + n_wq + n_g;
    for (int j = obid(); j < total; j += gridDim.x) {
        if (j < n_win) {
            const int l = j / (68 * 16), r = j % (68 * 16), nt = r / 16, kt = r % 16;
            const int n0 = nt * 64, c0 = n0 < 3584 ? n0 : n0 + 16;
            tr_tile(s, P.w_in + (size_t)l * 1024 * PROJ_LD, PROJ_LD, kt * 64, c0, (bf16_t*)(ws + WS_WIN) + (size_t)l * N_IN * 1024, 1024, n0, nullptr);
        } else if (j < n_win + n_wout) {
            const int jj = j - n_win, l = jj / (16 * 32), r = jj % (16 * 32), nt = r / 32, kt = r % 32;
            const int k0 = kt * 64;
            const float* sc = (k0 >= 512 && k0 < 1536) ? P.ssm_norm_g + l * 1024 + (k0 - 512) : nullptr;
            tr_tile(s, P.w_out + (size_t)l * MIXW * 1024, 1024, k0, nt * 64, (bf16_t*)(ws + WS_WOUT) + (size_t)l * 1024 * MIXW, MIXW, nt * 64, sc);
        } else if (j < n_win + n_wout + n_wq) {
            const int jj = j - n_win - n_wout, l = jj / 256, r = jj % 256, nt = r / 16, kt = r % 16;
            tr_tile(s, P.peer_wq + (size_t)l * 1024 * 1024, 1024, kt * 64, nt * 64, (bf16_t*)(ws + WS_WQ) + (size_t)l * 1024 * 1024, 1024, nt * 64, nullptr);
        } else {
            const int jj = j - n_win - n_wout - n_wq, which = jj / 16, lb = jj % 16;
            const float* src = (which ? P.rg_wx : P.rg_wa) + (size_t)lb * 4096;
            bf16_t* dst = (bf16_t*)(ws + (which ? WS_WX : WS_WA)) + (size_t)lb * 4096;
            tr_tile(s, src, 64, 0, 0, dst, 64, 0, nullptr);
        }
    }
    for (int i = obid() * NTHREADS + otid(); i < 2 * 16 * 1024; i += gridDim.x * NTHREADS) {
        const int l = i >> 14, j = (i >> 10) & 15, k = i & 1023;
        ((bf16_t*)(ws + WS_WDT))[i] = f2bf(P.w_in[((size_t)l * 1024 + k) * PROJ_LD + C_DT + j]);
    }
    convert_rows(P.peer_keys, (bf16_t*)(ws + WS_KEYS), (size_t)2 * 2 * 128 * 64);
    convert_rows(P.peer_u, (bf16_t*)(ws + WS_U), (size_t)2 * 16384 * 1024);
    convert_rows(P.peer_v, (bf16_t*)(ws + WS_V), (size_t)2 * 16384 * 1024);
    ln_rows(P.x, P.out, (bf16_t*)(ws + WS_HB), P.emb_g, P.emb_b);
}

__device__ void phase_dt(const Params& P, int layer) {
    const int lane = otid() & 63, wid = otid() >> 6;
    const bf16_t* hb = (const bf16_t*)(P.ws + WS_HB);
    const bf16_t* wdt = (const bf16_t*)(P.ws + WS_WDT) + (size_t)layer * 16 * 1024;
    float* DT = (float*)(P.ws + WS_DT);
    const float bias = P.ssm_dt_bias[layer * 16 + (lane & 15)];
    for (int task = obid() * 8 + wid; task < T_TOK / 16; task += gridDim.x * 8) {
        const int t0 = task * 16;
        f32x4 acc = {0.f, 0.f, 0.f, 0.f};
        const bf16_t* ap = hb + (size_t)(t0 + (lane & 15)) * DM + (lane >> 4) * 8;
        const bf16_t* bp = wdt + (size_t)(lane & 15) * DM + (lane >> 4) * 8;
#pragma unroll 8
        for (int ks = 0; ks < 32; ++ks) {
            const bf16x8 a = *(const bf16x8*)(ap + ks * 32), b = *(const bf16x8*)(bp + ks * 32);
            acc = MFMA16(a, b, acc);
        }
#pragma unroll
        for (int j = 0; j < 4; ++j) DT[(size_t)(t0 + (lane >> 4) * 4 + j) * 16 + (lane & 15)] = softplusf_(acc[j] + bias);
    }
}

__device__ void ssd_tile(const Params& P, int layer, int b, int h, LAS unsigned char* lds) {
    const int tid = otid(), lane = tid & 63, wid = tid >> 6, fr = lane & 15, fq = lane >> 4;
    bf16_t* proj = (bf16_t*)(P.ws + WS_PROJ);
    const float* DT = (const float*)(P.ws + WS_DT);
    float* SSQ = (float*)(P.ws + WS_SSQ);
    const int g = h >> 3;
    LAS bf16_t* sC = (LAS bf16_t*)lds;
    LAS bf16_t* sB = sC + 64 * 136;
    LAS bf16_t* sS = sB + 64 * 136;
    LAS bf16_t* sXH = sS + 64 * 136;
    LAS bf16_t* sXS = sXH + 64 * 72;
    LAS bf16_t* sXD = sXS + 64 * 72;
    LAS bf16_t* sM = sXD + 64 * 72;
    LAS float* sY = (LAS float*)(sM + 64 * 72);
    LAS float* sAcs = sY + 64 * 68;
    LAS float* sDt = sAcs + 64;
    const float a_h = -__expf(P.ssm_a_log[layer * 16 + h]);
    const float d_h = P.ssm_d[layer * 16 + h];
    const int cg = tid % 40, lrow = tid / 40;
    const bool cv_active = tid < 480;
    int ch0;
    if (cg < 8) ch0 = h * 64 + cg * 8; else if (cg < 24) ch0 = 1024 + g * 128 + (cg - 8) * 8; else ch0 = 1280 + g * 128 + (cg - 24) * 8;
    float cw[4][8], cb[8];
#pragma unroll
    for (int j = 0; j < 8; ++j) {
        cb[j] = P.ssm_conv_b[layer * 1536 + ch0 + j];
#pragma unroll
        for (int i = 0; i < 4; ++i) cw[i][j] = P.ssm_conv_w[(layer * 4 + i) * 1536 + ch0 + j];
    }
    for (int i = tid; i < 64 * 136 / 2; i += NTHREADS) ((LAS unsigned*)sS)[i] = 0u;
    f32x4 accS[4];
#pragma unroll
    for (int q = 0; q < 4; ++q) accS[q] = (f32x4){0.f, 0.f, 0.f, 0.f};
    __syncthreads();
    for (int c = 0; c < 64; ++c) {
        const int t0 = b * SEQ + c * 64;
        if (wid == 0) {
            const float dt = DT[(size_t)(t0 + lane) * 16 + h];
            float v = dt * a_h;
#pragma unroll
            for (int o = 1; o < 64; o <<= 1) { const float n = __shfl_up(v, o); if (lane >= o) v += n; }
            sDt[lane] = dt; sAcs[lane] = v;
        }
        __syncthreads();
        if (cv_active) {
            const float acs_end = sAcs[63];
            for (int l = lrow; l < 64; l += 12) {
                float v[8];
#pragma unroll
                for (int j = 0; j < 8; ++j) v[j] = cb[j];
#pragma unroll
                for (int i = 0; i < 4; ++i) {
                    const int pos = c * 64 + l - 3 + i;
                    if (pos >= 0) {
                        const u32x4 w = *(const u32x4*)(proj + (size_t)(b * SEQ + pos) * PROJ_LD + C_XBC + ch0);
                        v[0] += cw[i][0] * bflo(w.x); v[1] += cw[i][1] * bfhi(w.x); v[2] += cw[i][2] * bflo(w.y); v[3] += cw[i][3] * bfhi(w.y);
                        v[4] += cw[i][4] * bflo(w.z); v[5] += cw[i][5] * bfhi(w.z); v[6] += cw[i][6] * bflo(w.w); v[7] += cw[i][7] * bfhi(w.w);
                    }
                }
#pragma unroll
                for (int j = 0; j < 8; ++j) v[j] = siluf_(v[j]);
                u32x4 o; o.x = cvt_pk_bf16(v[0], v[1]); o.y = cvt_pk_bf16(v[2], v[3]); o.z = cvt_pk_bf16(v[4], v[5]); o.w = cvt_pk_bf16(v[6], v[7]);
                if (cg < 8) {
                    *(LAS u32x4*)(sXH + l * 72 + cg * 8) = o;
                    const float dt = sDt[l], dd = dt * __expf(acs_end - sAcs[l]);
                    u32x4 o2; o2.x = cvt_pk_bf16(v[0] * dt, v[1] * dt); o2.y = cvt_pk_bf16(v[2] * dt, v[3] * dt); o2.z = cvt_pk_bf16(v[4] * dt, v[5] * dt); o2.w = cvt_pk_bf16(v[6] * dt, v[7] * dt);
                    *(LAS u32x4*)(sXS + l * 72 + cg * 8) = o2;
                    u32x4 o3; o3.x = cvt_pk_bf16(v[0] * dd, v[1] * dd); o3.y = cvt_pk_bf16(v[2] * dd, v[3] * dd); o3.z = cvt_pk_bf16(v[4] * dd, v[5] * dd); o3.w = cvt_pk_bf16(v[6] * dd, v[7] * dd);
                    *(LAS u32x4*)(sXD + l * 72 + cg * 8) = o3;
                } else if (cg < 24) {
                    *(LAS u32x4*)(sB + l * 136 + (cg - 8) * 8) = o;
                } else {
                    *(LAS u32x4*)(sC + l * 136 + (cg - 24) * 8) = o;
                }
            }
        }
        __syncthreads();
        const int lt = wid >> 1, ph = wid & 1;
        f32x4 accY[2];
        {
            bf16x8 aC[4];
#pragma unroll
            for (int ks = 0; ks < 4; ++ks) aC[ks] = *(const LAS bf16x8*)(sC + (lt * 16 + fr) * 136 + ks * 32 + fq * 8);
#pragma unroll
            for (int tt = 0; tt < 2; ++tt) {
                const int st = ph * 2 + tt;
                f32x4 accG = {0.f, 0.f, 0.f, 0.f};
#pragma unroll
                for (int ks = 0; ks < 4; ++ks) { const bf16x8 bb = *(const LAS bf16x8*)(sB + (st * 16 + fr) * 136 + ks * 32 + fq * 8); accG = MFMA16(aC[ks], bb, accG); }
                const int s_idx = st * 16 + fr; const float acs_s = sAcs[s_idx];
#pragma unroll
                for (int j = 0; j < 4; ++j) {
                    const int l = lt * 16 + fq * 4 + j;
                    const float val = (s_idx <= l) ? accG[j] * __expf(sAcs[l] - acs_s) : 0.f;
                    sM[l * 72 + s_idx] = f2bf(val);
                }
            }
#pragma unroll
            for (int tt = 0; tt < 2; ++tt) {
                const int pt = ph * 2 + tt;
                f32x4 a = {0.f, 0.f, 0.f, 0.f};
#pragma unroll
                for (int ks = 0; ks < 4; ++ks) { const bf16x8 bb = *(const LAS bf16x8*)(sS + (pt * 16 + fr) * 136 + ks * 32 + fq * 8); a = MFMA16(aC[ks], bb, a); }
#pragma unroll
                for (int j = 0; j < 4; ++j) a[j] *= __expf(sAcs[lt * 16 + fq * 4 + j]);
                accY[tt] = a;
            }
        }
        __syncthreads();
        {
#pragma unroll
            for (int tt = 0; tt < 2; ++tt) {
                const int pt = ph * 2 + tt;
#pragma unroll
                for (int ks = 0; ks < 2; ++ks) {
                    const bf16x8 am = *(const LAS bf16x8*)(sM + (lt * 16 + fr) * 72 + ks * 32 + fq * 8);
                    bf16x8 bx;
#pragma unroll
                    for (int j = 0; j < 8; ++j) bx[j] = (short)sXS[(ks * 32 + fq * 8 + j) * 72 + pt * 16 + fr];
                    accY[tt] = MFMA16(am, bx, accY[tt]);
                }
#pragma unroll
                for (int j = 0; j < 4; ++j) sY[(lt * 16 + fq * 4 + j) * 68 + pt * 16 + fr] = accY[tt][j];
            }
            const float dec = __expf(sAcs[63]);
            const int pt2 = wid >> 1;
            bf16x8 ax[2];
#pragma unroll
            for (int ks = 0; ks < 2; ++ks)
#pragma unroll
                for (int j = 0; j < 8; ++j) ax[ks][j] = (short)sXD[(ks * 32 + fq * 8 + j) * 72 + pt2 * 16 + fr];
#pragma unroll
            for (int q = 0; q < 4; ++q) {
                const int nt = ph * 4 + q;
                f32x4 a = accS[q] * dec;
#pragma unroll
                for (int ks = 0; ks < 2; ++ks) {
                    bf16x8 bb;
#pragma unroll
                    for (int j = 0; j < 8; ++j) bb[j] = (short)sB[(ks * 32 + fq * 8 + j) * 136 + nt * 16 + fr];
                    a = MFMA16(ax[ks], bb, a);
                }
                accS[q] = a;
#pragma unroll
                for (int j = 0; j < 4; ++j) sS[(pt2 * 16 + fq * 4 + j) * 136 + nt * 16 + fr] = f2bf(a[j]);
            }
        }
        __syncthreads();
        {
            const int l = tid >> 3, p8 = (tid & 7) * 8;
            const size_t ga = (size_t)(t0 + l) * PROJ_LD + C_Z + h * 64 + p8;
            const u32x4 zw = *(const u32x4*)(proj + ga);
            const u32x4 xw = *(const LAS u32x4*)(sXH + l * 72 + p8);
            const f32x4 y0 = *(const LAS f32x4*)(sY + l * 68 + p8), y1 = *(const LAS f32x4*)(sY + l * 68 + p8 + 4);
            float y[8];
            y[0] = (y0[0] + d_h * bflo(xw.x)) * siluf_(bflo(zw.x)); y[1] = (y0[1] + d_h * bfhi(xw.x)) * siluf_(bfhi(zw.x));
            y[2] = (y0[2] + d_h * bflo(xw.y)) * siluf_(bflo(zw.y)); y[3] = (y0[3] + d_h * bfhi(xw.y)) * siluf_(bfhi(zw.y));
            y[4] = (y1[0] + d_h * bflo(xw.z)) * siluf_(bflo(zw.z)); y[5] = (y1[1] + d_h * bfhi(xw.z)) * siluf_(bfhi(zw.z));
            y[6] = (y1[2] + d_h * bflo(xw.w)) * siluf_(bflo(zw.w)); y[7] = (y1[3] + d_h * bfhi(xw.w)) * siluf_(bfhi(zw.w));
            float q = 0.f;
#pragma unroll
            for (int j = 0; j < 8; ++j) q += y[j] * y[j];
            q += __shfl_xor(q, 1); q += __shfl_xor(q, 2); q += __shfl_xor(q, 4);
            if ((tid & 7) == 0) SSQ[(size_t)(t0 + l) * 16 + h] = q;
            u32x4 o; o.x = cvt_pk_bf16(y[0], y[1]); o.y = cvt_pk_bf16(y[2], y[3]); o.z = cvt_pk_bf16(y[4], y[5]); o.w = cvt_pk_bf16(y[6], y[7]);
            *(u32x4*)(proj + ga) = o;
        }
        __syncthreads();
    }
}

__device__ void rglru_tile(const Params& P, int layer, int b, int n, LAS unsigned char* lds) {
    const int tid = otid(), lane = tid & 63, wid = tid >> 6, fr = lane & 15, fq = lane >> 4;
    bf16_t* proj = (bf16_t*)(P.ws + WS_PROJ);
    LAS bf16_t* sXC = (LAS bf16_t*)lds;
    LAS bf16_t* sWa = sXC + 64 * 72;
    LAS bf16_t* sWx = sWa + 64 * 72;
    LAS float* sXCf = (LAS float*)(sWx + 64 * 72);
    LAS float* sA = sXCf + 64 * 64;
    LAS float* sU = sA + 64 * 64;
    LAS float* sPs = sU + 64 * 64;
    LAS float* sHs = sPs + 8 * 64;
    LAS float* sCar = sHs + 8 * 64;
    {
        const int d = tid >> 3, c8 = (tid & 7) * 8;
        const bf16_t* wa = (const bf16_t*)(P.ws + WS_WA) + (size_t)(layer * 8 + n) * 4096;
        const bf16_t* wx = (const bf16_t*)(P.ws + WS_WX) + (size_t)(layer * 8 + n) * 4096;
        *(LAS u32x4*)(sWa + d * 72 + c8) = *(const u32x4*)(wa + d * 64 + c8);
        *(LAS u32x4*)(sWx + d * 72 + c8) = *(const u32x4*)(wx + d * 64 + c8);
    }
    if (tid < 64) sCar[tid] = 0.f;
    const int cg = tid & 7, crow = tid >> 3, ch0 = n * 64 + cg * 8;
    float cw[4][8], cb[8];
#pragma unroll
    for (int j = 0; j < 8; ++j) {
        cb[j] = P.rg_conv_b[layer * 512 + ch0 + j];
#pragma unroll
        for (int i = 0; i < 4; ++i) cw[i][j] = P.rg_conv_w[(layer * 4 + i) * 512 + ch0 + j];
    }
    const int tt = wid & 3, dpair = wid >> 2;
    float ba[2], bx[2], sp[2];
#pragma unroll
    for (int dd = 0; dd < 2; ++dd) {
        const int ch = layer * 512 + n * 64 + (dpair * 2 + dd) * 16 + fr;
        ba[dd] = P.rg_ba[ch]; bx[dd] = P.rg_bx[ch]; sp[dd] = softplusf_(-P.rg_lambda[ch]);
    }
    const int sc = tid & 63, seg = wid;
    __syncthreads();
    for (int c = 0; c < 64; ++c) {
        const int t0 = b * SEQ + c * 64;
        {
            float v[8];
#pragma unroll
            for (int j = 0; j < 8; ++j) v[j] = cb[j];
#pragma unroll
            for (int i = 0; i < 4; ++i) {
                const int pos = c * 64 + crow - 3 + i;
                if (pos >= 0) {
                    const u32x4 w = *(const u32x4*)(proj + (size_t)(b * SEQ + pos) * PROJ_LD + C_RGX + ch0);
                    v[0] += cw[i][0] * bflo(w.x); v[1] += cw[i][1] * bfhi(w.x); v[2] += cw[i][2] * bflo(w.y); v[3] += cw[i][3] * bfhi(w.y);
                    v[4] += cw[i][4] * bflo(w.z); v[5] += cw[i][5] * bfhi(w.z); v[6] += cw[i][6] * bflo(w.w); v[7] += cw[i][7] * bfhi(w.w);
                }
            }
            *(LAS f32x4*)(sXCf + crow * 64 + cg * 8) = (f32x4){v[0], v[1], v[2], v[3]};
            *(LAS f32x4*)(sXCf + crow * 64 + cg * 8 + 4) = (f32x4){v[4], v[5], v[6], v[7]};
            u32x4 o; o.x = cvt_pk_bf16(v[0], v[1]); o.y = cvt_pk_bf16(v[2], v[3]); o.z = cvt_pk_bf16(v[4], v[5]); o.w = cvt_pk_bf16(v[6], v[7]);
            *(LAS u32x4*)(sXC + crow * 72 + cg * 8) = o;
        }
        __syncthreads();
        {
            bf16x8 ax[2];
#pragma unroll
            for (int ks = 0; ks < 2; ++ks) ax[ks] = *(const LAS bf16x8*)(sXC + (tt * 16 + fr) * 72 + ks * 32 + fq * 8);
#pragma unroll
            for (int dd = 0; dd < 2; ++dd) {
                const int dt_ = dpair * 2 + dd;
                f32x4 accA = {0.f, 0.f, 0.f, 0.f}, accX = {0.f, 0.f, 0.f, 0.f};
#pragma unroll
                for (int ks = 0; ks < 2; ++ks) {
                    const bf16x8 wa = *(const LAS bf16x8*)(sWa + (dt_ * 16 + fr) * 72 + ks * 32 + fq * 8);
                    const bf16x8 wx = *(const LAS bf16x8*)(sWx + (dt_ * 16 + fr) * 72 + ks * 32 + fq * 8);
                    accA = MFMA16(ax[ks], wa, accA); accX = MFMA16(ax[ks], wx, accX);
                }
#pragma unroll
                for (int j = 0; j < 4; ++j) {
                    const int t = tt * 16 + fq * 4 + j, d = dt_ * 16 + fr;
                    const float r = sigmoidf_(accA[j] + ba[dd]), ig = sigmoidf_(accX[j] + bx[dd]);
                    const float log_a = -8.f * r * sp[dd];
                    const float a = __expf(log_a);
                    const float mult = sqrtf(fmaxf(-expm1f(2.f * log_a), 0.f));
                    sA[t * 64 + d] = a;
                    sU[t * 64 + d] = mult * ig * sXCf[t * 64 + d];
                }
            }
        }
        __syncthreads();
        {
            float Pl = 1.f, Hl = 0.f;
#pragma unroll
            for (int i = 0; i < 8; ++i) { const float a = sA[(seg * 8 + i) * 64 + sc], u = sU[(seg * 8 + i) * 64 + sc]; Hl = a * Hl + u; Pl *= a; }
            sPs[seg * 64 + sc] = Pl; sHs[seg * 64 + sc] = Hl;
        }
        __syncthreads();
        float H = sCar[sc];
        for (int s2 = 0; s2 < seg; ++s2) H = sPs[s2 * 64 + sc] * H + sHs[s2 * 64 + sc];
#pragma unroll
        for (int i = 0; i < 8; ++i) {
            const int t = seg * 8 + i;
            H = sA[t * 64 + sc] * H + sU[t * 64 + sc];
            const size_t ga = (size_t)(t0 + t) * PROJ_LD + C_GATE + n * 64 + sc;
            const float gate = bf2f(proj[ga]);
            proj[ga] = f2bf(gelu_tanhf_(gate) * H);
        }
        __syncthreads();
        if (seg == 7) sCar[sc] = H;
    }
    __syncthreads();
}

__device__ void attn_tile(const Params& P, int layer, int b, int qb, int kvh, LAS unsigned char* lds) {
    const int tid = otid(), lane = tid & 63, wid = tid >> 6, fr = lane & 15, fq = lane >> 4;
    bf16_t* proj = (bf16_t*)(P.ws + WS_PROJ);
    LAS bf16_t* sK = (LAS bf16_t*)lds;
    LAS bf16_t* sVT = sK + 256 * 72;
    LAS bf16_t* sP = sVT + 64 * 280 + wid * (16 * 168);
    const int tb = b * SEQ + qb * 128;
#pragma unroll
    for (int it = 0; it < 4; ++it) {
        const int idx = it * NTHREADS + tid;
        { const int kk = idx >> 3, dg = idx & 7;
          u32x4 v = {0u, 0u, 0u, 0u};
          if (qb > 0 || kk >= 128) v = *(const u32x4*)(proj + (size_t)(tb - 128 + kk) * PROJ_LD + C_K + kvh * 64 + dg * 8);
          *(LAS u32x4*)(sK + kk * 72 + dg * 8) = v; }
        { const int kk = idx & 255, dg = idx >> 8;
          u32x4 v = {0u, 0u, 0u, 0u};
          if (qb > 0 || kk >= 128) v = *(const u32x4*)(proj + (size_t)(tb - 128 + kk) * PROJ_LD + C_V + kvh * 64 + dg * 8);
          const unsigned wv[4] = {v.x, v.y, v.z, v.w};
#pragma unroll
          for (int j = 0; j < 4; ++j) { sVT[(dg * 8 + 2 * j) * 280 + kk] = (bf16_t)(wv[j] & 0xffffu); sVT[(dg * 8 + 2 * j + 1) * 280 + kk] = (bf16_t)(wv[j] >> 16); } }
    }
    if (tid < 192) { const int d = tid / 3, part = tid % 3; *(LAS u32x4*)(sVT + d * 280 + 256 + part * 8) = (u32x4){0u, 0u, 0u, 0u}; }
    __syncthreads();
    const int q0 = wid * 16;
    for (int r = 0; r < 4; ++r) {
        const int hq = kvh * 4 + r;
        const float sink = P.attn_sinks[layer * 8 + hq];
        bf16x8 qf[2];
#pragma unroll
        for (int ks = 0; ks < 2; ++ks) qf[ks] = *(const bf16x8*)(proj + (size_t)(tb + q0 + fr) * PROJ_LD + C_Q + hq * 64 + ks * 32 + fq * 8);
        f32x4 S[9];
#pragma unroll
        for (int kt = 0; kt < 9; ++kt) {
            f32x4 a = {0.f, 0.f, 0.f, 0.f};
#pragma unroll
            for (int ks = 0; ks < 2; ++ks) { const bf16x8 kf = *(const LAS bf16x8*)(sK + ((wid + kt) * 16 + fr) * 72 + ks * 32 + fq * 8); a = MFMA16(qf[ks], kf, a); }
            S[kt] = a;
        }
        float mx[4], sm[4];
#pragma unroll
        for (int j = 0; j < 4; ++j) mx[j] = -INFINITY;
#pragma unroll
        for (int kt = 0; kt < 9; ++kt)
#pragma unroll
            for (int j = 0; j < 4; ++j) {
                const int qi = q0 + fq * 4 + j, kk = (wid + kt) * 16 + fr, kj = kk - 128;
                const bool valid = (kj <= qi) && (kj > qi - 128) && (qb > 0 || kk >= 128);
                const float s = valid ? S[kt][j] * 0.125f : -INFINITY;
                S[kt][j] = s; mx[j] = fmaxf(mx[j], s);
            }
#pragma unroll
        for (int j = 0; j < 4; ++j) {
            float m = mx[j];
            m = fmaxf(m, __shfl_xor(m, 1)); m = fmaxf(m, __shfl_xor(m, 2)); m = fmaxf(m, __shfl_xor(m, 4)); m = fmaxf(m, __shfl_xor(m, 8));
            mx[j] = fmaxf(m, sink); sm[j] = 0.f;
        }
#pragma unroll
        for (int kt = 0; kt < 9; ++kt)
#pragma unroll
            for (int j = 0; j < 4; ++j) { const float p = __expf(S[kt][j] - mx[j]); S[kt][j] = p; sm[j] += p; }
#pragma unroll
        for (int j = 0; j < 4; ++j) {
            float s = sm[j];
            s += __shfl_xor(s, 1); s += __shfl_xor(s, 2); s += __shfl_xor(s, 4); s += __shfl_xor(s, 8);
            sm[j] = 1.f / (s + __expf(sink - mx[j]));
        }
#pragma unroll
        for (int kt = 0; kt < 9; ++kt)
#pragma unroll
            for (int j = 0; j < 4; ++j) sP[(fq * 4 + j) * 168 + kt * 16 + fr] = f2bf(S[kt][j] * sm[j]);
#pragma unroll
        for (int j = 0; j < 4; ++j) sP[(fq * 4 + j) * 168 + 144 + fr] = 0;
        f32x4 O[4];
#pragma unroll
        for (int dt_ = 0; dt_ < 4; ++dt_) O[dt_] = (f32x4){0.f, 0.f, 0.f, 0.f};
#pragma unroll
        for (int ks = 0; ks < 5; ++ks) {
            const bf16x8 pa = *(const LAS bf16x8*)(sP + fr * 168 + ks * 32 + fq * 8);
#pragma unroll
            for (int dt_ = 0; dt_ < 4; ++dt_) { const bf16x8 vb = *(const LAS bf16x8*)(sVT + (dt_ * 16 + fr) * 280 + wid * 16 + ks * 32 + fq * 8); O[dt_] = MFMA16(pa, vb, O[dt_]); }
        }
#pragma unroll
        for (int dt_ = 0; dt_ < 4; ++dt_)
#pragma unroll
            for (int j = 0; j < 4; ++j) proj[(size_t)(tb + q0 + fq * 4 + j) * PROJ_LD + C_Q + hq * 64 + dt_ * 16 + fr] = f2bf(O[dt_][j]);
    }
    __syncthreads();
}

__device__ void phase_mixers(const Params& P, int layer, LAS unsigned char* lds) {
    unsigned* ctr = (unsigned*)(P.ws + WS_CTL) + 64 * (1 + layer);
    LAS int* sTile = (LAS int*)(lds + LDS_BYTES - 16);
    for (;;) {
        if (otid() == 0) *sTile = (int)atomicAdd(ctr, 1u);
        __syncthreads();
        const int tile = *sTile;
        __syncthreads();
        if (tile >= 256 + 128 + 1024) break;
        if (tile < 256) { if (MIX_MASK & 1) ssd_tile(P, layer, tile >> 4, tile & 15, lds); }
        else if (tile < 384) { const int j = tile - 256; if (MIX_MASK & 2) rglru_tile(P, layer, j >> 3, j & 7, lds); }
        else { const int j = tile - 384; if (MIX_MASK & 4) attn_tile(P, layer, j >> 6, (j >> 1) & 31, j & 1, lds); }
    }
}

__device__ void phase_ssdnorm(const Params& P) {
    bf16_t* proj = (bf16_t*)(P.ws + WS_PROJ);
    const float* SSQ = (const float*)(P.ws + WS_SSQ);
    for (size_t i = (size_t)obid() * NTHREADS + otid(); i < (size_t)T_TOK * 128; i += (size_t)gridDim.x * NTHREADS) {
        const size_t t = i >> 7; const int c8 = (int)(i & 127) * 8, g = c8 >> 9;
        const f32x4 s0 = *(const f32x4*)(SSQ + t * 16 + g * 8), s1 = *(const f32x4*)(SSQ + t * 16 + g * 8 + 4);
        const float ss = s0[0] + s0[1] + s0[2] + s0[3] + s1[0] + s1[1] + s1[2] + s1[3];
        const float sc = rsqrtf(ss * (1.f / 512.f) + LN_EPS);
        u32x4* p = (u32x4*)(proj + t * PROJ_LD + C_Z + c8);
        const u32x4 w = *p;
        u32x4 o; o.x = cvt_pk_bf16(bflo(w.x) * sc, bfhi(w.x) * sc); o.y = cvt_pk_bf16(bflo(w.y) * sc, bfhi(w.y) * sc);
        o.z = cvt_pk_bf16(bflo(w.z) * sc, bfhi(w.z) * sc); o.w = cvt_pk_bf16(bflo(w.w) * sc, bfhi(w.w) * sc);
        *p = o;
    }
}

__device__ __forceinline__ unsigned mono_(float f) { const unsigned u = __float_as_uint(f); return (u & 0x80000000u) ? ~u : (u | 0x80000000u); }
__device__ __forceinline__ float unmono_(unsigned u) { return __uint_as_float((u & 0x80000000u) ? (u ^ 0x80000000u) : ~u); }

__device__ void phase_peer_topk(const Params& P, int layer, LAS unsigned char* lds) {
    const int tid = otid(), lane = tid & 63, wid = tid >> 6, fr = lane & 15, fq = lane >> 4;
    const bf16_t* QP = (const bf16_t*)(P.ws + WS_QP);
    const bf16_t* keys = (const bf16_t*)(P.ws + WS_KEYS) + (size_t)layer * 2 * 128 * 64;
    int* IDX = (int*)(P.ws + WS_IDX);
    float* GATE = (float*)(P.ws + WS_GATE);
    LAS float* sSc = (LAS float*)lds;
    LAS unsigned* sTop = (LAS unsigned*)lds;
    for (int tile = obid(); tile < T_TOK / 32; tile += gridDim.x) {
        const int tok0 = tile * 32;
        unsigned top[16];
#pragma unroll
        for (int k = 0; k < 16; ++k) top[k] = 0u;
        for (int ps = 0; ps < 2; ++ps) {
#pragma unroll
            for (int i = 0; i < 2; ++i)
#pragma unroll
                for (int mt = 0; mt < 2; ++mt) {
                    bf16x8 a[2];
#pragma unroll
                    for (int ks = 0; ks < 2; ++ks) a[ks] = *(const bf16x8*)(QP + (size_t)(tok0 + mt * 16 + fr) * DM + wid * 128 + i * 64 + ks * 32 + fq * 8);
#pragma unroll
                    for (int nt = 0; nt < 4; ++nt) {
                        f32x4 acc = {0.f, 0.f, 0.f, 0.f};
#pragma unroll
                        for (int ks = 0; ks < 2; ++ks) { const bf16x8 kb = *(const bf16x8*)(keys + (size_t)(i * 128 + ps * 64 + nt * 16 + fr) * 64 + ks * 32 + fq * 8); acc = MFMA16(a[ks], kb, acc); }
#pragma unroll
                        for (int j = 0; j < 4; ++j) sSc[((wid * 2 + i) * 32 + mt * 16 + fq * 4 + j) * 65 + nt * 16 + fr] = acc[j];
                    }
                }
            __syncthreads();
            for (int k = 0; k < 64; ++k) {
                const float s = sSc[tid * 65 + k];
                unsigned x = (mono_(s) & ~0x7Fu) | (unsigned)(127 - (ps * 64 + k));
#pragma unroll
                for (int q = 0; q < 16; ++q) { const unsigned hi = umax_(top[q], x); x = umin_(top[q], x); top[q] = hi; }
            }
            __syncthreads();
        }
#pragma unroll
        for (int q = 0; q < 4; ++q) *(LAS u32x4*)(sTop + tid * 16 + q * 4) = (u32x4){top[q * 4], top[q * 4 + 1], top[q * 4 + 2], top[q * 4 + 3]};
        __syncthreads();
        if (tid < 256) {
            const int token = tid & 31, h = tid >> 5;
            const int row1 = (h * 2) * 32 + token, row2 = (h * 2 + 1) * 32 + token;
            float s1[16], s2[16];
#pragma unroll
            for (int q = 0; q < 4; ++q) {
                const u32x4 a = *(const LAS u32x4*)(sTop + row1 * 16 + q * 4), bq = *(const LAS u32x4*)(sTop + row2 * 16 + q * 4);
#pragma unroll
                for (int e = 0; e < 4; ++e) { s1[q * 4 + e] = unmono_(a[e] & ~0x7Fu); s2[q * 4 + e] = unmono_(bq[e] & ~0x7Fu); }
            }
            unsigned best[16];
#pragma unroll
            for (int k = 0; k < 16; ++k) best[k] = 0u;
#pragma unroll
            for (int a = 0; a < 16; ++a)
#pragma unroll
                for (int bb = 0; bb < 16; ++bb) {
                    if ((a + 1) * (bb + 1) <= 16) {
                        unsigned x = (mono_(s1[a] + s2[bb]) & ~0xFFu) | (unsigned)(255 - (a * 16 + bb));
#pragma unroll
                        for (int q = 0; q < 16; ++q) { const unsigned hi = umax_(best[q], x); x = umin_(best[q], x); best[q] = hi; }
                    }
                }
            float val[16], gsum = 0.f;
            const float vmax = unmono_(best[0] & ~0xFFu);
#pragma unroll
            for (int k = 0; k < 16; ++k) { val[k] = __expf(unmono_(best[k] & ~0xFFu) - vmax); gsum += val[k]; }
            const float ginv = 1.f / gsum;
            const size_t ob = (size_t)(tok0 + token) * 128 + h * 16;
#pragma unroll
            for (int k = 0; k < 16; ++k) {
                const int code = 255 - (int)(best[k] & 0xFFu), a = code >> 4, bb = code & 15;
                const int i1 = 127 - (int)(sTop[row1 * 16 + a] & 0x7Fu), i2 = 127 - (int)(sTop[row2 * 16 + bb] & 0x7Fu);
                IDX[ob + k] = i1 * 128 + i2;
                GATE[ob + k] = val[k] * ginv;
            }
        }
        __syncthreads();
    }
}

__device__ void phase_peer_experts(const Params& P, int layer) {
    const int lane = otid() & 63, wid = otid() >> 6;
    bf16_t* hb = (bf16_t*)(P.ws + WS_HB);
    const bf16_t* U = (const bf16_t*)(P.ws + WS_U) + (size_t)layer * 16384 * 1024;
    const bf16_t* V = (const bf16_t*)(P.ws + WS_V) + (size_t)layer * 16384 * 1024;
    const int* IDX = (const int*)(P.ws + WS_IDX);
    const float* GATE = (const float*)(P.ws + WS_GATE);
    const float* g = P.ln2_g + layer * DM; const float* bta = P.ln2_b + layer * DM;
    for (int t = obid() * 8 + wid; t < T_TOK; t += gridDim.x * 8) {
        const u32x4 xa = *(const u32x4*)(hb + (size_t)t * DM + lane * 8), xb = *(const u32x4*)(hb + (size_t)t * DM + 512 + lane * 8);
        const int my_i0 = IDX[(size_t)t * 128 + lane], my_i1 = IDX[(size_t)t * 128 + 64 + lane];
        const float my_g0 = GATE[(size_t)t * 128 + lane], my_g1 = GATE[(size_t)t * 128 + 64 + lane];
        float acc[16];
#pragma unroll
        for (int j = 0; j < 16; ++j) acc[j] = 0.f;
        for (int e0 = 0; e0 < 128; e0 += 4) {
            u32x4 ua[4], ub[4], va[4], vb[4]; float gq[4];
#pragma unroll
            for (int q = 0; q < 4; ++q) {
                const int e = e0 + q;
                const int idx = __shfl(e0 < 64 ? my_i0 : my_i1, e & 63);
                gq[q] = __shfl(e0 < 64 ? my_g0 : my_g1, e & 63);
                const bf16_t* up = U + (size_t)idx * DM + lane * 8; const bf16_t* vp = V + (size_t)idx * DM + lane * 8;
                ua[q] = *(const u32x4*)up; ub[q] = *(const u32x4*)(up + 512);
                va[q] = *(const u32x4*)vp; vb[q] = *(const u32x4*)(vp + 512);
            }
#pragma unroll
            for (int q = 0; q < 4; ++q) {
                float d = 0.f;
                d = dot2bf(xa.x, ua[q].x, d); d = dot2bf(xa.y, ua[q].y, d); d = dot2bf(xa.z, ua[q].z, d); d = dot2bf(xa.w, ua[q].w, d);
                d = dot2bf(xb.x, ub[q].x, d); d = dot2bf(xb.y, ub[q].y, d); d = dot2bf(xb.z, ub[q].z, d); d = dot2bf(xb.w, ub[q].w, d);
                d = wave_sum(d);
                const float w = gq[q] * gelu_erff_(d);
                acc[0] += w * bflo(va[q].x); acc[1] += w * bfhi(va[q].x); acc[2] += w * bflo(va[q].y); acc[3] += w * bfhi(va[q].y);
                acc[4] += w * bflo(va[q].z); acc[5] += w * bfhi(va[q].z); acc[6] += w * bflo(va[q].w); acc[7] += w * bfhi(va[q].w);
                acc[8] += w * bflo(vb[q].x); acc[9] += w * bfhi(vb[q].x); acc[10] += w * bflo(vb[q].y); acc[11] += w * bfhi(vb[q].y);
                acc[12] += w * bflo(vb[q].z); acc[13] += w * bfhi(vb[q].z); acc[14] += w * bflo(vb[q].w); acc[15] += w * bfhi(vb[q].w);
            }
        }
        float* hrow = P.out + (size_t)t * DM;
        float y[16];
        {
            const f32x4 h0 = *(const f32x4*)(hrow + lane * 8), h1 = *(const f32x4*)(hrow + lane * 8 + 4), h2 = *(const f32x4*)(hrow + 512 + lane * 8), h3 = *(const f32x4*)(hrow + 512 + lane * 8 + 4);
#pragma unroll
            for (int j = 0; j < 4; ++j) { y[j] = DN_ALPHA * h0[j] + acc[j]; y[4 + j] = DN_ALPHA * h1[j] + acc[4 + j]; y[8 + j] = DN_ALPHA * h2[j] + acc[8 + j]; y[12 + j] = DN_ALPHA * h3[j] + acc[12 + j]; }
        }
        float s = 0.f;
#pragma unroll
        for (int j = 0; j < 16; ++j) s += y[j];
        s = wave_sum(s);
        const float mu = s * (1.f / DM);
        float q = 0.f;
#pragma unroll
        for (int j = 0; j < 16; ++j) { y[j] -= mu; q += y[j] * y[j]; }
        q = wave_sum(q);
        const float rs = rsqrtf(q * (1.f / DM) + LN_EPS);
        {
            const f32x4 g0 = *(const f32x4*)(g + lane * 8), g1 = *(const f32x4*)(g + lane * 8 + 4), g2 = *(const f32x4*)(g + 512 + lane * 8), g3 = *(const f32x4*)(g + 512 + lane * 8 + 4);
            const f32x4 b0 = *(const f32x4*)(bta + lane * 8), b1 = *(const f32x4*)(bta + lane * 8 + 4), b2 = *(const f32x4*)(bta + 512 + lane * 8), b3 = *(const f32x4*)(bta + 512 + lane * 8 + 4);
            f32x4 o0, o1, o2, o3;
#pragma unroll
            for (int j = 0; j < 4; ++j) { o0[j] = y[j] * rs * g0[j] + b0[j]; o1[j] = y[4 + j] * rs * g1[j] + b1[j]; o2[j] = y[8 + j] * rs * g2[j] + b2[j]; o3[j] = y[12 + j] * rs * g3[j] + b3[j]; }
            *(f32x4*)(hrow + lane * 8) = o0; *(f32x4*)(hrow + lane * 8 + 4) = o1; *(f32x4*)(hrow + 512 + lane * 8) = o2; *(f32x4*)(hrow + 512 + lane * 8 + 4) = o3;
            u32x4 w0, w1;
            w0.x = cvt_pk_bf16(o0[0], o0[1]); w0.y = cvt_pk_bf16(o0[2], o0[3]); w0.z = cvt_pk_bf16(o1[0], o1[1]); w0.w = cvt_pk_bf16(o1[2], o1[3]);
            w1.x = cvt_pk_bf16(o2[0], o2[1]); w1.y = cvt_pk_bf16(o2[2], o2[3]); w1.z = cvt_pk_bf16(o3[0], o3[1]); w1.w = cvt_pk_bf16(o3[2], o3[3]);
            *(u32x4*)(hb + (size_t)t * DM + lane * 8) = w0; *(u32x4*)(hb + (size_t)t * DM + 512 + lane * 8) = w1;
        }
    }
}

constexpr int N_PHASES = 1 + 8 * DEPTH;
__global__ void __launch_bounds__(NTHREADS, 2) fwd_megakernel(Params P) {
    extern __shared__ __attribute__((aligned(16))) unsigned char lds_raw[];
    LAS unsigned char* lds = (LAS unsigned char*)lds_raw;
    cg::grid_group grid = cg::this_grid();
    unsigned char* ws = P.ws;
#ifdef DEBUG_COPY
    const int ph_end = P.ph_hi + 1;
#else
    const int ph_end = P.ph_hi;
#endif
    for (int ph = P.ph_lo; ph < ph_end; ++ph) {
        if (ph > P.ph_lo) {
            asm volatile("s_waitcnt vmcnt(0)" ::: "memory");
            __syncthreads();
            grid.sync();
            if (otid() < 64) { __builtin_amdgcn_fence(__ATOMIC_ACQUIRE, "agent"); asm volatile("s_waitcnt vmcnt(0)" ::: "memory"); }
            __syncthreads();
        }
        if (ph == 0) { phase_prep(P, lds); continue; }
#ifdef DEBUG_COPY
        if (ph == P.ph_hi) {
            const bf16_t* proj = (const bf16_t*)(ws + WS_PROJ);
            const float* DTp = (const float*)(ws + WS_DT);
            for (size_t i = (size_t)obid() * NTHREADS + otid(); i < (size_t)T_TOK * 1024; i += (size_t)gridDim.x * NTHREADS) {
                const size_t t = i >> 10; const int c = (int)(i & 1023);
                float v;
                if (c < 256) v = bf2f(proj[t * PROJ_LD + C_K + c]);
                else if (c < 1008) v = bf2f(proj[t * PROJ_LD + C_XBC + (c - 256) * 2]);
                else v = DTp[t * 16 + (c - 1008)];
                P.out[i] = v;
            }
            continue;
        }
#endif
        const int layer = (ph - 1) / 8, sub = (ph - 1) % 8;
        if (sub == 0 || sub == 3 || sub == 5) {
            pg8::Gemm g; pg8::Epi E; int N;
            if (sub == 0) {
                g = pg8::Gemm{(const bf16_t*)(ws + WS_HB), (const bf16_t*)(ws + WS_WIN) + (size_t)layer * N_IN * 1024, T_TOK, N_IN, 1024, 1024, 1 << 30, 0};
                E.mode = 0; E.eb = pg8::EpiBf16{(bf16_t*)(ws + WS_PROJ), PROJ_LD, 3584, (size_t)3600}; E.er = pg8::EpiResF32{nullptr, 0, 0.f}; N = N_IN;
            } else if (sub == 3) {
                g = pg8::Gemm{(const bf16_t*)(ws + WS_PROJ) + C_GATE, (const bf16_t*)(ws + WS_WOUT) + (size_t)layer * 1024 * MIXW, T_TOK, 1024, MIXW, PROJ_LD, 24, (C_Q - (C_GATE + 1536)) * 2};
                E.mode = 1; E.eb = pg8::EpiBf16{nullptr, 0, 0, (size_t)0}; E.er = pg8::EpiResF32{P.out, DM, DN_ALPHA}; N = 1024;
            } else {
                g = pg8::Gemm{(const bf16_t*)(ws + WS_HB), (const bf16_t*)(ws + WS_WQ) + (size_t)layer * 1024 * 1024, T_TOK, 1024, 1024, 1024, 1 << 30, 0};
                E.mode = 0; E.eb = pg8::EpiBf16{(bf16_t*)(ws + WS_QP), DM, 0, (size_t)0}; E.er = pg8::EpiResF32{nullptr, 0, 0.f}; N = 1024;
            }
            pg8::StaticOrder S; S.init(T_TOK, N, (int)gridDim.x, (int)obid());
            __syncthreads();
            pg8::gemm_phase(lds, g, S, E);
            if (sub == 0) phase_dt(P, layer);
        } else if (sub == 1) {
#ifndef SKIP_MIX
            phase_mixers(P, layer, lds);
#endif
        } else if (sub == 2) {
            phase_ssdnorm(P);
        } else if (sub == 4) {
            ln_rows(P.out, P.out, (bf16_t*)(ws + WS_HB), P.ln1_g + layer * DM, P.ln1_b + layer * DM);
        } else if (sub == 6) {
            phase_peer_topk(P, layer, lds);
        } else {
            phase_peer_experts(P, layer);
        }
    }
}

extern "C" void kernel_launch(void* const* d_in, const int* in_sizes, int n_in, void* d_out, int out_size, void* d_ws, size_t ws_size, hipStream_t stream) {
    static int grid_blocks = 0;
    if (grid_blocks == 0) {
        if (n_in != 27 || out_size != T_TOK * DM || ws_size < WS_END) { fprintf(stderr, "kernel_launch: unexpected shapes (n_in %d out %d ws %zu need %zu)\n", n_in, out_size, ws_size, (size_t)WS_END); grid_blocks = -1; return; }
        int dev = 0, cus = 0, per_cu = 0;
        hipGetDevice(&dev);
        hipDeviceGetAttribute(&cus, hipDeviceAttributeMultiprocessorCount, dev);
        if (hipFuncSetAttribute((const void*)fwd_megakernel, hipFuncAttributeMaxDynamicSharedMemorySize, LDS_BYTES) != hipSuccess) { fprintf(stderr, "kernel_launch: hipFuncSetAttribute failed\n"); grid_blocks = -1; return; }
        hipOccupancyMaxActiveBlocksPerMultiprocessor(&per_cu, (const void*)fwd_megakernel, NTHREADS, LDS_BYTES);
        if (per_cu < 1) { fprintf(stderr, "kernel_launch: occupancy query says %d blocks per CU\n", per_cu); grid_blocks = -1; return; }
        grid_blocks = cus;
    }
    if (grid_blocks < 0) return;
    hipMemsetAsync((char*)d_ws + WS_CTL, 0, 65536, stream);
    Params p{};
    const float** pp = (const float**)&p;
    for (int i = 0; i < 27; ++i) pp[i] = (const float*)d_in[i];
    p.out = (float*)d_out; p.ws = (unsigned char*)d_ws; p.ph_lo = 0; p.ph_hi = PH_HI;
    void* args[] = {&p};
    hipError_t e = hipLaunchCooperativeKernel((const void*)fwd_megakernel, dim3(grid_blocks), dim3(NTHREADS), args, LDS_BYTES, stream);
    if (e != hipSuccess) fprintf(stderr, "cooperative launch failed: %s (grid %d)\n", hipGetErrorString(e), grid_blocks);
}
```

```cpp
#include <hip/hip_runtime.h>
#include <hip/hip_cooperative_groups.h>
#include <cstdio>
#include <cstdint>
namespace cg = cooperative_groups;
#ifndef PH_HI
#define PH_HI N_PHASES
#endif
#ifndef MIX_MASK
#define MIX_MASK 7
#endif

#define LAS __attribute__((address_space(3)))
typedef unsigned short bf16_t;
typedef short bf16x8 __attribute__((ext_vector_type(8)));
typedef float f32x4 __attribute__((ext_vector_type(4)));
typedef float f32x2 __attribute__((ext_vector_type(2)));
typedef unsigned u32x4 __attribute__((ext_vector_type(4)));
typedef unsigned u32x2 __attribute__((ext_vector_type(2)));
using bf16x2v = __attribute__((ext_vector_type(2))) __bf16;

constexpr int T_TOK = 65536, DM = 1024, SEQ = 4096, NBATCH = 16, DEPTH = 2;
constexpr int PROJ_LD = 4368;
constexpr int C_RGX = 0, C_GATE = 512, C_Z = 1024, C_XBC = 2048, C_DT = 3584, C_Q = 3600, C_K = 4112, C_V = 4240;
constexpr int N_IN = 4352;
constexpr int MIXW = 2048;
constexpr float DN_ALPHA = 1.41421356237f;
constexpr float LN_EPS = 1e-5f;
constexpr int NTHREADS = 512;
constexpr int LDS_BYTES = 147456;

constexpr size_t WS_CTL  = 0;
constexpr size_t WS_WIN  = 65536;
constexpr size_t WS_WDT  = WS_WIN  + (size_t)2 * N_IN * 1024 * 2;
constexpr size_t WS_WOUT = WS_WDT  + (size_t)2 * 16 * 1024 * 2;
constexpr size_t WS_WQ   = WS_WOUT + (size_t)2 * 1024 * 2048 * 2;
constexpr size_t WS_KEYS = WS_WQ   + (size_t)2 * 1024 * 1024 * 2;
constexpr size_t WS_WA   = WS_KEYS + (size_t)2 * 2 * 128 * 64 * 2;
constexpr size_t WS_WX   = WS_WA   + (size_t)2 * 8 * 64 * 64 * 2;
constexpr size_t WS_U    = WS_WX   + (size_t)2 * 8 * 64 * 64 * 2;
constexpr size_t WS_V    = WS_U    + (size_t)2 * 16384 * 1024 * 2;
constexpr size_t WS_HB   = WS_V    + (size_t)2 * 16384 * 1024 * 2;
constexpr size_t WS_DT   = WS_HB   + (size_t)T_TOK * 1024 * 2;
constexpr size_t WS_SSQ  = WS_DT   + (size_t)T_TOK * 16 * 4;
constexpr size_t WS_PROJ = WS_SSQ  + (size_t)T_TOK * 16 * 4;
constexpr size_t WS_END  = WS_PROJ + (size_t)T_TOK * PROJ_LD * 2;
constexpr size_t WS_U8 = WS_U, WS_SU = WS_U + (size_t)2 * 16384 * 1024;
constexpr size_t WS_V8 = WS_V, WS_SV = WS_V + (size_t)2 * 16384 * 1024;
constexpr size_t WS_QP   = WS_PROJ;
constexpr size_t WS_IDX  = WS_QP  + (size_t)T_TOK * 1024 * 2;
constexpr size_t WS_GATE = WS_IDX + (size_t)T_TOK * 128 * 4;

struct Params {
    const float* x; const float* emb_g; const float* emb_b; const float* w_in; const float* rg_conv_w; const float* rg_conv_b;
    const float* rg_wa; const float* rg_ba; const float* rg_wx; const float* rg_bx; const float* rg_lambda;
    const float* ssm_conv_w; const float* ssm_conv_b; const float* ssm_dt_bias; const float* ssm_a_log; const float* ssm_d; const float* ssm_norm_g;
    const float* attn_sinks; const float* w_out; const float* ln1_g; const float* ln1_b;
    const float* peer_wq; const float* peer_keys; const float* peer_u; const float* peer_v; const float* ln2_g; const float* ln2_b;
    float* out; unsigned char* ws; int ph_lo, ph_hi;
};

typedef __bf16 bf16x2n __attribute__((ext_vector_type(2)));
__device__ __forceinline__ unsigned cvt_pk_bf16(float lo, float hi) { const f32x2 v = {lo, hi}; const bf16x2n r = __builtin_convertvector(v, bf16x2n); return __builtin_bit_cast(unsigned, r); }
__device__ __forceinline__ bf16_t f2bf(float f) { return (bf16_t)(cvt_pk_bf16(f, 0.f) & 0xffffu); }
__device__ __forceinline__ float bf2f(bf16_t b) { return __uint_as_float(((unsigned)b) << 16); }
__device__ __forceinline__ float bflo(unsigned w) { return __uint_as_float(w << 16); }
__device__ __forceinline__ float bfhi(unsigned w) { return __uint_as_float(w & 0xffff0000u); }
__device__ __forceinline__ float sigmoidf_(float x) { return 1.f / (1.f + __expf(-x)); }
__device__ __forceinline__ float siluf_(float x) { return x / (1.f + __expf(-x)); }
__device__ __forceinline__ float softplusf_(float x) { return x > 20.f ? x : log1pf(__expf(x)); }
__device__ __forceinline__ float gelu_tanhf_(float x) { const float u = 0.7978845608028654f * (x + 0.044715f * x * x * x); const float t = 1.f - 2.f / (__expf(2.f * u) + 1.f); return 0.5f * x * (1.f + t); }
__device__ __forceinline__ float gelu_erff_(float x) { return 0.5f * x * (1.f + erff(x * 0.70710678118654752f)); }
__device__ __forceinline__ float wave_sum(float v) {
#pragma unroll
    for (int o = 32; o > 0; o >>= 1) v += __shfl_xor(v, o);
    return v;
}
template <int CTRL> __device__ __forceinline__ float dpp_(float x) { return __builtin_bit_cast(float, __builtin_amdgcn_mov_dpp(__builtin_bit_cast(int, x), CTRL, 0xf, 0xf, true)); }
__device__ __forceinline__ float row_sum16(float x) { x += dpp_<0xB1>(x); x += dpp_<0x4E>(x); x += dpp_<0x141>(x); x += dpp_<0x128>(x); return x; }
__device__ __forceinline__ float rdlane(float x, int l) { return __builtin_bit_cast(float, __builtin_amdgcn_readlane(__builtin_bit_cast(int, x), l)); }
__device__ __forceinline__ float wave_sum_dpp(float x) { x = row_sum16(x); return (rdlane(x, 0) + rdlane(x, 16)) + (rdlane(x, 32) + rdlane(x, 48)); }
__device__ __forceinline__ float gelu_cdf_(float v) {
    const float av = fabsf(v), t = __builtin_amdgcn_rcpf(av * 0.2316418882f + 1.0f);
    float q = t * 0.5307027145f + (-0.7265760135f); q = q * t + 0.7107068705f; q = q * t + (-0.142248368f); q = q * t + 0.127414796f; q = q * t;
    const float e = __builtin_amdgcn_exp2f(v * v * (-0.72134752044f));
    const float m = v * (q * e), r = v - m;
    return v < 0.f ? m : r;
}
__device__ __forceinline__ float dot2bf(unsigned a, unsigned b, float acc) { return __builtin_amdgcn_fdot2_f32_bf16(__builtin_bit_cast(bf16x2v, a), __builtin_bit_cast(bf16x2v, b), acc, false); }
__device__ __forceinline__ unsigned umax_(unsigned a, unsigned b) { return a > b ? a : b; }
__device__ __forceinline__ unsigned umin_(unsigned a, unsigned b) { return a < b ? a : b; }
__device__ __forceinline__ int otid() { int t = (int)threadIdx.x; asm volatile("" : "+v"(t)); return t; }
__device__ __forceinline__ int obid() { int b = (int)blockIdx.x; asm volatile("" : "+s"(b)); return b; }
#define MFMA16(a, b, c) __builtin_amdgcn_mfma_f32_16x16x32_bf16((a), (b), (c), 0, 0, 0)

namespace pg8 {
constexpr int BM = 256, BK = 64, HALF = 128, HTB = HALF * BK * 2, STAGE_BYTES = 8 * HTB, NXCD = 8, WGM = 8;
__device__ __forceinline__ int lds_byte(int r, int c) { const int st = (r >> 4) * 2 + (c >> 5), rr = r & 15, cc = c & 31, ob = rr * 64 + cc * 2; return st * 1024 + (ob ^ (((ob >> 9) & 1) << 5)); }
__device__ __forceinline__ void stage_rc(int b, int& R, int& C) { const int st = b / 1024, sb = b % 1024, swz = sb ^ (((sb >> 9) & 1) << 5); R = (st >> 1) * 16 + swz / 64; C = (st & 1) * 32 + (swz % 64) / 2; }
__device__ __forceinline__ int perm32(int rho) { const int n = rho >> 4, i = rho & 15; return 8 * (i >> 2) + 4 * n + (i & 3); }
struct Unit { int pm, pn; };
struct Gemm { const bf16_t* A; const bf16_t* Bt; int M, N, K, lda, ksplit, kextra; };
struct StaticOrder {
    int nM, nN, nwg, G, c;
    __device__ void init(int M, int N, int G_, int c_) { nM = M / BM; nN = N / BM; nwg = nM * nN; G = G_; c = c_; }
    __device__ bool next(int i, Unit& u) const {
        const long L = (long)i * G + c; if (L >= nwg) return false;
        int wgid = (int)L; { const int q = nwg / NXCD, r = nwg % NXCD, xcd = wgid % NXCD, off = wgid / NXCD; wgid = (xcd < r ? xcd * (q + 1) : r * (q + 1) + (xcd - r) * q) + off; }
        const int nig = WGM * nN, gid = wgid / nig, fm = gid * WGM, gsz = (nM - fm) < WGM ? (nM - fm) : WGM;
        u.pm = fm + ((wgid % nig) % gsz); u.pn = (wgid % nig) / gsz; return true;
    }
};
struct EpiBf16 {
    static constexpr bool PERM = true;
    bf16_t* O; int ldc; int split_cols; size_t split_stride;
    __device__ __forceinline__ void operator()(const f32x4 (&acc)[2][2][4][2], const Unit& u, int wr, int wc, int fr, int fq) const {
        const int row0 = u.pm * BM + wr * 64 + fr; int colt = u.pn * BM; bf16_t* base = O;
        if (split_cols) { const int t = colt / split_cols; base += (size_t)t * split_stride; colt -= t * split_cols; }
        const int col0 = colt + wc * 32 + 8 * fq;
#pragma unroll
        for (int ai = 0; ai < 2; ++ai)
#pragma unroll
            for (int m = 0; m < 4; ++m) { bf16_t* rowp = base + (size_t)(row0 + ai * HALF + m * 16) * ldc + col0;
#pragma unroll
                for (int bj = 0; bj < 2; ++bj) { const f32x4 v0 = acc[ai][bj][m][0], v1 = acc[ai][bj][m][1];
                    u32x4 w; w.x = cvt_pk_bf16(v0[0], v0[1]); w.y = cvt_pk_bf16(v0[2], v0[3]); w.z = cvt_pk_bf16(v1[0], v1[1]); w.w = cvt_pk_bf16(v1[2], v1[3]);
                    *(u32x4*)(rowp + bj * HALF) = w; } }
    }
};
struct EpiResF32 {
    static constexpr bool PERM = false;
    float* C; int ldc; float alpha;
    __device__ __forceinline__ void operator()(const f32x4 (&acc)[2][2][4][2], const Unit& u, int wr, int wc, int fr, int fq) const {
        const int row0 = u.pm * BM + wr * 64 + fr, col0 = u.pn * BM + wc * 32 + 4 * fq;
#pragma unroll
        for (int ai = 0; ai < 2; ++ai)
#pragma unroll
            for (int m = 0; m < 4; ++m) { float* rowp = C + (size_t)(row0 + ai * HALF + m * 16) * ldc + col0;
#pragma unroll
                for (int bj = 0; bj < 2; ++bj)
#pragma unroll
                    for (int n = 0; n < 2; ++n) { f32x4* p = (f32x4*)(rowp + bj * HALF + n * 16); const f32x4 h = *p; *p = h * alpha + acc[ai][bj][m][n]; } }
    }
};

struct Epi {
    int mode; EpiBf16 eb; EpiResF32 er;
};
__device__ __forceinline__ void gemm_phase(LAS unsigned char* lds, const Gemm g, const StaticOrder& S, const Epi& E) {
    const int tid = otid(), wid = __builtin_amdgcn_readfirstlane(tid >> 6), lane = tid & 63, wr = wid >> 2, wc = wid & 3, fr = lane & 15, fq = lane >> 4;
    const int K = g.K, nt = K / BK, lda = g.lda;
    unsigned voffA[2], voffB[2];
#pragma unroll
    for (int i = 0; i < 2; ++i) { int R, C; stage_rc(tid * 16 + i * 8192, R, C); const int Rb = (E.mode == 0) ? ((R & ~31) + perm32(R & 31)) : R;
        voffA[i] = (unsigned)(R * lda + C) * 2u; voffB[i] = (unsigned)(Rb * K + C) * 2u; }
    const size_t kstep = (size_t)(BK * 2);
    const size_t hstepA = (size_t)HALF * lda * 2, hstepB = (size_t)HALF * K * 2;
    const size_t tstepA = 2 * hstepA, tstepB = 2 * hstepB;
    const int ksplit = g.ksplit; const size_t kextra = (size_t)g.kextra;
#define PG8_AKOFF(t) ((size_t)(t) * kstep + (((t) >= ksplit) ? kextra : (size_t)0))
    const unsigned ldsw = (unsigned)wid * 1024u;
    const int aoff = lds_byte(wr * 64 + fr, fq * 8), boff = lds_byte(wc * 32 + fr, fq * 8);
#define PG8_SA(b, h) (((b) * 2 + (h)) * HTB)
#define PG8_SB(b, h) ((4 + (b) * 2 + (h)) * HTB)
#define PG8_STAGE(bufoff, gbase, voff) do { _Pragma("unroll") for (int _i = 0; _i < 2; ++_i) \
        __builtin_amdgcn_global_load_lds((const unsigned*)((const char*)(gbase) + (voff)[_i]), (LAS unsigned*)(lds + (bufoff) + ldsw + _i * 8192), 16, 0, 0); } while (0)
#define PG8_LDA(dst, b, h) do { _Pragma("unroll") for (int m = 0; m < 4; ++m) _Pragma("unroll") for (int k = 0; k < 2; ++k) dst[m][k] = *(const LAS bf16x8*)(lds + PG8_SA(b, h) + aoff + m * 2048 + k * 1024); } while (0)
#define PG8_LDB(dst, b, h) do { _Pragma("unroll") for (int n = 0; n < 2; ++n) _Pragma("unroll") for (int k = 0; k < 2; ++k) dst[n][k] = *(const LAS bf16x8*)(lds + PG8_SB(b, h) + boff + n * 2048 + k * 1024); } while (0)
#define PG8_MMA(ai, bj, At, Bt) do { __builtin_amdgcn_s_setprio(1); _Pragma("unroll") for (int m = 0; m < 4; ++m) _Pragma("unroll") for (int n = 0; n < 2; ++n) _Pragma("unroll") for (int k = 0; k < 2; ++k) \
        acc[ai][bj][m][n] = __builtin_amdgcn_mfma_f32_16x16x32_bf16(Bt[n][k], At[m][k], acc[ai][bj][m][n], 0, 0, 0); __builtin_amdgcn_s_setprio(0); } while (0)
#define PG8_WAIT_V(n) asm volatile("s_waitcnt vmcnt(" #n ")" ::: "memory")
#define PG8_WAIT_L(n) asm volatile("s_waitcnt lgkmcnt(" #n ")" ::: "memory")
#define PG8_BAR __builtin_amdgcn_s_barrier()
#define PG8_SCHED __builtin_amdgcn_sched_barrier(0)
    Unit cur, nxt; int ui = 0;
    if (!S.next(0, cur)) return;
    f32x4 acc[2][2][4][2];
#pragma unroll
    for (int a = 0; a < 2; ++a)
#pragma unroll
        for (int b = 0; b < 2; ++b)
#pragma unroll
            for (int m = 0; m < 4; ++m)
#pragma unroll
                for (int n = 0; n < 2; ++n) acc[a][b][m][n] = (f32x4){0.f, 0.f, 0.f, 0.f};
    bf16x8 At[4][2], B0[2][2], B1[2][2];
    const char* cA = (const char*)g.A + (size_t)cur.pm * tstepA; const char* cB = (const char*)g.Bt + (size_t)cur.pn * tstepB;
    PG8_STAGE(PG8_SB(0, 0), cB, voffB); PG8_STAGE(PG8_SA(0, 0), cA, voffA); PG8_STAGE(PG8_SB(0, 1), cB + hstepB, voffB); PG8_STAGE(PG8_SA(0, 1), cA + hstepA, voffA);
    if (wr == 1) PG8_BAR;
    PG8_WAIT_V(4); PG8_BAR;
    PG8_STAGE(PG8_SB(1, 0), cB + kstep, voffB); PG8_STAGE(PG8_SA(1, 0), cA + PG8_AKOFF(1), voffA); PG8_STAGE(PG8_SB(1, 1), cB + hstepB + kstep, voffB);
    PG8_WAIT_V(6); PG8_BAR;
    for (;;) {
        const bool has_next = S.next(ui + 1, nxt);
        const char* nA = has_next ? (const char*)g.A + (size_t)nxt.pm * tstepA : cA; const char* nB = has_next ? (const char*)g.Bt + (size_t)nxt.pn * tstepB : cB;
        for (int t = 0; t < nt; t += 2) {
            const bool last = (t == nt - 2);
            const char* a1 = cA + PG8_AKOFF(t + 1);
            const char* a2 = last ? nA : cA + PG8_AKOFF(t + 2); const char* b2 = last ? nB : cB + (size_t)(t + 2) * kstep;
            const char* a3 = last ? nA + PG8_AKOFF(1) : cA + PG8_AKOFF(t + 3); const char* b3 = b2 + kstep;
            PG8_LDB(B0, 0, 0); PG8_SCHED; PG8_LDA(At, 0, 0); PG8_STAGE(PG8_SA(1, 1), a1 + hstepA, voffA);
            PG8_WAIT_L(8); PG8_BAR; PG8_WAIT_L(0); PG8_MMA(0, 0, At, B0); PG8_BAR; PG8_SCHED;
            PG8_LDB(B1, 0, 1); PG8_STAGE(PG8_SB(0, 0), b2, voffB);
            PG8_BAR; PG8_WAIT_L(0); PG8_MMA(0, 1, At, B1); PG8_BAR;
            PG8_LDA(At, 0, 1); PG8_STAGE(PG8_SA(0, 0), a2, voffA);
            PG8_BAR; PG8_WAIT_L(0); PG8_MMA(1, 0, At, B0); PG8_BAR; PG8_SCHED;
            PG8_STAGE(PG8_SB(0, 1), b2 + hstepB, voffB);
            PG8_WAIT_V(6); PG8_BAR; PG8_MMA(1, 1, At, B1); PG8_BAR;
            PG8_LDB(B0, 1, 0); PG8_SCHED; PG8_LDA(At, 1, 0); PG8_STAGE(PG8_SA(0, 1), a2 + hstepA, voffA);
            PG8_WAIT_L(8); PG8_BAR; PG8_WAIT_L(0); PG8_MMA(0, 0, At, B0); PG8_BAR; PG8_SCHED;
            PG8_LDB(B1, 1, 1); PG8_STAGE(PG8_SB(1, 0), b3, voffB);
            PG8_BAR; PG8_WAIT_L(0); PG8_MMA(0, 1, At, B1); PG8_BAR;
            PG8_LDA(At, 1, 1); PG8_STAGE(PG8_SA(1, 0), a3, voffA);
            PG8_BAR; PG8_WAIT_L(0); PG8_MMA(1, 0, At, B0); PG8_BAR; PG8_SCHED;
            PG8_STAGE(PG8_SB(1, 1), b3 + hstepB, voffB);
            PG8_WAIT_V(6); PG8_BAR; PG8_MMA(1, 1, At, B1); PG8_BAR;
        }
        if (E.mode == 0) E.eb(acc, cur, wr, wc, fr, fq); else E.er(acc, cur, wr, wc, fr, fq);
        if (!has_next) break;
#pragma unroll
        for (int a = 0; a < 2; ++a)
#pragma unroll
            for (int b = 0; b < 2; ++b)
#pragma unroll
                for (int m = 0; m < 4; ++m)
#pragma unroll
                    for (int n = 0; n < 2; ++n) acc[a][b][m][n] = (f32x4){0.f, 0.f, 0.f, 0.f};
        cur = nxt; cA = nA; cB = nB; ++ui;
    }
    PG8_WAIT_V(0);
    if (wr == 0) PG8_BAR;
    PG8_BAR;
#undef PG8_AKOFF
#undef PG8_SA
#undef PG8_SB
#undef PG8_STAGE
#undef PG8_LDA
#undef PG8_LDB
#undef PG8_MMA
#undef PG8_WAIT_V
#undef PG8_WAIT_L
#undef PG8_BAR
#undef PG8_SCHED
}
}

__device__ __forceinline__ void tr_tile(LAS float* s, const float* src, int ld_src, int k0, int c0, bf16_t* dst, int ld_dst, int n0, const float* scale) {
    const int tid = otid();
    {
        const int r = tid >> 4, c4 = (tid & 15) * 4;
#pragma unroll
        for (int p = 0; p < 2; ++p) {
            const int rr = r + p * 32;
            f32x4 v = *(const f32x4*)(src + (size_t)(k0 + rr) * ld_src + c0 + c4);
            if (scale) { const float sc = scale[rr]; v = v * sc; }
            s[rr * 65 + c4 + 0] = v[0]; s[rr * 65 + c4 + 1] = v[1]; s[rr * 65 + c4 + 2] = v[2]; s[rr * 65 + c4 + 3] = v[3];
        }
    }
    __syncthreads();
    {
        const int n = tid >> 3, kq = (tid & 7) * 8;
        float v[8];
#pragma unroll
        for (int j = 0; j < 8; ++j) v[j] = s[(kq + j) * 65 + n];
        u32x4 w; w.x = cvt_pk_bf16(v[0], v[1]); w.y = cvt_pk_bf16(v[2], v[3]); w.z = cvt_pk_bf16(v[4], v[5]); w.w = cvt_pk_bf16(v[6], v[7]);
        *(u32x4*)(dst + (size_t)(n0 + n) * ld_dst + k0 + kq) = w;
    }
    __syncthreads();
}

__device__ __forceinline__ void convert_rows(const float* src, bf16_t* dst, size_t n_elems) {
    const size_t n8 = n_elems / 8;
    for (size_t i = (size_t)obid() * NTHREADS + otid(); i < n8; i += (size_t)gridDim.x * NTHREADS) {
        const f32x4 a = *(const f32x4*)(src + i * 8), b = *(const f32x4*)(src + i * 8 + 4);
        u32x4 w; w.x = cvt_pk_bf16(a[0], a[1]); w.y = cvt_pk_bf16(a[2], a[3]); w.z = cvt_pk_bf16(b[0], b[1]); w.w = cvt_pk_bf16(b[2], b[3]);
        *(u32x4*)(dst + i * 8) = w;
    }
}

__device__ __forceinline__ void ln_rows(const float* in, float* out, bf16_t* hb, const float* g, const float* bta) {
    const int lane = otid() & 63, wid = otid() >> 6;
    f32x4 gg[4], bb[4];
#pragma unroll
    for (int i = 0; i < 4; ++i) { gg[i] = ((const f32x4*)g)[lane + 64 * i]; bb[i] = ((const f32x4*)bta)[lane + 64 * i]; }
    for (int r = obid() * 8 + wid; r < T_TOK; r += gridDim.x * 8) {
        const f32x4* xr = (const f32x4*)(in + (size_t)r * DM);
        f32x4 v[4]; float s = 0.f;
#pragma unroll
        for (int i = 0; i < 4; ++i) { v[i] = xr[lane + 64 * i]; s += v[i][0] + v[i][1] + v[i][2] + v[i][3]; }
        s = wave_sum(s);
        const float mu = s * (1.f / DM);
        float q = 0.f;
#pragma unroll
        for (int i = 0; i < 4; ++i) { v[i] = v[i] - mu; q += v[i][0] * v[i][0] + v[i][1] * v[i][1] + v[i][2] * v[i][2] + v[i][3] * v[i][3]; }
        q = wave_sum(q);
        const float rs = rsqrtf(q * (1.f / DM) + LN_EPS);
        f32x4* orow = (f32x4*)(out + (size_t)r * DM);
        u32x2* hrow = (u32x2*)(hb + (size_t)r * DM);
#pragma unroll
        for (int i = 0; i < 4; ++i) {
            const f32x4 o = v[i] * rs * gg[i] + bb[i];
            orow[lane + 64 * i] = o;
            u32x2 w; w.x = cvt_pk_bf16(o[0], o[1]); w.y = cvt_pk_bf16(o[2], o[3]);
            hrow[lane + 64 * i] = w;
        }
    }
}

__device__ void phase_prep(const Params& P, LAS unsigned char* lds) {
    unsigned char* ws = P.ws;
    if (obid() == 0 && otid() < DEPTH) __hip_atomic_store((unsigned*)(ws + WS_CTL) + 64 * (1 + otid()), 0u, __ATOMIC_RELAXED, __HIP_MEMORY_SCOPE_AGENT);
    LAS float* s = (LAS float*)lds;
    const int n_win = 2 * 68 * 16, n_wout = 2 * 16 * 32, n_wq = 2 * 16 * 16, n_g = 2 * 8 * 2;
    const int total = n_win + n_wout + n_wq + n_g;
    for (int j = obid(); j < total; j += gridDim.x) {
        if (j < n_win) {
            const int l = j / (68 * 16), r = j % (68 * 16), nt = r / 16, kt = r % 16;
            const int n0 = nt * 64, c0 = n0 < 3584 ? n0 : n0 + 16;
            tr_tile(s, P.w_in + (size_t)l * 1024 * PROJ_LD, PROJ_LD, kt * 64, c0, (bf16_t*)(ws + WS_WIN) + (size_t)l * N_IN * 1024, 1024, n0, nullptr);
        } else if (j < n_win + n_wout) {
            const int jj = j - n_win, l = jj / (16 * 32), r = jj % (16 * 32), nt = r / 32, kt = r % 32;
            const int k0 = kt * 64;
            const float* sc = (k0 >= 512 && k0 < 1536) ? P.ssm_norm_g + l * 1024 + (k0 - 512) : nullptr;
            tr_tile(s, P.w_out + (size_t)l * MIXW * 1024, 1024, k0, nt * 64, (bf16_t*)(ws + WS_WOUT) + (size_t)l * 1024 * MIXW, MIXW, nt * 64, sc);
        } else if (j < n_win + n_wout + n_wq) {
            const int jj = j - n_win - n_wout, l = jj / 256, r = jj % 256, nt = r / 16, kt = r % 16;
            tr_tile(s, P.peer_wq + (size_t)l * 1024 * 1024, 1024, kt * 64, nt * 64, (bf16_t*)(ws + WS_WQ) + (size_t)l * 1024 * 1024, 1024, nt * 64, nullptr);
        } else {
            const int jj = j - n_win - n_wout - n_wq, which = jj / 16, lb = jj % 16;
            const float* src = (which ? P.rg_wx : P.rg_wa) + (size_t)lb * 4096;
            bf16_t* dst = (bf16_t*)(ws + (which ? WS_WX : WS_WA)) + (size_t)lb * 4096;
            tr_tile(s, src, 64, 0, 0, dst, 64, 0, nullptr);
        }
    }
    for (int i = obid() * NTHREADS + otid(); i < 2 * 16 * 1024; i += gridDim.x * NTHREADS) {
        const int l = i >> 14, j = (i >> 10) & 15, k = i & 1023;
        ((bf16_t*)(ws + WS_WDT))[i] = f2bf(P.w_in[((size_t)l * 1024 + k) * PROJ_LD + C_DT + j]);
    }
    convert_rows(P.peer_keys, (bf16_t*)(ws + WS_KEYS), (size_t)2 * 2 * 128 * 64);
    {
        const int lane = otid() & 63, wid = otid() >> 6;
        for (int r = obid() * 8 + wid; r < 2 * 2 * 16384; r += gridDim.x * 8) {
            const int which = r >> 15, row = r & 32767;
            const float* src = (which ? P.peer_v : P.peer_u) + (size_t)row * DM + lane * 16;
            f32x4 v[4]; float amax = 0.f;
#pragma unroll
            for (int i = 0; i < 4; ++i) { v[i] = *(const f32x4*)(src + 4 * i); amax = fmaxf(amax, fmaxf(fmaxf(fabsf(v[i][0]), fabsf(v[i][1])), fmaxf(fabsf(v[i][2]), fabsf(v[i][3])))); }
#pragma unroll
            for (int o = 32; o > 0; o >>= 1) amax = fmaxf(amax, __shfl_xor(amax, o));
            const float inv = amax > 0.f ? 448.f / amax : 0.f;
            u32x4 w;
#pragma unroll
            for (int i = 0; i < 4; ++i) { int d = 0; d = __builtin_amdgcn_cvt_pk_fp8_f32(v[i][0] * inv, v[i][1] * inv, d, false); d = __builtin_amdgcn_cvt_pk_fp8_f32(v[i][2] * inv, v[i][3] * inv, d, true); w[i] = (unsigned)d; }
            *(u32x4*)(ws + (which ? WS_V8 : WS_U8) + (size_t)row * DM + lane * 16) = w;
            if (lane == 0) ((float*)(ws + (which ? WS_SV : WS_SU)))[row] = amax * (1.f / 448.f);
        }
    }
    ln_rows(P.x, P.out, (bf16_t*)(ws + WS_HB), P.emb_g, P.emb_b);
}

__device__ void phase_dt(const Params& P, int layer) {
    const int lane = otid() & 63, wid = otid() >> 6;
    const bf16_t* hb = (const bf16_t*)(P.ws + WS_HB);
    const bf16_t* wdt = (const bf16_t*)(P.ws + WS_WDT) + (size_t)layer * 16 * 1024;
    float* DT = (float*)(P.ws + WS_DT);
    const float bias = P.ssm_dt_bias[layer * 16 + (lane & 15)];
    for (int task = obid() * 8 + wid; task < T_TOK / 16; task += gridDim.x * 8) {
        const int t0 = task * 16;
        f32x4 acc = {0.f, 0.f, 0.f, 0.f};
        const bf16_t* ap = hb + (size_t)(t0 + (lane & 15)) * DM + (lane >> 4) * 8;
        const bf16_t* bp = wdt + (size_t)(lane & 15) * DM + (lane >> 4) * 8;
#pragma unroll 8
        for (int ks = 0; ks < 32; ++ks) {
            const bf16x8 a = *(const bf16x8*)(ap + ks * 32), b = *(const bf16x8*)(bp + ks * 32);
            acc = MFMA16(a, b, acc);
        }
#pragma unroll
        for (int j = 0; j < 4; ++j) DT[(size_t)(t0 + (lane >> 4) * 4 + j) * 16 + (lane & 15)] = softplusf_(acc[j] + bias);
    }
}

__device__ void ssd_tile(const Params& P, int layer, int b, int h, LAS unsigned char* lds) {
    const int tid = otid(), lane = tid & 63, wid = tid >> 6, fr = lane & 15, fq = lane >> 4;
    bf16_t* proj = (bf16_t*)(P.ws + WS_PROJ);
    const float* DT = (const float*)(P.ws + WS_DT);
    float* SSQ = (float*)(P.ws + WS_SSQ);
    const int g = h >> 3;
    LAS bf16_t* sC = (LAS bf16_t*)lds;
    LAS bf16_t* sB = sC + 64 * 136;
    LAS bf16_t* sS = sB + 64 * 136;
    LAS bf16_t* sXH = sS + 64 * 136;
    LAS bf16_t* sXS = sXH + 64 * 72;
    LAS bf16_t* sXD = sXS + 64 * 72;
    LAS bf16_t* sM = sXD + 64 * 72;
    LAS float* sY = (LAS float*)(sM + 64 * 72);
    LAS float* sAcs = sY + 64 * 68;
    LAS float* sDt = sAcs + 64;
    const float a_h = -__expf(P.ssm_a_log[layer * 16 + h]);
    const float d_h = P.ssm_d[layer * 16 + h];
    const int cg = tid % 40, lrow = tid / 40;
    const bool cv_active = tid < 480;
    int ch0;
    if (cg < 8) ch0 = h * 64 + cg * 8; else if (cg < 24) ch0 = 1024 + g * 128 + (cg - 8) * 8; else ch0 = 1280 + g * 128 + (cg - 24) * 8;
    float cw[4][8], cb[8];
#pragma unroll
    for (int j = 0; j < 8; ++j) {
        cb[j] = P.ssm_conv_b[layer * 1536 + ch0 + j];
#pragma unroll
        for (int i = 0; i < 4; ++i) cw[i][j] = P.ssm_conv_w[(layer * 4 + i) * 1536 + ch0 + j];
    }
    for (int i = tid; i < 64 * 136 / 2; i += NTHREADS) ((LAS unsigned*)sS)[i] = 0u;
    f32x4 accS[4];
#pragma unroll
    for (int q = 0; q < 4; ++q) accS[q] = (f32x4){0.f, 0.f, 0.f, 0.f};
    __syncthreads();
    for (int c = 0; c < 64; ++c) {
        const int t0 = b * SEQ + c * 64;
        if (wid == 0) {
            const float dt = DT[(size_t)(t0 + lane) * 16 + h];
            float v = dt * a_h;
#pragma unroll
            for (int o = 1; o < 64; o <<= 1) { const float n = __shfl_up(v, o); if (lane >= o) v += n; }
            sDt[lane] = dt; sAcs[lane] = v;
        }
        __syncthreads();
        if (cv_active) {
            const float acs_end = sAcs[63];
            for (int l = lrow; l < 64; l += 12) {
                float v[8];
#pragma unroll
                for (int j = 0; j < 8; ++j) v[j] = cb[j];
#pragma unroll
                for (int i = 0; i < 4; ++i) {
                    const int pos = c * 64 + l - 3 + i;
                    if (pos >= 0) {
                        const u32x4 w = *(const u32x4*)(proj + (size_t)(b * SEQ + pos) * PROJ_LD + C_XBC + ch0);
                        v[0] += cw[i][0] * bflo(w.x); v[1] += cw[i][1] * bfhi(w.x); v[2] += cw[i][2] * bflo(w.y); v[3] += cw[i][3] * bfhi(w.y);
                        v[4] += cw[i][4] * bflo(w.z); v[5] += cw[i][5] * bfhi(w.z); v[6] += cw[i][6] * bflo(w.w); v[7] += cw[i][7] * bfhi(w.w);
                    }
                }
#pragma unroll
                for (int j = 0; j < 8; ++j) v[j] = siluf_(v[j]);
                u32x4 o; o.x = cvt_pk_bf16(v[0], v[1]); o.y = cvt_pk_bf16(v[2], v[3]); o.z = cvt_pk_bf16(v[4], v[5]); o.w = cvt_pk_bf16(v[6], v[7]);
                if (cg < 8) {
                    *(LAS u32x4*)(sXH + l * 72 + cg * 8) = o;
                    const float dt = sDt[l], dd = dt * __expf(acs_end - sAcs[l]);
                    u32x4 o2; o2.x = cvt_pk_bf16(v[0] * dt, v[1] * dt); o2.y = cvt_pk_bf16(v[2] * dt, v[3] * dt); o2.z = cvt_pk_bf16(v[4] * dt, v[5] * dt); o2.w = cvt_pk_bf16(v[6] * dt, v[7] * dt);
                    *(LAS u32x4*)(sXS + l * 72 + cg * 8) = o2;
                    u32x4 o3; o3.x = cvt_pk_bf16(v[0] * dd, v[1] * dd); o3.y = cvt_pk_bf16(v[2] * dd, v[3] * dd); o3.z = cvt_pk_bf16(v[4] * dd, v[5] * dd); o3.w = cvt_pk_bf16(v[6] * dd, v[7] * dd);
                    *(LAS u32x4*)(sXD + l * 72 + cg * 8) = o3;
                } else if (cg < 24) {
                    *(LAS u32x4*)(sB + l * 136 + (cg - 8) * 8) = o;
                } else {
                    *(LAS u32x4*)(sC + l * 136 + (cg - 24) * 8) = o;
                }
            }
        }
        __syncthreads();
        const int lt = wid >> 1, ph = wid & 1;
        f32x4 accY[2];
        {
            bf16x8 aC[4];
#pragma unroll
            for (int ks = 0; ks < 4; ++ks) aC[ks] = *(const LAS bf16x8*)(sC + (lt * 16 + fr) * 136 + ks * 32 + fq * 8);
#pragma unroll
            for (int tt = 0; tt < 2; ++tt) {
                const int st = ph * 2 + tt;
                f32x4 accG = {0.f, 0.f, 0.f, 0.f};
#pragma unroll
                for (int ks = 0; ks < 4; ++ks) { const bf16x8 bb = *(const LAS bf16x8*)(sB + (st * 16 + fr) * 136 + ks * 32 + fq * 8); accG = MFMA16(aC[ks], bb, accG); }
                const int s_idx = st * 16 + fr; const float acs_s = sAcs[s_idx];
#pragma unroll
                for (int j = 0; j < 4; ++j) {
                    const int l = lt * 16 + fq * 4 + j;
                    const float val = (s_idx <= l) ? accG[j] * __expf(sAcs[l] - acs_s) : 0.f;
                    sM[l * 72 + s_idx] = f2bf(val);
                }
            }
#pragma unroll
            for (int tt = 0; tt < 2; ++tt) {
                const int pt = ph * 2 + tt;
                f32x4 a = {0.f, 0.f, 0.f, 0.f};
#pragma unroll
                for (int ks = 0; ks < 4; ++ks) { const bf16x8 bb = *(const LAS bf16x8*)(sS + (pt * 16 + fr) * 136 + ks * 32 + fq * 8); a = MFMA16(aC[ks], bb, a); }
#pragma unroll
                for (int j = 0; j < 4; ++j) a[j] *= __expf(sAcs[lt * 16 + fq * 4 + j]);
                accY[tt] = a;
            }
        }
        __syncthreads();
        {
#pragma unroll
            for (int tt = 0; tt < 2; ++tt) {
                const int pt = ph * 2 + tt;
#pragma unroll
                for (int ks = 0; ks < 2; ++ks) {
                    const bf16x8 am = *(const LAS bf16x8*)(sM + (lt * 16 + fr) * 72 + ks * 32 + fq * 8);
                    bf16x8 bx;
#pragma unroll
                    for (int j = 0; j < 8; ++j) bx[j] = (short)sXS[(ks * 32 + fq * 8 + j) * 72 + pt * 16 + fr];
                    accY[tt] = MFMA16(am, bx, accY[tt]);
                }
#pragma unroll
                for (int j = 0; j < 4; ++j) sY[(lt * 16 + fq * 4 + j) * 68 + pt * 16 + fr] = accY[tt][j];
            }
            const float dec = __expf(sAcs[63]);
            const int pt2 = wid >> 1;
            bf16x8 ax[2];
#pragma unroll
            for (int ks = 0; ks < 2; ++ks)
#pragma unroll
                for (int j = 0; j < 8; ++j) ax[ks][j] = (short)sXD[(ks * 32 + fq * 8 + j) * 72 + pt2 * 16 + fr];
#pragma unroll
            for (int q = 0; q < 4; ++q) {
                const int nt = ph * 4 + q;
                f32x4 a = accS[q] * dec;
#pragma unroll
                for (int ks = 0; ks < 2; ++ks) {
                    bf16x8 bb;
#pragma unroll
                    for (int j = 0; j < 8; ++j) bb[j] = (short)sB[(ks * 32 + fq * 8 + j) * 136 + nt * 16 + fr];
                    a = MFMA16(ax[ks], bb, a);
                }
                accS[q] = a;
#pragma unroll
                for (int j = 0; j < 4; ++j) sS[(pt2 * 16 + fq * 4 + j) * 136 + nt * 16 + fr] = f2bf(a[j]);
            }
        }
        __syncthreads();
        {
            const int l = tid >> 3, p8 = (tid & 7) * 8;
            const size_t ga = (size_t)(t0 + l) * PROJ_LD + C_Z + h * 64 + p8;
            const u32x4 zw = *(const u32x4*)(proj + ga);
            const u32x4 xw = *(const LAS u32x4*)(sXH + l * 72 + p8);
            const f32x4 y0 = *(const LAS f32x4*)(sY + l * 68 + p8), y1 = *(const LAS f32x4*)(sY + l * 68 + p8 + 4);
            float y[8];
            y[0] = (y0[0] + d_h * bflo(xw.x)) * siluf_(bflo(zw.x)); y[1] = (y0[1] + d_h * bfhi(xw.x)) * siluf_(bfhi(zw.x));
            y[2] = (y0[2] + d_h * bflo(xw.y)) * siluf_(bflo(zw.y)); y[3] = (y0[3] + d_h * bfhi(xw.y)) * siluf_(bfhi(zw.y));
            y[4] = (y1[0] + d_h * bflo(xw.z)) * siluf_(bflo(zw.z)); y[5] = (y1[1] + d_h * bfhi(xw.z)) * siluf_(bfhi(zw.z));
            y[6] = (y1[2] + d_h * bflo(xw.w)) * siluf_(bflo(zw.w)); y[7] = (y1[3] + d_h * bfhi(xw.w)) * siluf_(bfhi(zw.w));
            float q = 0.f;
#pragma unroll
            for (int j = 0; j < 8; ++j) q += y[j] * y[j];
            q += __shfl_xor(q, 1); q += __shfl_xor(q, 2); q += __shfl_xor(q, 4);
            if ((tid & 7) == 0) SSQ[(size_t)(t0 + l) * 16 + h] = q;
            u32x4 o; o.x = cvt_pk_bf16(y[0], y[1]); o.y = cvt_pk_bf16(y[2], y[3]); o.z = cvt_pk_bf16(y[4], y[5]); o.w = cvt_pk_bf16(y[6], y[7]);
            *(u32x4*)(proj + ga) = o;
        }
        __syncthreads();
    }
}

__device__ void rglru_tile(const Params& P, int layer, int b, int n, LAS unsigned char* lds) {
    const int tid = otid(), lane = tid & 63, wid = tid >> 6, fr = lane & 15, fq = lane >> 4;
    bf16_t* proj = (bf16_t*)(P.ws + WS_PROJ);
    LAS bf16_t* sXC = (LAS bf16_t*)lds;
    LAS bf16_t* sWa = sXC + 64 * 72;
    LAS bf16_t* sWx = sWa + 64 * 72;
    LAS float* sXCf = (LAS float*)(sWx + 64 * 72);
    LAS float* sA = sXCf + 64 * 64;
    LAS float* sU = sA + 64 * 64;
    LAS float* sPs = sU + 64 * 64;
    LAS float* sHs = sPs + 8 * 64;
    LAS float* sCar = sHs + 8 * 64;
    {
        const int d = tid >> 3, c8 = (tid & 7) * 8;
        const bf16_t* wa = (const bf16_t*)(P.ws + WS_WA) + (size_t)(layer * 8 + n) * 4096;
        const bf16_t* wx = (const bf16_t*)(P.ws + WS_WX) + (size_t)(layer * 8 + n) * 4096;
        *(LAS u32x4*)(sWa + d * 72 + c8) = *(const u32x4*)(wa + d * 64 + c8);
        *(LAS u32x4*)(sWx + d * 72 + c8) = *(const u32x4*)(wx + d * 64 + c8);
    }
    if (tid < 64) sCar[tid] = 0.f;
    const int cg = tid & 7, crow = tid >> 3, ch0 = n * 64 + cg * 8;
    float cw[4][8], cb[8];
#pragma unroll
    for (int j = 0; j < 8; ++j) {
        cb[j] = P.rg_conv_b[layer * 512 + ch0 + j];
#pragma unroll
        for (int i = 0; i < 4; ++i) cw[i][j] = P.rg_conv_w[(layer * 4 + i) * 512 + ch0 + j];
    }
    const int tt = wid & 3, dpair = wid >> 2;
    float ba[2], bx[2], sp[2];
#pragma unroll
    for (int dd = 0; dd < 2; ++dd) {
        const int ch = layer * 512 + n * 64 + (dpair * 2 + dd) * 16 + fr;
        ba[dd] = P.rg_ba[ch]; bx[dd] = P.rg_bx[ch]; sp[dd] = softplusf_(-P.rg_lambda[ch]);
    }
    const int sc = tid & 63, seg = wid;
    __syncthreads();
    for (int c = 0; c < 64; ++c) {
        const int t0 = b * SEQ + c * 64;
        {
            float v[8];
#pragma unroll
            for (int j = 0; j < 8; ++j) v[j] = cb[j];
#pragma unroll
            for (int i = 0; i < 4; ++i) {
                const int pos = c * 64 + crow - 3 + i;
                if (pos >= 0) {
                    const u32x4 w = *(const u32x4*)(proj + (size_t)(b * SEQ + pos) * PROJ_LD + C_RGX + ch0);
                    v[0] += cw[i][0] * bflo(w.x); v[1] += cw[i][1] * bfhi(w.x); v[2] += cw[i][2] * bflo(w.y); v[3] += cw[i][3] * bfhi(w.y);
                    v[4] += cw[i][4] * bflo(w.z); v[5] += cw[i][5] * bfhi(w.z); v[6] += cw[i][6] * bflo(w.w); v[7] += cw[i][7] * bfhi(w.w);
                }
            }
            *(LAS f32x4*)(sXCf + crow * 64 + cg * 8) = (f32x4){v[0], v[1], v[2], v[3]};
            *(LAS f32x4*)(sXCf + crow * 64 + cg * 8 + 4) = (f32x4){v[4], v[5], v[6], v[7]};
            u32x4 o; o.x = cvt_pk_bf16(v[0], v[1]); o.y = cvt_pk_bf16(v[2], v[3]); o.z = cvt_pk_bf16(v[4], v[5]); o.w = cvt_pk_bf16(v[6], v[7]);
            *(LAS u32x4*)(sXC + crow * 72 + cg * 8) = o;
        }
        __syncthreads();
        {
            bf16x8 ax[2];
#pragma unroll
            for (int ks = 0; ks < 2; ++ks) ax[ks] = *(const LAS bf16x8*)(sXC + (tt * 16 + fr) * 72 + ks * 32 + fq * 8);
#pragma unroll
            for (int dd = 0; dd < 2; ++dd) {
                const int dt_ = dpair * 2 + dd;
                f32x4 accA = {0.f, 0.f, 0.f, 0.f}, accX = {0.f, 0.f, 0.f, 0.f};
#pragma unroll
                for (int ks = 0; ks < 2; ++ks) {
                    const bf16x8 wa = *(const LAS bf16x8*)(sWa + (dt_ * 16 + fr) * 72 + ks * 32 + fq * 8);
                    const bf16x8 wx = *(const LAS bf16x8*)(sWx + (dt_ * 16 + fr) * 72 + ks * 32 + fq * 8);
                    accA = MFMA16(ax[ks], wa, accA); accX = MFMA16(ax[ks], wx, accX);
                }
#pragma unroll
                for (int j = 0; j < 4; ++j) {
                    const int t = tt * 16 + fq * 4 + j, d = dt_ * 16 + fr;
                    const float r = sigmoidf_(accA[j] + ba[dd]), ig = sigmoidf_(accX[j] + bx[dd]);
                    const float log_a = -8.f * r * sp[dd];
                    const float a = __expf(log_a);
                    const float mult = sqrtf(fmaxf(-expm1f(2.f * log_a), 0.f));
                    sA[t * 64 + d] = a;
                    sU[t * 64 + d] = mult * ig * sXCf[t * 64 + d];
                }
            }
        }
        __syncthreads();
        {
            float Pl = 1.f, Hl = 0.f;
#pragma unroll
            for (int i = 0; i < 8; ++i) { const float a = sA[(seg * 8 + i) * 64 + sc], u = sU[(seg * 8 + i) * 64 + sc]; Hl = a * Hl + u; Pl *= a; }
            sPs[seg * 64 + sc] = Pl; sHs[seg * 64 + sc] = Hl;
        }
        __syncthreads();
        float H = sCar[sc];
        for (int s2 = 0; s2 < seg; ++s2) H = sPs[s2 * 64 + sc] * H + sHs[s2 * 64 + sc];
#pragma unroll
        for (int i = 0; i < 8; ++i) {
            const int t = seg * 8 + i;
            H = sA[t * 64 + sc] * H + sU[t * 64 + sc];
            const size_t ga = (size_t)(t0 + t) * PROJ_LD + C_GATE + n * 64 + sc;
            const float gate = bf2f(proj[ga]);
            proj[ga] = f2bf(gelu_tanhf_(gate) * H);
        }
        __syncthreads();
        if (seg == 7) sCar[sc] = H;
    }
    __syncthreads();
}

__device__ void attn_tile(const Params& P, int layer, int b, int qb, int kvh, LAS unsigned char* lds) {
    const int tid = otid(), lane = tid & 63, wid = tid >> 6, fr = lane & 15, fq = lane >> 4;
    bf16_t* proj = (bf16_t*)(P.ws + WS_PROJ);
    LAS bf16_t* sK = (LAS bf16_t*)lds;
    LAS bf16_t* sVT = sK + 256 * 72;
    LAS bf16_t* sP = sVT + 64 * 280 + wid * (16 * 168);
    const int tb = b * SEQ + qb * 128;
#pragma unroll
    for (int it = 0; it < 4; ++it) {
        const int idx = it * NTHREADS + tid;
        { const int kk = idx >> 3, dg = idx & 7;
          u32x4 v = {0u, 0u, 0u, 0u};
          if (qb > 0 || kk >= 128) v = *(const u32x4*)(proj + (size_t)(tb - 128 + kk) * PROJ_LD + C_K + kvh * 64 + dg * 8);
          *(LAS u32x4*)(sK + kk * 72 + dg * 8) = v; }
        { const int kk = idx & 255, dg = idx >> 8;
          u32x4 v = {0u, 0u, 0u, 0u};
          if (qb > 0 || kk >= 128) v = *(const u32x4*)(proj + (size_t)(tb - 128 + kk) * PROJ_LD + C_V + kvh * 64 + dg * 8);
          const unsigned wv[4] = {v.x, v.y, v.z, v.w};
#pragma unroll
          for (int j = 0; j < 4; ++j) { sVT[(dg * 8 + 2 * j) * 280 + kk] = (bf16_t)(wv[j] & 0xffffu); sVT[(dg * 8 + 2 * j + 1) * 280 + kk] = (bf16_t)(wv[j] >> 16); } }
    }
    if (tid < 192) { const int d = tid / 3, part = tid % 3; *(LAS u32x4*)(sVT + d * 280 + 256 + part * 8) = (u32x4){0u, 0u, 0u, 0u}; }
    __syncthreads();
    const int q0 = wid * 16;
    for (int r = 0; r < 4; ++r) {
        const int hq = kvh * 4 + r;
        const float sink = P.attn_sinks[layer * 8 + hq];
        bf16x8 qf[2];
#pragma unroll
        for (int ks = 0; ks < 2; ++ks) qf[ks] = *(const bf16x8*)(proj + (size_t)(tb + q0 + fr) * PROJ_LD + C_Q + hq * 64 + ks * 32 + fq * 8);
        f32x4 S[9];
#pragma unroll
        for (int kt = 0; kt < 9; ++kt) {
            f32x4 a = {0.f, 0.f, 0.f, 0.f};
#pragma unroll
            for (int ks = 0; ks < 2; ++ks) { const bf16x8 kf = *(const LAS bf16x8*)(sK + ((wid + kt) * 16 + fr) * 72 + ks * 32 + fq * 8); a = MFMA16(qf[ks], kf, a); }
            S[kt] = a;
        }
        float mx[4], sm[4];
#pragma unroll
        for (int j = 0; j < 4; ++j) mx[j] = -INFINITY;
#pragma unroll
        for (int kt = 0; kt < 9; ++kt)
#pragma unroll
            for (int j = 0; j < 4; ++j) {
                const int qi = q0 + fq * 4 + j, kk = (wid + kt) * 16 + fr, kj = kk - 128;
                const bool valid = (kj <= qi) && (kj > qi - 128) && (qb > 0 || kk >= 128);
                const float s = valid ? S[kt][j] * 0.125f : -INFINITY;
                S[kt][j] = s; mx[j] = fmaxf(mx[j], s);
            }
#pragma unroll
        for (int j = 0; j < 4; ++j) {
            float m = mx[j];
            m = fmaxf(m, __shfl_xor(m, 1)); m = fmaxf(m, __shfl_xor(m, 2)); m = fmaxf(m, __shfl_xor(m, 4)); m = fmaxf(m, __shfl_xor(m, 8));
            mx[j] = fmaxf(m, sink); sm[j] = 0.f;
        }
#pragma unroll
        for (int kt = 0; kt < 9; ++kt)
#pragma unroll
            for (int j = 0; j < 4; ++j) { const float p = __expf(S[kt][j] - mx[j]); S[kt][j] = p; sm[j] += p; }
#pragma unroll
        for (int j = 0; j < 4; ++j) {
            float s = sm[j];
            s += __shfl_xor(s, 1); s += __shfl_xor(s, 2); s += __shfl_xor(s, 4); s += __shfl_xor(s, 8);
            sm[j] = 1.f / (s + __expf(sink - mx[j]));
        }
#pragma unroll
        for (int kt = 0; kt < 9; ++kt)
#pragma unroll
            for (int j = 0; j < 4; ++j) sP[(fq * 4 + j) * 168 + kt * 16 + fr] = f2bf(S[kt][j] * sm[j]);
#pragma unroll
        for (int j = 0; j < 4; ++j) sP[(fq * 4 + j) * 168 + 144 + fr] = 0;
        f32x4 O[4];
#pragma unroll
        for (int dt_ = 0; dt_ < 4; ++dt_) O[dt_] = (f32x4){0.f, 0.f, 0.f, 0.f};
#pragma unroll
        for (int ks = 0; ks < 5; ++ks) {
            const bf16x8 pa = *(const LAS bf16x8*)(sP + fr * 168 + ks * 32 + fq * 8);
#pragma unroll
            for (int dt_ = 0; dt_ < 4; ++dt_) { const bf16x8 vb = *(const LAS bf16x8*)(sVT + (dt_ * 16 + fr) * 280 + wid * 16 + ks * 32 + fq * 8); O[dt_] = MFMA16(pa, vb, O[dt_]); }
        }
#pragma unroll
        for (int dt_ = 0; dt_ < 4; ++dt_)
#pragma unroll
            for (int j = 0; j < 4; ++j) proj[(size_t)(tb + q0 + fq * 4 + j) * PROJ_LD + C_Q + hq * 64 + dt_ * 16 + fr] = f2bf(O[dt_][j]);
    }
    __syncthreads();
}

__device__ void phase_mixers(const Params& P, int layer, LAS unsigned char* lds) {
    unsigned* ctr = (unsigned*)(P.ws + WS_CTL) + 64 * (1 + layer);
    LAS int* sTile = (LAS int*)(lds + LDS_BYTES - 16);
    for (;;) {
        if (otid() == 0) *sTile = (int)atomicAdd(ctr, 1u);
        __syncthreads();
        const int tile = *sTile;
        __syncthreads();
        if (tile >= 256 + 128 + 1024) break;
        if (tile < 256) { if (MIX_MASK & 1) ssd_tile(P, layer, tile >> 4, tile & 15, lds); }
        else if (tile < 384) { const int j = tile - 256; if (MIX_MASK & 2) rglru_tile(P, layer, j >> 3, j & 7, lds); }
        else { const int j = tile - 384; if (MIX_MASK & 4) attn_tile(P, layer, j >> 6, (j >> 1) & 31, j & 1, lds); }
    }
}

__device__ void phase_ssdnorm(const Params& P) {
    bf16_t* proj = (bf16_t*)(P.ws + WS_PROJ);
    const float* SSQ = (const float*)(P.ws + WS_SSQ);
    for (size_t i = (size_t)obid() * NTHREADS + otid(); i < (size_t)T_TOK * 128; i += (size_t)gridDim.x * NTHREADS) {
        const size_t t = i >> 7; const int c8 = (int)(i & 127) * 8, g = c8 >> 9;
        const f32x4 s0 = *(const f32x4*)(SSQ + t * 16 + g * 8), s1 = *(const f32x4*)(SSQ + t * 16 + g * 8 + 4);
        const float ss = s0[0] + s0[1] + s0[2] + s0[3] + s1[0] + s1[1] + s1[2] + s1[3];
        const float sc = rsqrtf(ss * (1.f / 512.f) + LN_EPS);
        u32x4* p = (u32x4*)(proj + t * PROJ_LD + C_Z + c8);
        const u32x4 w = *p;
        u32x4 o; o.x = cvt_pk_bf16(bflo(w.x) * sc, bfhi(w.x) * sc); o.y = cvt_pk_bf16(bflo(w.y) * sc, bfhi(w.y) * sc);
        o.z = cvt_pk_bf16(bflo(w.z) * sc, bfhi(w.z) * sc); o.w = cvt_pk_bf16(bflo(w.w) * sc, bfhi(w.w) * sc);
        *p = o;
    }
}

__device__ __forceinline__ unsigned mono_(float f) { const unsigned u = __float_as_uint(f); return (u & 0x80000000u) ? ~u : (u | 0x80000000u); }
__device__ __forceinline__ float unmono_(unsigned u) { return __uint_as_float((u & 0x80000000u) ? (u ^ 0x80000000u) : ~u); }

__device__ void phase_peer_topk(const Params& P, int layer, LAS unsigned char* lds) {
    const int tid = otid(), lane = tid & 63, wid = tid >> 6, fr = lane & 15, fq = lane >> 4;
    const bf16_t* QP = (const bf16_t*)(P.ws + WS_QP);
    const bf16_t* keys = (const bf16_t*)(P.ws + WS_KEYS) + (size_t)layer * 2 * 128 * 64;
    int* IDX = (int*)(P.ws + WS_IDX);
    float* GATE = (float*)(P.ws + WS_GATE);
    LAS float* sSc = (LAS float*)lds;
    LAS unsigned* sTop = (LAS unsigned*)lds;
    for (int tile = obid(); tile < T_TOK / 32; tile += gridDim.x) {
        const int tok0 = tile * 32;
        unsigned top[16];
#pragma unroll
        for (int k = 0; k < 16; ++k) top[k] = 0u;
        for (int ps = 0; ps < 2; ++ps) {
#pragma unroll
            for (int i = 0; i < 2; ++i)
#pragma unroll
                for (int mt = 0; mt < 2; ++mt) {
                    bf16x8 a[2];
#pragma unroll
                    for (int ks = 0; ks < 2; ++ks) a[ks] = *(const bf16x8*)(QP + (size_t)(tok0 + mt * 16 + fr) * DM + wid * 128 + i * 64 + ks * 32 + fq * 8);
#pragma unroll
                    for (int nt = 0; nt < 4; ++nt) {
                        f32x4 acc = {0.f, 0.f, 0.f, 0.f};
#pragma unroll
                        for (int ks = 0; ks < 2; ++ks) { const bf16x8 kb = *(const bf16x8*)(keys + (size_t)(i * 128 + ps * 64 + nt * 16 + fr) * 64 + ks * 32 + fq * 8); acc = MFMA16(a[ks], kb, acc); }
#pragma unroll
                        for (int j = 0; j < 4; ++j) sSc[((wid * 2 + i) * 32 + mt * 16 + fq * 4 + j) * 65 + nt * 16 + fr] = acc[j];
                    }
                }
            __syncthreads();
            for (int k = 0; k < 64; ++k) {
                const float s = sSc[tid * 65 + k];
                unsigned x = (mono_(s) & ~0x7Fu) | (unsigned)(127 - (ps * 64 + k));
#pragma unroll
                for (int q = 0; q < 16; ++q) { const unsigned hi = umax_(top[q], x); x = umin_(top[q], x); top[q] = hi; }
            }
            __syncthreads();
        }
#pragma unroll
        for (int q = 0; q < 4; ++q) *(LAS u32x4*)(sTop + tid * 16 + q * 4) = (u32x4){top[q * 4], top[q * 4 + 1], top[q * 4 + 2], top[q * 4 + 3]};
        __syncthreads();
        if (tid < 256) {
            const int token = tid & 31, h = tid >> 5;
            const int row1 = (h * 2) * 32 + token, row2 = (h * 2 + 1) * 32 + token;
            float s1[16], s2[16];
#pragma unroll
            for (int q = 0; q < 4; ++q) {
                const u32x4 a = *(const LAS u32x4*)(sTop + row1 * 16 + q * 4), bq = *(const LAS u32x4*)(sTop + row2 * 16 + q * 4);
#pragma unroll
                for (int e = 0; e < 4; ++e) { s1[q * 4 + e] = unmono_(a[e] & ~0x7Fu); s2[q * 4 + e] = unmono_(bq[e] & ~0x7Fu); }
            }
            unsigned best[16];
#pragma unroll
            for (int k = 0; k < 16; ++k) best[k] = 0u;
#pragma unroll
            for (int a = 0; a < 16; ++a)
#pragma unroll
                for (int bb = 0; bb < 16; ++bb) {
                    if ((a + 1) * (bb + 1) <= 16) {
                        unsigned x = (mono_(s1[a] + s2[bb]) & ~0xFFu) | (unsigned)(255 - (a * 16 + bb));
#pragma unroll
                        for (int q = 0; q < 16; ++q) { const unsigned hi = umax_(best[q], x); x = umin_(best[q], x); best[q] = hi; }
                    }
                }
            float val[16], gsum = 0.f;
            const float vmax = unmono_(best[0] & ~0xFFu);
#pragma unroll
            for (int k = 0; k < 16; ++k) { val[k] = __expf(unmono_(best[k] & ~0xFFu) - vmax); gsum += val[k]; }
            const float ginv = 1.f / gsum;
            const size_t ob = (size_t)(tok0 + token) * 128 + h * 16;
#pragma unroll
            for (int k = 0; k < 16; ++k) {
                const int code = 255 - (int)(best[k] & 0xFFu), a = code >> 4, bb = code & 15;
                const int i1 = 127 - (int)(sTop[row1 * 16 + a] & 0x7Fu), i2 = 127 - (int)(sTop[row2 * 16 + bb] & 0x7Fu);
                IDX[ob + k] = i1 * 128 + i2;
                GATE[ob + k] = val[k] * ginv;
            }
        }
        __syncthreads();
    }
}

#define PEER_NB 4
#define PEER_LOAD(UU, VV, E0) do { _Pragma("unroll") for (int q_ = 0; q_ < PEER_NB; ++q_) { \
        const int e_ = (E0) + q_; const int idx_ = __builtin_amdgcn_readlane((e_ < 64) ? my_i0 : my_i1, e_ & 63); \
        UU[q_] = *(const u32x4*)(U8 + (size_t)idx_ * DM + lane * 16); VV[q_] = *(const u32x4*)(V8 + (size_t)idx_ * DM + lane * 16); } } while (0)
#define PEER_COMPUTE(UU, VV, E0) do { _Pragma("unroll") for (int q_ = 0; q_ < PEER_NB; ++q_) { \
        const int e_ = (E0) + q_; float d_ = 0.f; \
        _Pragma("unroll") for (int i_ = 0; i_ < 4; ++i_) { const f32x2 lo_ = __builtin_amdgcn_cvt_pk_f32_fp8((int)UU[q_][i_], false), hi_ = __builtin_amdgcn_cvt_pk_f32_fp8((int)UU[q_][i_], true); \
            d_ += lo_[0] * xf[4 * i_] + lo_[1] * xf[4 * i_ + 1]; d_ += hi_[0] * xf[4 * i_ + 2] + hi_[1] * xf[4 * i_ + 3]; } \
        d_ = wave_sum_dpp(d_) * rdlane((e_ < 64) ? my_su0 : my_su1, e_ & 63); \
        const float w_ = rdlane((e_ < 64) ? my_g0 : my_g1, e_ & 63) * gelu_cdf_(d_); \
        _Pragma("unroll") for (int i_ = 0; i_ < 4; ++i_) { const f32x2 lo_ = __builtin_amdgcn_cvt_pk_f32_fp8((int)VV[q_][i_], false), hi_ = __builtin_amdgcn_cvt_pk_f32_fp8((int)VV[q_][i_], true); \
            acc[4 * i_] += w_ * lo_[0]; acc[4 * i_ + 1] += w_ * lo_[1]; acc[4 * i_ + 2] += w_ * hi_[0]; acc[4 * i_ + 3] += w_ * hi_[1]; } } } while (0)
__device__ void phase_peer_experts(const Params& P, int layer) {
    const int lane = otid() & 63, wid = otid() >> 6;
    bf16_t* hb = (bf16_t*)(P.ws + WS_HB);
    const unsigned char* U8 = P.ws + WS_U8 + (size_t)layer * 16384 * 1024;
    const unsigned char* V8 = P.ws + WS_V8 + (size_t)layer * 16384 * 1024;
    const float* SU = (const float*)(P.ws + WS_SU) + layer * 16384;
    const float* SV = (const float*)(P.ws + WS_SV) + layer * 16384;
    const int* IDX = (const int*)(P.ws + WS_IDX);
    const float* GATE = (const float*)(P.ws + WS_GATE);
    const float* g = P.ln2_g + layer * DM; const float* bta = P.ln2_b + layer * DM;
    for (int t = obid() * 8 + wid; t < T_TOK; t += gridDim.x * 8) {
        float xf[16];
        {
            const u32x4 xa = *(const u32x4*)(hb + (size_t)t * DM + lane * 16), xb = *(const u32x4*)(hb + (size_t)t * DM + lane * 16 + 8);
#pragma unroll
            for (int i = 0; i < 4; ++i) { xf[2 * i] = bflo(xa[i]); xf[2 * i + 1] = bfhi(xa[i]); xf[8 + 2 * i] = bflo(xb[i]); xf[8 + 2 * i + 1] = bfhi(xb[i]); }
        }
        const int my_i0 = IDX[(size_t)t * 128 + lane], my_i1 = IDX[(size_t)t * 128 + 64 + lane];
        const float my_su0 = SU[my_i0], my_su1 = SU[my_i1];
        const float my_g0 = GATE[(size_t)t * 128 + lane] * SV[my_i0], my_g1 = GATE[(size_t)t * 128 + 64 + lane] * SV[my_i1];
        float acc[16];
#pragma unroll
        for (int j = 0; j < 16; ++j) acc[j] = 0.f;
        u32x4 UA[PEER_NB], VA[PEER_NB], UB[PEER_NB], VB[PEER_NB];
        PEER_LOAD(UA, VA, 0);
        for (int e0 = 0; e0 < 128; e0 += 2 * PEER_NB) {
            PEER_LOAD(UB, VB, e0 + PEER_NB);
            PEER_COMPUTE(UA, VA, e0);
            if (e0 + 2 * PEER_NB < 128) PEER_LOAD(UA, VA, e0 + 2 * PEER_NB);
            PEER_COMPUTE(UB, VB, e0 + PEER_NB);
        }
        float* hrow = P.out + (size_t)t * DM + lane * 16;
        float y[16];
#pragma unroll
        for (int i = 0; i < 4; ++i) { const f32x4 h4 = *(const f32x4*)(hrow + 4 * i);
#pragma unroll
            for (int j = 0; j < 4; ++j) y[4 * i + j] = DN_ALPHA * h4[j] + acc[4 * i + j]; }
        float sm = 0.f;
#pragma unroll
        for (int j = 0; j < 16; ++j) sm += y[j];
        sm = wave_sum_dpp(sm);
        const float mu = sm * (1.f / DM);
        float qv = 0.f;
#pragma unroll
        for (int j = 0; j < 16; ++j) { y[j] -= mu; qv += y[j] * y[j]; }
        qv = wave_sum_dpp(qv);
        const float rs = rsqrtf(qv * (1.f / DM) + LN_EPS);
        u32x4 w0, w1;
#pragma unroll
        for (int i = 0; i < 4; ++i) {
            const f32x4 g4 = *(const f32x4*)(g + lane * 16 + 4 * i), b4 = *(const f32x4*)(bta + lane * 16 + 4 * i);
            f32x4 o;
#pragma unroll
            for (int j = 0; j < 4; ++j) o[j] = y[4 * i + j] * rs * g4[j] + b4[j];
            *(f32x4*)(hrow + 4 * i) = o;
            const unsigned p0 = cvt_pk_bf16(o[0], o[1]), p1 = cvt_pk_bf16(o[2], o[3]);
            if (i == 0) { w0.x = p0; w0.y = p1; } else if (i == 1) { w0.z = p0; w0.w = p1; } else if (i == 2) { w1.x = p0; w1.y = p1; } else { w1.z = p0; w1.w = p1; }
        }
        *(u32x4*)(hb + (size_t)t * DM + lane * 16) = w0; *(u32x4*)(hb + (size_t)t * DM + lane * 16 + 8) = w1;
    }
}
#undef PEER_LOAD
#undef PEER_COMPUTE

constexpr int N_PHASES = 1 + 8 * DEPTH;
__global__ void __launch_bounds__(NTHREADS, 2) fwd_megakernel(Params P) {
    extern __shared__ __attribute__((aligned(16))) unsigned char lds_raw[];
    LAS unsigned char* lds = (LAS unsigned char*)lds_raw;
    cg::grid_group grid = cg::this_grid();
    unsigned char* ws = P.ws;
#ifdef DEBUG_COPY
    const int ph_end = P.ph_hi + 1;
#else
    const int ph_end = P.ph_hi;
#endif
    for (int ph = P.ph_lo; ph < ph_end; ++ph) {
        if (ph > P.ph_lo) {
            asm volatile("s_waitcnt vmcnt(0)" ::: "memory");
            __syncthreads();
            grid.sync();
            if (otid() < 64) { __builtin_amdgcn_fence(__ATOMIC_ACQUIRE, "agent"); asm volatile("s_waitcnt vmcnt(0)" ::: "memory"); }
            __syncthreads();
        }
        if (ph == 0) { phase_prep(P, lds); continue; }
#ifdef DEBUG_COPY
        if (ph == P.ph_hi) {
            const bf16_t* proj = (const bf16_t*)(ws + WS_PROJ);
            const float* DTp = (const float*)(ws + WS_DT);
            for (size_t i = (size_t)obid() * NTHREADS + otid(); i < (size_t)T_TOK * 1024; i += (size_t)gridDim.x * NTHREADS) {
                const size_t t = i >> 10; const int c = (int)(i & 1023);
                float v;
                if (c < 256) v = bf2f(proj[t * PROJ_LD + C_K + c]);
                else if (c < 1008) v = bf2f(proj[t * PROJ_LD + C_XBC + (c - 256) * 2]);
                else v = DTp[t * 16 + (c - 1008)];
                P.out[i] = v;
            }
            continue;
        }
#endif
        const int layer = (ph - 1) / 8, sub = (ph - 1) % 8;
        if (sub == 0 || sub == 3 || sub == 5) {
            pg8::Gemm g; pg8::Epi E; int N;
            if (sub == 0) {
                g = pg8::Gemm{(const bf16_t*)(ws + WS_HB), (const bf16_t*)(ws + WS_WIN) + (size_t)layer * N_IN * 1024, T_TOK, N_IN, 1024, 1024, 1 << 30, 0};
                E.mode = 0; E.eb = pg8::EpiBf16{(bf16_t*)(ws + WS_PROJ), PROJ_LD, 3584, (size_t)3600}; E.er = pg8::EpiResF32{nullptr, 0, 0.f}; N = N_IN;
            } else if (sub == 3) {
                g = pg8::Gemm{(const bf16_t*)(ws + WS_PROJ) + C_GATE, (const bf16_t*)(ws + WS_WOUT) + (size_t)layer * 1024 * MIXW, T_TOK, 1024, MIXW, PROJ_LD, 24, (C_Q - (C_GATE + 1536)) * 2};
                E.mode = 1; E.eb = pg8::EpiBf16{nullptr, 0, 0, (size_t)0}; E.er = pg8::EpiResF32{P.out, DM, DN_ALPHA}; N = 1024;
            } else {
                g = pg8::Gemm{(const bf16_t*)(ws + WS_HB), (const bf16_t*)(ws + WS_WQ) + (size_t)layer * 1024 * 1024, T_TOK, 1024, 1024, 1024, 1 << 30, 0};
                E.mode = 0; E.eb = pg8::EpiBf16{(bf16_t*)(ws + WS_QP), DM, 0, (size_t)0}; E.er = pg8::EpiResF32{nullptr, 0, 0.f}; N = 1024;
            }
            pg8::StaticOrder S; S.init(T_TOK, N, (int)gridDim.x, (int)obid());
            __syncthreads();
            pg8::gemm_phase(lds, g, S, E);
            if (sub == 0) phase_dt(P, layer);
        } else if (sub == 1) {
#ifndef SKIP_MIX
            phase_mixers(P, layer, lds);
#endif
        } else if (sub == 2) {
            phase_ssdnorm(P);
        } else if (sub == 4) {
            ln_rows(P.out, P.out, (bf16_t*)(ws + WS_HB), P.ln1_g + layer * DM, P.ln1_b + layer * DM);
        } else if (sub == 6) {
            phase_peer_topk(P, layer, lds);
        } else {
            phase_peer_experts(P, layer);
        }
    }
}

extern "C" void kernel_launch(void* const* d_in, const int* in_sizes, int n_in, void* d_out, int out_size, void* d_ws, size_t ws_size, hipStream_t stream) {
    static int grid_blocks = 0;
    if (grid_blocks == 0) {
        if (n_in != 27 || out_size != T_TOK * DM || ws_size < WS_END) { fprintf(stderr, "kernel_launch: unexpected shapes (n_in %d out %d ws %zu need %zu)\n", n_in, out_size, ws_size, (size_t)WS_END); grid_blocks = -1; return; }
        int dev = 0, cus = 0, per_cu = 0;
        hipGetDevice(&dev);
        hipDeviceGetAttribute(&cus, hipDeviceAttributeMultiprocessorCount, dev);
        if (hipFuncSetAttribute((const void*)fwd_megakernel, hipFuncAttributeMaxDynamicSharedMemorySize, LDS_BYTES) != hipSuccess) { fprintf(stderr, "kernel_launch: hipFuncSetAttribute failed\n"); grid_blocks = -1; return; }
        hipOccupancyMaxActiveBlocksPerMultiprocessor(&per_cu, (const void*)fwd_megakernel, NTHREADS, LDS_BYTES);
        if (per_cu < 1) { fprintf(stderr, "kernel_launch: occupancy query says %d blocks per CU\n", per_cu); grid_blocks = -1; return; }
        grid_blocks = cus;
    }
    if (grid_blocks < 0) return;
    hipMemsetAsync((char*)d_ws + WS_CTL, 0, 65536, stream);
    Params p{};
    const float** pp = (const float**)&p;
    for (int i = 0; i < 27; ++i) pp[i] = (const float*)d_in[i];
    p.out = (float*)d_out; p.ws = (unsigned char*)d_ws; p.ph_lo = 0; p.ph_hi = PH_HI;
    void* args[] = {&p};
    hipError_t e = hipLaunchCooperativeKernel((const void*)fwd_megakernel, dim3(grid_blocks), dim3(NTHREADS), args, LDS_BYTES, stream);
    if (e != hipSuccess) fprintf(stderr, "cooperative launch failed: %s (grid %d)\n", hipGetErrorString(e), grid_blocks);
}
```

```cpp
#include <hip/hip_runtime.h>
#include <hip/hip_cooperative_groups.h>
#include <cstdio>
#include <cstdint>
namespace cg = cooperative_groups;
#ifndef PH_HI
#define PH_HI N_PHASES
#endif
#ifdef TS_SUB
#ifndef TS_AMP
#define TS_AMP 4
#endif
#endif
#ifndef FP8_IN
#define FP8_IN 0
#endif
#ifndef FP8_OUT
#define FP8_OUT 0
#endif
#ifndef FP8_Q
#define FP8_Q 0
#endif
#ifndef MIX_MASK
#define MIX_MASK 7
#endif

#define LAS __attribute__((address_space(3)))
typedef unsigned short bf16_t;
typedef short bf16x8 __attribute__((ext_vector_type(8)));
typedef float f32x4 __attribute__((ext_vector_type(4)));
typedef float f32x2 __attribute__((ext_vector_type(2)));
typedef unsigned u32x4 __attribute__((ext_vector_type(4)));
typedef unsigned u32x2 __attribute__((ext_vector_type(2)));
using bf16x2v = __attribute__((ext_vector_type(2))) __bf16;

constexpr int T_TOK = 65536, DM = 1024, SEQ = 4096, NBATCH = 16, DEPTH = 2;
constexpr int PROJ_LD = 4368;
constexpr int C_RGX = 0, C_GATE = 512, C_Z = 1024, C_XBC = 2048, C_DT = 3584, C_Q = 3600, C_K = 4112, C_V = 4240;
constexpr int N_IN = 4352;
constexpr int MIXW = 2048;
constexpr float DN_ALPHA = 1.41421356237f;
constexpr float LN_EPS = 1e-5f;
constexpr int NTHREADS = 512;
constexpr int LDS_BYTES = 147456;

constexpr size_t WS_CTL  = 0;
constexpr size_t WS_WIN  = 65536;
constexpr size_t WS_WDT  = WS_WIN  + (size_t)2 * N_IN * 1024 * 2;
constexpr size_t WS_WOUT = WS_WDT  + (size_t)2 * 16 * 1024 * 2;
constexpr size_t WS_WQ   = WS_WOUT + (size_t)2 * 1024 * 2048 * 2;
constexpr size_t WS_KEYS = WS_WQ   + (size_t)2 * 1024 * 1024 * 2;
constexpr size_t WS_WA   = WS_KEYS + (size_t)2 * 2 * 128 * 64 * 2;
constexpr size_t WS_WX   = WS_WA   + (size_t)2 * 8 * 64 * 64 * 2;
constexpr size_t WS_U    = WS_WX   + (size_t)2 * 8 * 64 * 64 * 2;
constexpr size_t WS_V    = WS_U    + (size_t)2 * 16384 * 1024 * 2;
constexpr size_t WS_HB   = WS_V    + (size_t)2 * 16384 * 1024 * 2;
constexpr size_t WS_DT   = WS_HB   + (size_t)T_TOK * 1024 * 2;
constexpr size_t WS_SSQ  = WS_DT   + (size_t)T_TOK * 16 * 4;
constexpr size_t WS_PROJ = WS_SSQ  + (size_t)T_TOK * 16 * 4;
constexpr size_t WS_PEND = WS_PROJ + (size_t)T_TOK * PROJ_LD * 2;
constexpr size_t WS_HB8  = WS_PEND;
constexpr size_t WS_WIN8 = WS_HB8 + (size_t)T_TOK * 1024;
constexpr size_t WS_WQ8  = WS_WIN8 + (size_t)2 * N_IN * 1024;
constexpr size_t WS_WOUT8 = WS_WQ8 + (size_t)2 * 1024 * 1024;
constexpr size_t WS_END  = WS_WOUT8 + (size_t)2 * 1024 * MIXW;
constexpr size_t WS_U8 = WS_U, WS_SU = WS_U + (size_t)2 * 16384 * 1024;
constexpr size_t WS_V8 = WS_V, WS_SV = WS_V + (size_t)2 * 16384 * 1024;
constexpr size_t WS_QP   = WS_PROJ;
constexpr size_t WS_IDX  = WS_QP  + (size_t)T_TOK * 1024 * 2;
constexpr size_t WS_GATE = WS_IDX + (size_t)T_TOK * 128 * 4;
constexpr size_t WS_PD   = WS_GATE + (size_t)T_TOK * 128 * 4;
constexpr size_t WS_STAT = WS_PD + (size_t)T_TOK * 8 * 128 * 4;
static_assert(WS_STAT + (size_t)T_TOK * 8 * 2 * 4 <= WS_PEND, "PEER buffers must fit inside the proj region");
static_assert(WS_END <= ((size_t)1 << 30), "workspace must fit 1 GiB");
constexpr int CTLW_QE1 = 5120, CTLW_QE3 = 6144;

struct Params {
    const float* x; const float* emb_g; const float* emb_b; const float* w_in; const float* rg_conv_w; const float* rg_conv_b;
    const float* rg_wa; const float* rg_ba; const float* rg_wx; const float* rg_bx; const float* rg_lambda;
    const float* ssm_conv_w; const float* ssm_conv_b; const float* ssm_dt_bias; const float* ssm_a_log; const float* ssm_d; const float* ssm_norm_g;
    const float* attn_sinks; const float* w_out; const float* ln1_g; const float* ln1_b;
    const float* peer_wq; const float* peer_keys; const float* peer_u; const float* peer_v; const float* ln2_g; const float* ln2_b;
    float* out; unsigned char* ws; int ph_lo, ph_hi;
};

typedef __bf16 bf16x2n __attribute__((ext_vector_type(2)));
__device__ __forceinline__ unsigned cvt_pk_bf16(float lo, float hi) { const f32x2 v = {lo, hi}; const bf16x2n r = __builtin_convertvector(v, bf16x2n); return __builtin_bit_cast(unsigned, r); }
__device__ __forceinline__ bf16_t f2bf(float f) { return (bf16_t)(cvt_pk_bf16(f, 0.f) & 0xffffu); }
__device__ __forceinline__ float bf2f(bf16_t b) { return __uint_as_float(((unsigned)b) << 16); }
__device__ __forceinline__ float bflo(unsigned w) { return __uint_as_float(w << 16); }
__device__ __forceinline__ float bfhi(unsigned w) { return __uint_as_float(w & 0xffff0000u); }
__device__ __forceinline__ float sigmoidf_(float x) { return 1.f / (1.f + __expf(-x)); }
__device__ __forceinline__ float siluf_(float x) { return x / (1.f + __expf(-x)); }
__device__ __forceinline__ float softplusf_(float x) { return x > 20.f ? x : log1pf(__expf(x)); }
__device__ __forceinline__ float gelu_tanhf_(float x) { const float u = 0.7978845608028654f * (x + 0.044715f * x * x * x); const float t = 1.f - 2.f / (__expf(2.f * u) + 1.f); return 0.5f * x * (1.f + t); }
__device__ __forceinline__ float gelu_erff_(float x) { return 0.5f * x * (1.f + erff(x * 0.70710678118654752f)); }
__device__ __forceinline__ float wave_sum(float v) {
#pragma unroll
    for (int o = 32; o > 0; o >>= 1) v += __shfl_xor(v, o);
    return v;
}
template <int CTRL> __device__ __forceinline__ float dpp_(float x) { return __builtin_bit_cast(float, __builtin_amdgcn_mov_dpp(__builtin_bit_cast(int, x), CTRL, 0xf, 0xf, true)); }
__device__ __forceinline__ float row_sum16(float x) { x += dpp_<0xB1>(x); x += dpp_<0x4E>(x); x += dpp_<0x141>(x); x += dpp_<0x128>(x); return x; }
__device__ __forceinline__ float rdlane(float x, int l) { return __builtin_bit_cast(float, __builtin_amdgcn_readlane(__builtin_bit_cast(int, x), l)); }
__device__ __forceinline__ float wave_sum_dpp(float x) { x = row_sum16(x); return (rdlane(x, 0) + rdlane(x, 16)) + (rdlane(x, 32) + rdlane(x, 48)); }
__device__ __forceinline__ float gelu_cdf_(float v) {
    const float av = fabsf(v), t = __builtin_amdgcn_rcpf(av * 0.2316418882f + 1.0f);
    float q = t * 0.5307027145f + (-0.7265760135f); q = q * t + 0.7107068705f; q = q * t + (-0.142248368f); q = q * t + 0.127414796f; q = q * t;
    const float e = __builtin_amdgcn_exp2f(v * v * (-0.72134752044f));
    const float m = v * (q * e), r = v - m;
    return v < 0.f ? m : r;
}
__device__ __forceinline__ float dot2bf(unsigned a, unsigned b, float acc) { return __builtin_amdgcn_fdot2_f32_bf16(__builtin_bit_cast(bf16x2v, a), __builtin_bit_cast(bf16x2v, b), acc, false); }
__device__ __forceinline__ unsigned umax_(unsigned a, unsigned b) { return a > b ? a : b; }
__device__ __forceinline__ unsigned umin_(unsigned a, unsigned b) { return a < b ? a : b; }
__device__ __forceinline__ u32x2 cvt8_fp8(const float* v, float sc) {
    int a = 0, b = 0;
    a = __builtin_amdgcn_cvt_pk_fp8_f32(v[0] * sc, v[1] * sc, a, false); a = __builtin_amdgcn_cvt_pk_fp8_f32(v[2] * sc, v[3] * sc, a, true);
    b = __builtin_amdgcn_cvt_pk_fp8_f32(v[4] * sc, v[5] * sc, b, false); b = __builtin_amdgcn_cvt_pk_fp8_f32(v[6] * sc, v[7] * sc, b, true);
    u32x2 r; r.x = (unsigned)a; r.y = (unsigned)b; return r;
}
__device__ __forceinline__ int otid() { int t = (int)threadIdx.x; asm volatile("" : "+v"(t)); return t; }
__device__ __forceinline__ int obid() { int b = (int)blockIdx.x; asm volatile("" : "+s"(b)); return b; }
#define MFMA16(a, b, c) __builtin_amdgcn_mfma_f32_16x16x32_bf16((a), (b), (c), 0, 0, 0)

#define XB_TMO      128
#define XB_XCNT(j)  (256  + 64 * (j))
#define XB_XSUB(j)  (1280 + 64 * (j))
#define XB_XGEN(j)  (2304 + 64 * (j))
#define XB_TOP      3328
#define XB_TOPGEN   3392
#define XCD_BAR_WORDS 3456
#define XB_SPIN_CAP (1u << 22)
__device__ __forceinline__ unsigned xb_ld(unsigned* p)              { return __hip_atomic_load(p, __ATOMIC_RELAXED, __HIP_MEMORY_SCOPE_AGENT); }
__device__ __forceinline__ unsigned xb_add(unsigned* p, unsigned v) { return __hip_atomic_fetch_add(p, v, __ATOMIC_RELAXED, __HIP_MEMORY_SCOPE_AGENT); }
__device__ __forceinline__ unsigned xb_xcc_id() { return (unsigned)__builtin_amdgcn_s_getreg((3 << 11) | 20) & 0xFu; }
#define XB_SPIN(cond, bar) do { unsigned _sp = 0; while (cond) { __builtin_amdgcn_s_sleep(1); \
    if ((++_sp & 255u) == 0u) { if (xb_ld(&(bar)[XB_TMO])) break; if (_sp > XB_SPIN_CAP) { atomicAdd(&(bar)[XB_TMO], 1u); break; } } } } while (0)
struct XcdBarrier { unsigned* bar; unsigned x; volatile LAS unsigned* st; };
__device__ __forceinline__ XcdBarrier xcd_barrier_post(unsigned* bar, volatile LAS unsigned* st) {
    XcdBarrier b; b.bar = bar; b.x = xb_xcc_id(); b.st = st;
    if (otid() == 0) (void)xb_add(&bar[XB_XCNT(b.x)], 1u);
    return b;
}
__device__ __forceinline__ void xcd_barrier_complete(unsigned* bar, unsigned x, unsigned& nloc, unsigned& nx) {
    const unsigned G = gridDim.x * gridDim.y * gridDim.z;
    unsigned sum, cnt, mine, sp = 0u;
    for (;;) {
        sum = 0u; cnt = 0u; mine = 0u;
#pragma unroll
        for (unsigned j = 0; j < 16; ++j) { const unsigned c = xb_ld(&bar[XB_XCNT(j)]); sum += c; cnt += (c > 0u) ? 1u : 0u; mine = (j == x) ? c : mine; }
        if (sum == G) break;
        __builtin_amdgcn_s_sleep(1);
        if ((++sp & 255u) == 0u) { if (xb_ld(&bar[XB_TMO])) break; if (sp > XB_SPIN_CAP) { atomicAdd(&bar[XB_TMO], 1u); break; } }
    }
    nloc = mine > 0u ? mine : 1u; nx = cnt > 0u ? cnt : 1u;
}
__device__ __forceinline__ void xcd_barrier(const XcdBarrier& b) {
    asm volatile("s_waitcnt vmcnt(0)" ::: "memory");
    __syncthreads();
    if (otid() == 0) {
        unsigned* bar = b.bar;
        __builtin_amdgcn_s_waitcnt(0);
        unsigned nloc = b.st[0], nx = b.st[1];
        if (nloc == 0u) { xcd_barrier_complete(bar, b.x, nloc, nx); b.st[0] = nloc; b.st[1] = nx; }
        const unsigned old = xb_add(&bar[XB_XSUB(b.x)], 1u);
        const unsigned gen = old / nloc;
        if (old + 1u == (gen + 1u) * nloc) {
            __builtin_amdgcn_fence(__ATOMIC_RELEASE, "agent");
            asm volatile("s_waitcnt vmcnt(0)" ::: "memory");
            const unsigned og = xb_add(&bar[XB_TOP], 1u);
            const unsigned tg = og / nx;
            if (og + 1u == (tg + 1u) * nx) xb_add(&bar[XB_TOPGEN], 1u);
            else XB_SPIN(xb_ld(&bar[XB_TOPGEN]) == tg, bar);
            __builtin_amdgcn_fence(__ATOMIC_ACQUIRE, "agent");
            xb_add(&bar[XB_XGEN(b.x)], 1u);
            asm volatile("s_waitcnt vmcnt(0)" ::: "memory");
        } else {
            XB_SPIN(xb_ld(&bar[XB_XGEN(b.x)]) == gen, bar);
            __builtin_amdgcn_fence(__ATOMIC_ACQUIRE, "agent");
            asm volatile("s_waitcnt vmcnt(0)" ::: "memory");
        }
    }
    __syncthreads();
}

namespace pg8 {
typedef int v8i32_t __attribute__((ext_vector_type(8)));
typedef int v4i32_t __attribute__((ext_vector_type(4)));
constexpr int BM = 256, BK = 64, HALF = 128, HTB = HALF * BK * 2, STAGE_BYTES = 8 * HTB, NXCD = 8, WGM = 4;
__device__ __forceinline__ int lds_byte(int r, int c) { const int st = (r >> 4) * 2 + (c >> 5), rr = r & 15, cc = c & 31, ob = rr * 64 + cc * 2; return st * 1024 + (ob ^ (((ob >> 9) & 1) << 5)); }
__device__ __forceinline__ void stage_rc(int b, int& R, int& C) { const int st = b / 1024, sb = b % 1024, swz = sb ^ (((sb >> 9) & 1) << 5); R = (st >> 1) * 16 + swz / 64; C = (st & 1) * 32 + (swz % 64) / 2; }
__device__ __forceinline__ int perm32(int rho) { const int n = rho >> 4, i = rho & 15; return 8 * (i >> 2) + 4 * n + (i & 3); }
struct Unit { int pm, pn; };
struct Gemm { const bf16_t* A; const bf16_t* Bt; int M, N, K, lda, ksplit, kextra; };
struct StaticOrder {
    int nM, nN, nwg, G, c;
    __device__ void init(int M, int N, int G_, int c_) { nM = M / BM; nN = N / BM; nwg = nM * nN; G = G_; c = c_; }
    __device__ bool next(int i, Unit& u) const {
        const long L = (long)i * G + c; if (L >= nwg) return false;
        int wgid = (int)L; { const int q = nwg / NXCD, r = nwg % NXCD, xcd = wgid % NXCD, off = wgid / NXCD; wgid = (xcd < r ? xcd * (q + 1) : r * (q + 1) + (xcd - r) * q) + off; }
        const int nig = WGM * nN, gid = wgid / nig, fm = gid * WGM, gsz = (nM - fm) < WGM ? (nM - fm) : WGM;
        u.pm = fm + ((wgid % nig) % gsz); u.pn = (wgid % nig) / gsz; return true;
    }
};
struct EpiBf16 {
    static constexpr bool PERM = true;
    bf16_t* O; int ldc; int split_cols; size_t split_stride; float oscale;
    __device__ __forceinline__ void operator()(const f32x4 (&acc)[2][2][4][2], const Unit& u, int wr, int wc, int fr, int fq) const {
        const int row0 = u.pm * BM + wr * 64 + fr; int colt = u.pn * BM; bf16_t* base = O;
        if (split_cols) { const int t = colt / split_cols; base += (size_t)t * split_stride; colt -= t * split_cols; }
        const int col0 = colt + wc * 32 + 8 * fq;
#pragma unroll
        for (int ai = 0; ai < 2; ++ai)
#pragma unroll
            for (int m = 0; m < 4; ++m) { bf16_t* rowp = base + (size_t)(row0 + ai * HALF + m * 16) * ldc + col0;
#pragma unroll
                for (int bj = 0; bj < 2; ++bj) { const f32x4 v0 = acc[ai][bj][m][0] * oscale, v1 = acc[ai][bj][m][1] * oscale;
                    u32x4 w; w.x = cvt_pk_bf16(v0[0], v0[1]); w.y = cvt_pk_bf16(v0[2], v0[3]); w.z = cvt_pk_bf16(v1[0], v1[1]); w.w = cvt_pk_bf16(v1[2], v1[3]);
                    *(u32x4*)(rowp + bj * HALF) = w; } }
    }
};
struct EpiResBf16 {
    bf16_t* H; int ldc; float alpha; float oscale;
    __device__ __forceinline__ void operator()(const f32x4 (&acc)[2][2][4][2], const Unit& u, int wr, int wc, int fr, int fq) const {
        const int row0 = u.pm * BM + wr * 64 + fr, col0 = u.pn * BM + wc * 32 + 8 * fq;
#pragma unroll
        for (int ai = 0; ai < 2; ++ai)
#pragma unroll
            for (int m = 0; m < 4; ++m) { bf16_t* rowp = H + (size_t)(row0 + ai * HALF + m * 16) * ldc + col0;
#pragma unroll
                for (int bj = 0; bj < 2; ++bj) { u32x4* p = (u32x4*)(rowp + bj * HALF); const u32x4 h = *p; const f32x4 v0 = acc[ai][bj][m][0] * oscale, v1 = acc[ai][bj][m][1] * oscale;
                    u32x4 w; w.x = cvt_pk_bf16(alpha * bflo(h.x) + v0[0], alpha * bfhi(h.x) + v0[1]); w.y = cvt_pk_bf16(alpha * bflo(h.y) + v0[2], alpha * bfhi(h.y) + v0[3]);
                    w.z = cvt_pk_bf16(alpha * bflo(h.z) + v1[0], alpha * bfhi(h.z) + v1[1]); w.w = cvt_pk_bf16(alpha * bflo(h.w) + v1[2], alpha * bfhi(h.w) + v1[3]);
                    *p = w; } }
    }
};
struct Epi {
    int mode; EpiBf16 eb; EpiResBf16 er;
};
template <bool FP8>
__device__ __forceinline__ void gemm_phase(LAS unsigned char* lds, const Gemm g, const StaticOrder& S, const Epi& E) {
    const int tid = otid(), wid = __builtin_amdgcn_readfirstlane(tid >> 6), lane = tid & 63, wr = wid >> 2, wc = wid & 3, fr = lane & 15, fq = lane >> 4;
    const int K = g.K, nt = K / BK, lda = g.lda;
    unsigned voffA[2], voffB[2];
#pragma unroll
    for (int i = 0; i < 2; ++i) { int R, C; stage_rc(tid * 16 + i * 8192, R, C); const int Rb = (R & ~31) + perm32(R & 31);
        voffA[i] = (unsigned)(R * lda + C) * 2u; voffB[i] = (unsigned)(Rb * K + C) * 2u; }
    const size_t kstep = (size_t)(BK * 2);
    const size_t hstepA = (size_t)HALF * lda * 2, hstepB = (size_t)HALF * K * 2;
    const size_t tstepA = 2 * hstepA, tstepB = 2 * hstepB;
    const int ksplit = g.ksplit; const size_t kextra = (size_t)g.kextra;
#define PG8_AKOFF(t) ((size_t)(t) * kstep + (((t) >= ksplit) ? kextra : (size_t)0))
    const unsigned ldsw = (unsigned)wid * 1024u;
    const int aoff = lds_byte(wr * 64 + fr, fq * 8), boff = lds_byte(wc * 32 + fr, fq * 8);
#define PG8_SA(b, h) (((b) * 2 + (h)) * HTB)
#define PG8_SB(b, h) ((4 + (b) * 2 + (h)) * HTB)
#define PG8_STAGE(bufoff, gbase, voff) do { _Pragma("unroll") for (int _i = 0; _i < 2; ++_i) \
        __builtin_amdgcn_global_load_lds((const unsigned*)((const char*)(gbase) + (voff)[_i]), (LAS unsigned*)(lds + (bufoff) + ldsw + _i * 8192), 16, 0, 0); } while (0)
#define PG8_LDA(dst, b, h) do { _Pragma("unroll") for (int m = 0; m < 4; ++m) dst[m] = __builtin_shufflevector(*(const LAS v4i32_t*)(lds + PG8_SA(b, h) + aoff + m * 2048), *(const LAS v4i32_t*)(lds + PG8_SA(b, h) + aoff + m * 2048 + 1024), 0, 1, 2, 3, 4, 5, 6, 7); } while (0)
#define PG8_LDB(dst, b, h) do { _Pragma("unroll") for (int n = 0; n < 2; ++n) dst[n] = __builtin_shufflevector(*(const LAS v4i32_t*)(lds + PG8_SB(b, h) + boff + n * 2048), *(const LAS v4i32_t*)(lds + PG8_SB(b, h) + boff + n * 2048 + 1024), 0, 1, 2, 3, 4, 5, 6, 7); } while (0)
#define PG8_MMA8(ai, bj, At, Bt) do { __builtin_amdgcn_s_setprio(1); _Pragma("unroll") for (int m = 0; m < 4; ++m) _Pragma("unroll") for (int n = 0; n < 2; ++n) \
        asm volatile("s_nop 1\n\tv_mfma_scale_f32_16x16x128_f8f6f4 %0, %1, %2, %0, %3, %3 op_sel_hi:[0,0,0]" : "+v"(acc[ai][bj][m][n]) : "v"(Bt[n]), "v"(At[m]), "v"(mxscale)); \
        __builtin_amdgcn_s_setprio(0); } while (0)
#define PG8_MMA16(ai, bj, At, Bt) do { __builtin_amdgcn_s_setprio(1); _Pragma("unroll") for (int m = 0; m < 4; ++m) _Pragma("unroll") for (int n = 0; n < 2; ++n) { \
        acc[ai][bj][m][n] = __builtin_amdgcn_mfma_f32_16x16x32_bf16(__builtin_bit_cast(bf16x8, __builtin_shufflevector(Bt[n], Bt[n], 0, 1, 2, 3)), __builtin_bit_cast(bf16x8, __builtin_shufflevector(At[m], At[m], 0, 1, 2, 3)), acc[ai][bj][m][n], 0, 0, 0); \
        acc[ai][bj][m][n] = __builtin_amdgcn_mfma_f32_16x16x32_bf16(__builtin_bit_cast(bf16x8, __builtin_shufflevector(Bt[n], Bt[n], 4, 5, 6, 7)), __builtin_bit_cast(bf16x8, __builtin_shufflevector(At[m], At[m], 4, 5, 6, 7)), acc[ai][bj][m][n], 0, 0, 0); } \
        __builtin_amdgcn_s_setprio(0); } while (0)
#define PG8_MM(ai, bj, At, Bt) do { if (FP8) PG8_MMA8(ai, bj, At, Bt); else PG8_MMA16(ai, bj, At, Bt); } while (0)
#define PG8_WAIT_V(n) asm volatile("s_waitcnt vmcnt(" #n ")" ::: "memory")
#define PG8_WAIT_L(n) asm volatile("s_waitcnt lgkmcnt(" #n ")" ::: "memory")
#define PG8_BAR __builtin_amdgcn_s_barrier()
#define PG8_SCHED __builtin_amdgcn_sched_barrier(0)
    Unit cur, nxt; int ui = 0;
    if (!S.next(0, cur)) return;
    f32x4 acc[2][2][4][2];
#pragma unroll
    for (int a = 0; a < 2; ++a)
#pragma unroll
        for (int b = 0; b < 2; ++b)
#pragma unroll
            for (int m = 0; m < 4; ++m)
#pragma unroll
                for (int n = 0; n < 2; ++n) acc[a][b][m][n] = (f32x4){0.f, 0.f, 0.f, 0.f};
    v8i32_t At[4], B0[2], B1[2];
    const int mxscale = 0x7F7F7F7F;
    const char* cA = (const char*)g.A + (size_t)cur.pm * tstepA; const char* cB = (const char*)g.Bt + (size_t)cur.pn * tstepB;
    PG8_STAGE(PG8_SB(0, 0), cB, voffB); PG8_STAGE(PG8_SA(0, 0), cA, voffA); PG8_STAGE(PG8_SB(0, 1), cB + hstepB, voffB); PG8_STAGE(PG8_SA(0, 1), cA + hstepA, voffA);
    if (wr == 1) PG8_BAR;
    PG8_WAIT_V(4); PG8_BAR;
    PG8_STAGE(PG8_SB(1, 0), cB + kstep, voffB); PG8_STAGE(PG8_SA(1, 0), cA + PG8_AKOFF(1), voffA); PG8_STAGE(PG8_SB(1, 1), cB + hstepB + kstep, voffB);
    PG8_WAIT_V(6); PG8_BAR;
    for (;;) {
        const bool has_next = S.next(ui + 1, nxt);
        const char* nA = has_next ? (const char*)g.A + (size_t)nxt.pm * tstepA : cA; const char* nB = has_next ? (const char*)g.Bt + (size_t)nxt.pn * tstepB : cB;
        for (int t = 0; t < nt; t += 2) {
            const bool last = (t == nt - 2);
            const char* a1 = cA + PG8_AKOFF(t + 1);
            const char* a2 = last ? nA : cA + PG8_AKOFF(t + 2); const char* b2 = last ? nB : cB + (size_t)(t + 2) * kstep;
            const char* a3 = last ? nA + PG8_AKOFF(1) : cA + PG8_AKOFF(t + 3); const char* b3 = b2 + kstep;
            PG8_LDB(B0, 0, 0); PG8_SCHED; PG8_LDA(At, 0, 0); PG8_STAGE(PG8_SA(1, 1), a1 + hstepA, voffA);
            PG8_WAIT_L(8); PG8_BAR; PG8_WAIT_L(0); PG8_MM(0, 0, At, B0); PG8_BAR; PG8_SCHED;
            PG8_LDB(B1, 0, 1); PG8_STAGE(PG8_SB(0, 0), b2, voffB);
            PG8_BAR; PG8_WAIT_L(0); PG8_MM(0, 1, At, B1); PG8_BAR;
            PG8_LDA(At, 0, 1); PG8_STAGE(PG8_SA(0, 0), a2, voffA);
            PG8_BAR; PG8_WAIT_L(0); PG8_MM(1, 0, At, B0); PG8_BAR; PG8_SCHED;
            PG8_STAGE(PG8_SB(0, 1), b2 + hstepB, voffB);
            PG8_WAIT_V(6); PG8_BAR; PG8_MM(1, 1, At, B1); PG8_BAR;
            PG8_LDB(B0, 1, 0); PG8_SCHED; PG8_LDA(At, 1, 0); PG8_STAGE(PG8_SA(0, 1), a2 + hstepA, voffA);
            PG8_WAIT_L(8); PG8_BAR; PG8_WAIT_L(0); PG8_MM(0, 0, At, B0); PG8_BAR; PG8_SCHED;
            PG8_LDB(B1, 1, 1); PG8_STAGE(PG8_SB(1, 0), b3, voffB);
            PG8_BAR; PG8_WAIT_L(0); PG8_MM(0, 1, At, B1); PG8_BAR;
            PG8_LDA(At, 1, 1); PG8_STAGE(PG8_SA(1, 0), a3, voffA);
            PG8_BAR; PG8_WAIT_L(0); PG8_MM(1, 0, At, B0); PG8_BAR; PG8_SCHED;
            PG8_STAGE(PG8_SB(1, 1), b3 + hstepB, voffB);
            PG8_WAIT_V(6); PG8_BAR; PG8_MM(1, 1, At, B1); PG8_BAR;
        }
        asm volatile("s_nop 15\n\ts_nop 15" ::: "memory");
        if (E.mode == 0) E.eb(acc, cur, wr, wc, fr, fq); else E.er(acc, cur, wr, wc, fr, fq);
        if (!has_next) break;
#pragma unroll
        for (int a = 0; a < 2; ++a)
#pragma unroll
            for (int b = 0; b < 2; ++b)
#pragma unroll
                for (int m = 0; m < 4; ++m)
#pragma unroll
                    for (int n = 0; n < 2; ++n) acc[a][b][m][n] = (f32x4){0.f, 0.f, 0.f, 0.f};
        cur = nxt; cA = nA; cB = nB; ++ui;
    }
    PG8_WAIT_V(0);
    if (wr == 0) PG8_BAR;
    PG8_BAR;
#undef PG8_AKOFF
#undef PG8_SA
#undef PG8_SB
#undef PG8_STAGE
#undef PG8_LDA
#undef PG8_LDB
#undef PG8_MMA8
#undef PG8_MMA16
#undef PG8_MM
#undef PG8_WAIT_V
#undef PG8_WAIT_L
#undef PG8_BAR
#undef PG8_SCHED
}
}

__device__ __forceinline__ void tr_tile(LAS float* s, const float* src, int ld_src, int k0, int c0, bf16_t* dst, int ld_dst, int n0, const float* scale, unsigned char* dst8 = nullptr, float sc8 = 32.f) {
    const int tid = otid();
    {
        const int r = tid >> 4, c4 = (tid & 15) * 4;
#pragma unroll
        for (int p = 0; p < 2; ++p) {
            const int rr = r + p * 32;
            f32x4 v = *(const f32x4*)(src + (size_t)(k0 + rr) * ld_src + c0 + c4);
            if (scale) { const float sc = scale[rr]; v = v * sc; }
            s[rr * 65 + c4 + 0] = v[0]; s[rr * 65 + c4 + 1] = v[1]; s[rr * 65 + c4 + 2] = v[2]; s[rr * 65 + c4 + 3] = v[3];
        }
    }
    __syncthreads();
    {
        const int n = tid >> 3, kq = (tid & 7) * 8;
        float v[8];
#pragma unroll
        for (int j = 0; j < 8; ++j) v[j] = s[(kq + j) * 65 + n];
        u32x4 w; w.x = cvt_pk_bf16(v[0], v[1]); w.y = cvt_pk_bf16(v[2], v[3]); w.z = cvt_pk_bf16(v[4], v[5]); w.w = cvt_pk_bf16(v[6], v[7]);
        *(u32x4*)(dst + (size_t)(n0 + n) * ld_dst + k0 + kq) = w;
        if (dst8) *(u32x2*)(dst8 + (size_t)(n0 + n) * ld_dst + k0 + kq) = cvt8_fp8(v, sc8);
    }
    __syncthreads();
}

__device__ __forceinline__ void convert_rows(const float* src, bf16_t* dst, size_t n_elems) {
    const size_t n8 = n_elems / 8;
    for (size_t i = (size_t)obid() * NTHREADS + otid(); i < n8; i += (size_t)gridDim.x * NTHREADS) {
        const f32x4 a = *(const f32x4*)(src + i * 8), b = *(const f32x4*)(src + i * 8 + 4);
        u32x4 w; w.x = cvt_pk_bf16(a[0], a[1]); w.y = cvt_pk_bf16(a[2], a[3]); w.z = cvt_pk_bf16(b[0], b[1]); w.w = cvt_pk_bf16(b[2], b[3]);
        *(u32x4*)(dst + i * 8) = w;
    }
}

__device__ __forceinline__ void ln_rows_f32(const float* in, bf16_t* hb, unsigned char* hb8, const float* g, const float* bta) {
    const int lane = otid() & 63, wid = otid() >> 6;
    f32x4 gg[4], bb[4];
#pragma unroll
    for (int i = 0; i < 4; ++i) { gg[i] = ((const f32x4*)g)[lane + 64 * i]; bb[i] = ((const f32x4*)bta)[lane + 64 * i]; }
    for (int r = obid() * 8 + wid; r < T_TOK; r += gridDim.x * 8) {
        const f32x4* xr = (const f32x4*)(in + (size_t)r * DM);
        f32x4 v[4]; float s = 0.f;
#pragma unroll
        for (int i = 0; i < 4; ++i) { v[i] = xr[lane + 64 * i]; s += v[i][0] + v[i][1] + v[i][2] + v[i][3]; }
        s = wave_sum(s);
        const float mu = s * (1.f / DM);
        float q = 0.f;
#pragma unroll
        for (int i = 0; i < 4; ++i) { v[i] = v[i] - mu; q += v[i][0] * v[i][0] + v[i][1] * v[i][1] + v[i][2] * v[i][2] + v[i][3] * v[i][3]; }
        q = wave_sum(q);
        const float rs = rsqrtf(q * (1.f / DM) + LN_EPS);
        u32x2* hrow = (u32x2*)(hb + (size_t)r * DM);
#pragma unroll
        for (int i = 0; i < 4; ++i) {
            const f32x4 o = v[i] * rs * gg[i] + bb[i];
            u32x2 w; w.x = cvt_pk_bf16(o[0], o[1]); w.y = cvt_pk_bf16(o[2], o[3]);
            hrow[lane + 64 * i] = w;
            if (FP8_IN || FP8_Q) { int d8 = 0; d8 = __builtin_amdgcn_cvt_pk_fp8_f32(o[0], o[1], d8, false); d8 = __builtin_amdgcn_cvt_pk_fp8_f32(o[2], o[3], d8, true);
                ((unsigned*)(hb8 + (size_t)r * DM))[lane + 64 * i] = (unsigned)d8; }
        }
    }
}
template <bool HAVE_STAT>
__device__ __forceinline__ void ln_rows_bf16(bf16_t* hb, unsigned char* hb8, float* out_f32, const float* STAT, const float* g, const float* bta) {
    const int lane = otid() & 63, wid = otid() >> 6;
    f32x4 gg[4], bb[4];
#pragma unroll
    for (int i = 0; i < 2; ++i) { gg[2 * i] = *(const f32x4*)(g + i * 512 + lane * 8); gg[2 * i + 1] = *(const f32x4*)(g + i * 512 + lane * 8 + 4);
        bb[2 * i] = *(const f32x4*)(bta + i * 512 + lane * 8); bb[2 * i + 1] = *(const f32x4*)(bta + i * 512 + lane * 8 + 4); }
    constexpr int NR = 4;
    for (int r0 = (obid() * 8 + wid) * NR; r0 < T_TOK; r0 += gridDim.x * 8 * NR) {
        u32x4 ra[NR], rb[NR]; f32x4 st[NR][2];
#pragma unroll
        for (int k = 0; k < NR; ++k) {
            const bf16_t* hrow = hb + (size_t)(r0 + k) * DM;
            ra[k] = *(const u32x4*)(hrow + lane * 8); rb[k] = *(const u32x4*)(hrow + 512 + lane * 8);
            if (HAVE_STAT) {
#pragma unroll
                for (int q = 0; q < 2; ++q) st[k][q] = *(const f32x4*)(STAT + (size_t)(r0 + k) * 8 + 4 * q);
            }
        }
#pragma unroll
        for (int k = 0; k < NR; ++k) {
            const int r = r0 + k;
            bf16_t* hrow = hb + (size_t)r * DM;
            float v[16];
#pragma unroll
            for (int i = 0; i < 4; ++i) { v[2 * i] = bflo(ra[k][i]); v[2 * i + 1] = bfhi(ra[k][i]); v[8 + 2 * i] = bflo(rb[k][i]); v[8 + 2 * i + 1] = bfhi(rb[k][i]); }
            float mu, rs;
            if (HAVE_STAT) {
                const float s1 = (st[k][0][0] + st[k][0][2]) + (st[k][1][0] + st[k][1][2]);
                const float s2 = (st[k][0][1] + st[k][0][3]) + (st[k][1][1] + st[k][1][3]);
                mu = s1 * (1.f / DM);
                rs = rsqrtf(fmaxf(s2 * (1.f / DM) - mu * mu, 0.f) + LN_EPS);
            } else {
                float sm = 0.f;
#pragma unroll
                for (int i = 0; i < 16; ++i) sm += v[i];
                sm = wave_sum(sm);
                mu = sm * (1.f / DM);
                float q = 0.f;
#pragma unroll
                for (int i = 0; i < 16; ++i) { const float d = v[i] - mu; q += d * d; }
                q = wave_sum(q);
                rs = rsqrtf(q * (1.f / DM) + LN_EPS);
            }
            float o[16];
#pragma unroll
            for (int i = 0; i < 4; ++i)
#pragma unroll
                for (int c = 0; c < 4; ++c) o[4 * i + c] = (v[4 * i + c] - mu) * rs * gg[i][c] + bb[i][c];
            u32x4 w0, w1;
            w0.x = cvt_pk_bf16(o[0], o[1]); w0.y = cvt_pk_bf16(o[2], o[3]); w0.z = cvt_pk_bf16(o[4], o[5]); w0.w = cvt_pk_bf16(o[6], o[7]);
            w1.x = cvt_pk_bf16(o[8], o[9]); w1.y = cvt_pk_bf16(o[10], o[11]); w1.z = cvt_pk_bf16(o[12], o[13]); w1.w = cvt_pk_bf16(o[14], o[15]);
            *(u32x4*)(hrow + lane * 8) = w0; *(u32x4*)(hrow + 512 + lane * 8) = w1;
            if (FP8_IN || FP8_Q) { *(u32x2*)(hb8 + (size_t)r * DM + lane * 8) = cvt8_fp8(o, 1.f); *(u32x2*)(hb8 + (size_t)r * DM + 512 + lane * 8) = cvt8_fp8(o + 8, 1.f); }
            if (out_f32) {
                float* orow = out_f32 + (size_t)r * DM;
                *(f32x4*)(orow + lane * 8) = (f32x4){o[0], o[1], o[2], o[3]}; *(f32x4*)(orow + lane * 8 + 4) = (f32x4){o[4], o[5], o[6], o[7]};
                *(f32x4*)(orow + 512 + lane * 8) = (f32x4){o[8], o[9], o[10], o[11]}; *(f32x4*)(orow + 512 + lane * 8 + 4) = (f32x4){o[12], o[13], o[14], o[15]};
            }
        }
    }
}

__device__ void phase_prep(const Params& P, LAS unsigned char* lds) {
    unsigned char* ws = P.ws;
#ifdef TS_SUB
    if (obid() == 0 && otid() < 16) ((unsigned long long*)(ws + WS_CTL + 40960))[otid()] = 0ull;
#endif
    if (obid() == 0 && otid() < 2 * DEPTH) __hip_atomic_store((unsigned*)(ws + WS_CTL) + 64 * (1 + otid()), 0u, __ATOMIC_RELAXED, __HIP_MEMORY_SCOPE_AGENT);
    if (obid() == 0 && otid() < 32) __hip_atomic_store((unsigned*)(ws + WS_CTL) + ((otid() < 16) ? CTLW_QE1 : CTLW_QE3 - 16 * 64) + 64 * otid(), 0u, __ATOMIC_RELAXED, __HIP_MEMORY_SCOPE_AGENT);
    LAS float* s = (LAS float*)lds;
    const int n_win = 2 * 68 * 16, n_wout = 2 * 16 * 32, n_wq = 2 * 16 * 16, n_g = 2 * 8 * 2;
    const int total = n_win + n_wout + n_wq + n_g;
    for (int j = obid(); j < total; j += gridDim.x) {
        if (j < n_win) {
            const int l = j / (68 * 16), r = j % (68 * 16), nt = r / 16, kt = r % 16;
            const int n0 = nt * 64, c0 = n0 < 3584 ? n0 : n0 + 16;
            tr_tile(s, P.w_in + (size_t)l * 1024 * PROJ_LD, PROJ_LD, kt * 64, c0, (bf16_t*)(ws + WS_WIN) + (size_t)l * N_IN * 1024, 1024, n0, nullptr, FP8_IN ? ws + WS_WIN8 + (size_t)l * N_IN * 1024 : nullptr);
        } else if (j < n_win + n_wout) {
            const int jj = j - n_win, l = jj / (16 * 32), r = jj % (16 * 32), nt = r / 32, kt = r % 32;
            const int k0 = kt * 64;
            const float* sc = (k0 >= 512 && k0 < 1536) ? P.ssm_norm_g + l * 1024 + (k0 - 512) : nullptr;
            tr_tile(s, P.w_out + (size_t)l * MIXW * 1024, 1024, k0, nt * 64, (bf16_t*)(ws + WS_WOUT) + (size_t)l * 1024 * MIXW, MIXW, nt * 64, sc, FP8_OUT ? ws + WS_WOUT8 + (size_t)l * 1024 * MIXW : nullptr, 64.f);
        } else if (j < n_win + n_wout + n_wq) {
            const int jj = j - n_win - n_wout, l = jj / 256, r = jj % 256, nt = r / 16, kt = r % 16;
            tr_tile(s, P.peer_wq + (size_t)l * 1024 * 1024, 1024, kt * 64, nt * 64, (bf16_t*)(ws + WS_WQ) + (size_t)l * 1024 * 1024, 1024, nt * 64, nullptr, FP8_Q ? ws + WS_WQ8 + (size_t)l * 1024 * 1024 : nullptr);
        } else {
            const int jj = j - n_win - n_wout - n_wq, which = jj / 16, lb = jj % 16;
            const float* src = (which ? P.rg_wx : P.rg_wa) + (size_t)lb * 4096;
            bf16_t* dst = (bf16_t*)(ws + (which ? WS_WX : WS_WA)) + (size_t)lb * 4096;
            tr_tile(s, src, 64, 0, 0, dst, 64, 0, nullptr);
        }
    }
    for (int i = obid() * NTHREADS + otid(); i < 2 * 16 * 1024; i += gridDim.x * NTHREADS) {
        const int l = i >> 14, j = (i >> 10) & 15, k = i & 1023;
        ((bf16_t*)(ws + WS_WDT))[i] = f2bf(P.w_in[((size_t)l * 1024 + k) * PROJ_LD + C_DT + j]);
    }
    convert_rows(P.peer_keys, (bf16_t*)(ws + WS_KEYS), (size_t)2 * 2 * 128 * 64);
    {
        const int lane = otid() & 63, wid = otid() >> 6;
        for (int r = obid() * 8 + wid; r < 2 * 2 * 16384; r += gridDim.x * 8) {
            const int which = r >> 15, row = r & 32767;
            const float* src = (which ? P.peer_v : P.peer_u) + (size_t)row * DM + lane * 16;
            f32x4 v[4]; float amax = 0.f;
#pragma unroll
            for (int i = 0; i < 4; ++i) { v[i] = *(const f32x4*)(src + 4 * i); amax = fmaxf(amax, fmaxf(fmaxf(fabsf(v[i][0]), fabsf(v[i][1])), fmaxf(fabsf(v[i][2]), fabsf(v[i][3])))); }
#pragma unroll
            for (int o = 32; o > 0; o >>= 1) amax = fmaxf(amax, __shfl_xor(amax, o));
            const float inv = amax > 0.f ? 6.f / amax : 0.f;
            u32x2 w;
#pragma unroll
            for (int i = 0; i < 2; ++i) { unsigned q = 0;
                q = __builtin_amdgcn_cvt_scalef32_pk_fp4_f32(q, v[2 * i][0] * inv, v[2 * i][1] * inv, 1.0f, 0); q = __builtin_amdgcn_cvt_scalef32_pk_fp4_f32(q, v[2 * i][2] * inv, v[2 * i][3] * inv, 1.0f, 1);
                q = __builtin_amdgcn_cvt_scalef32_pk_fp4_f32(q, v[2 * i + 1][0] * inv, v[2 * i + 1][1] * inv, 1.0f, 2); q = __builtin_amdgcn_cvt_scalef32_pk_fp4_f32(q, v[2 * i + 1][2] * inv, v[2 * i + 1][3] * inv, 1.0f, 3);
                w[i] = q; }
            *(u32x2*)(ws + (which ? WS_V8 : WS_U8) + (size_t)(row >> 14) * (16384 * 512) + (size_t)(lane >> 4) * (16384 * 128) + (size_t)(row & 16383) * 128 + (lane & 15) * 8) = w;
            if (lane == 0) ((float*)(ws + (which ? WS_SV : WS_SU)))[row] = amax * (1.f / 6.f);
        }
    }
    ln_rows_f32(P.x, (bf16_t*)(ws + WS_HB), ws + WS_HB8, P.emb_g, P.emb_b);
}

__device__ void phase_dt(const Params& P, int layer) {
    const int lane = otid() & 63, wid = otid() >> 6;
    const bf16_t* hb = (const bf16_t*)(P.ws + WS_HB);
    const bf16_t* wdt = (const bf16_t*)(P.ws + WS_WDT) + (size_t)layer * 16 * 1024;
    float* DT = (float*)(P.ws + WS_DT);
    const float bias = P.ssm_dt_bias[layer * 16 + (lane & 15)];
    for (int task = obid() * 8 + wid; task < T_TOK / 16; task += gridDim.x * 8) {
        const int t0 = task * 16;
        f32x4 acc = {0.f, 0.f, 0.f, 0.f};
        const bf16_t* ap = hb + (size_t)(t0 + (lane & 15)) * DM + (lane >> 4) * 8;
        const bf16_t* bp = wdt + (size_t)(lane & 15) * DM + (lane >> 4) * 8;
#pragma unroll 8
        for (int ks = 0; ks < 32; ++ks) {
            const bf16x8 a = *(const bf16x8*)(ap + ks * 32), b = *(const bf16x8*)(bp + ks * 32);
            acc = MFMA16(a, b, acc);
        }
#pragma unroll
        for (int j = 0; j < 4; ++j) DT[(size_t)(t0 + (lane >> 4) * 4 + j) * 16 + (lane & 15)] = softplusf_(acc[j] + bias);
    }
}

__device__ void phase_conv(const Params& P, int layer) {
    const int tid = otid();
    bf16_t* proj = (bf16_t*)(P.ws + WS_PROJ);
    for (int tile = obid(); tile < 128; tile += gridDim.x) {
        const int b = tile >> 3, slab = tile & 7;
        const int cg = tid & 7, chx = 1024 + slab * 64 + cg * 8;
        float cw[4][8], cb[8];
#pragma unroll
        for (int j = 0; j < 8; ++j) {
            cb[j] = P.ssm_conv_b[layer * 1536 + chx + j];
#pragma unroll
            for (int i = 0; i < 4; ++i) cw[i][j] = P.ssm_conv_w[(layer * 4 + i) * 1536 + chx + j];
        }
        bf16_t* base = proj + (size_t)b * SEQ * PROJ_LD + C_XBC + chx;
        const int r0 = tid >> 3;
        u32x4 tap[4][4];
#define CONV_LOAD(c) do { _Pragma("unroll") for (int it = 0; it < 4; ++it) _Pragma("unroll") for (int i = 0; i < 4; ++i) { \
            const int pos = (c) * 256 + r0 + it * 64 - 3 + i; \
            tap[it][i] = (pos >= 0) ? *(const u32x4*)(base + (size_t)pos * PROJ_LD) : (u32x4){0u, 0u, 0u, 0u}; } } while (0)
        CONV_LOAD(15);
        for (int c = 15; c >= 0; --c) {
            u32x4 res[4];
#pragma unroll
            for (int it = 0; it < 4; ++it) {
                float v[8];
#pragma unroll
                for (int j = 0; j < 8; ++j) v[j] = cb[j];
#pragma unroll
                for (int i = 0; i < 4; ++i) {
                    const u32x4 w = tap[it][i];
                    v[0] += cw[i][0] * bflo(w.x); v[1] += cw[i][1] * bfhi(w.x); v[2] += cw[i][2] * bflo(w.y); v[3] += cw[i][3] * bfhi(w.y);
                    v[4] += cw[i][4] * bflo(w.z); v[5] += cw[i][5] * bfhi(w.z); v[6] += cw[i][6] * bflo(w.w); v[7] += cw[i][7] * bfhi(w.w);
                }
#pragma unroll
                for (int j = 0; j < 8; ++j) v[j] = siluf_(v[j]);
                res[it].x = cvt_pk_bf16(v[0], v[1]); res[it].y = cvt_pk_bf16(v[2], v[3]); res[it].z = cvt_pk_bf16(v[4], v[5]); res[it].w = cvt_pk_bf16(v[6], v[7]);
            }
            if (c > 0) CONV_LOAD(c - 1);
            __syncthreads();
#pragma unroll
            for (int it = 0; it < 4; ++it) *(u32x4*)(base + (size_t)(c * 256 + r0 + it * 64) * PROJ_LD) = res[it];
        }
#undef CONV_LOAD
        __syncthreads();
    }
}

typedef short v4i16_t __attribute__((ext_vector_type(4)));
__device__ __forceinline__ bf16x8 tr_frag(const LAS bf16_t* base, int stride, int kbase, int n0, int fr, int fq) {
    const LAS bf16_t* p = base + (kbase + fq * 8 + (fr >> 2)) * stride + n0 + (fr & 3) * 4;
    const v4i16_t lo = __builtin_amdgcn_ds_read_tr16_b64_v4i16((LAS v4i16_t*)p);
    const v4i16_t hi = __builtin_amdgcn_ds_read_tr16_b64_v4i16((LAS v4i16_t*)(p + 4 * stride));
    return (bf16x8){lo[0], lo[1], lo[2], lo[3], hi[0], hi[1], hi[2], hi[3]};
}

__device__ void ssd_tile(const Params& P, int layer, int b, int h, LAS unsigned char* lds) {
    const int tid = otid(), lane = tid & 63, wid = tid >> 6, fr = lane & 15, fq = lane >> 4;
    bf16_t* proj = (bf16_t*)(P.ws + WS_PROJ);
    const float* DT = (const float*)(P.ws + WS_DT);
    float* SSQ = (float*)(P.ws + WS_SSQ);
    const int g = h >> 3;
    LAS bf16_t* sC = (LAS bf16_t*)lds;
    LAS bf16_t* sB = sC + 64 * 136;
    LAS bf16_t* sS = sB + 64 * 136;
    LAS bf16_t* sXH = sS + 64 * 136;
    LAS bf16_t* sXD = sXH + 64 * 72;
    LAS bf16_t* sM = sXD + 64 * 72;
    LAS float* sY = (LAS float*)(sM + 64 * 72);
    LAS float* sAcs = sY + 64 * 68;
    LAS float* sDt = sAcs + 128;
    LAS bf16_t* sXR = (LAS bf16_t*)(sDt + 128);
    LAS bf16_t* sXHalo = sXR + 64 * 72;
    const float a_h = -__expf(P.ssm_a_log[layer * 16 + h]);
    const float d_h = P.ssm_d[layer * 16 + h];
    int goff[5], loff[5];
#pragma unroll
    for (int it = 0; it < 5; ++it) {
        const int i = it * NTHREADS + tid, row = i / 40, c2 = i % 40;
        int ch, lo;
        if (c2 < 8) { ch = h * 64 + c2 * 8; lo = (int)(sXR - sC) + row * 72 + c2 * 8; }
        else if (c2 < 24) { ch = 1024 + g * 128 + (c2 - 8) * 8; lo = (int)(sB - sC) + row * 136 + (c2 - 8) * 8; }
        else { ch = 1280 + g * 128 + (c2 - 24) * 8; lo = row * 136 + (c2 - 24) * 8; }
        goff[it] = row * PROJ_LD + C_XBC + ch; loff[it] = lo;
    }
    const bf16_t* pbase = proj + (size_t)b * SEQ * PROJ_LD;
    float cw[4][8], cb[8];
#pragma unroll
    for (int j = 0; j < 8; ++j) {
        const int ch = h * 64 + (tid & 7) * 8 + j;
        cb[j] = P.ssm_conv_b[layer * 1536 + ch];
#pragma unroll
        for (int i = 0; i < 4; ++i) cw[i][j] = P.ssm_conv_w[(layer * 4 + i) * 1536 + ch];
    }
    for (int i = tid; i < 3 * 72 / 2; i += NTHREADS) ((LAS unsigned*)(sXHalo + 3 * 72))[i] = 0u;
    for (int i = tid; i < 64 * 136 / 2; i += NTHREADS) ((LAS unsigned*)sS)[i] = 0u;
    f32x4 accS[4];
#pragma unroll
    for (int q = 0; q < 4; ++q) accS[q] = (f32x4){0.f, 0.f, 0.f, 0.f};
    u32x4 raw[5];
#pragma unroll
    for (int it = 0; it < 5; ++it) raw[it] = *(const u32x4*)(pbase + goff[it]);
    float dtn = 0.f, dtc = 0.f;
    if (wid == 0) { dtc = DT[(size_t)(b * SEQ + lane) * 16 + h]; dtn = DT[(size_t)(b * SEQ + 64 + lane) * 16 + h]; }
#pragma unroll
    for (int it = 0; it < 5; ++it) {
        *(LAS u32x4*)(sC + loff[it]) = raw[it];
        const int i_ = it * NTHREADS + tid, row_ = i_ / 40, c2_ = i_ % 40;
        if (c2_ < 8 && row_ >= 61) *(LAS u32x4*)(sXHalo + (row_ - 61) * 72 + c2_ * 8) = raw[it];
    }
    if (wid == 0) {
        float v = dtc * a_h;
#pragma unroll
        for (int o = 1; o < 64; o <<= 1) { const float n = __shfl_up(v, o); if (lane >= o) v += n; }
        sDt[lane] = dtc; sAcs[lane] = v;
    }
    __syncthreads();
    const int dl = tid >> 3, dp8 = (tid & 7) * 8;
    for (int c = 0; c < 64; ++c) {
        const int t0 = b * SEQ + c * 64;
        if (c + 1 < 64) {
            const bf16_t* nb = pbase + (size_t)(c + 1) * 64 * PROJ_LD;
#pragma unroll
            for (int it = 0; it < 5; ++it) raw[it] = *(const u32x4*)(nb + goff[it]);
            if (wid == 0) {
                float v = dtn * a_h;
#pragma unroll
                for (int o = 1; o < 64; o <<= 1) { const float n = __shfl_up(v, o); if (lane >= o) v += n; }
                sDt[((c + 1) & 1) * 64 + lane] = dtn; sAcs[((c + 1) & 1) * 64 + lane] = v;
                if (c + 2 < 64) dtn = DT[(size_t)(t0 + 128 + lane) * 16 + h];
            }
        }
        const LAS float* cAcs = sAcs + (c & 1) * 64; const LAS float* cDt = sDt + (c & 1) * 64;
        const size_t ga = (size_t)(t0 + dl) * PROJ_LD + C_Z + h * 64 + dp8;
        const u32x4 zw = *(const u32x4*)(proj + ga);
        {
            const LAS bf16_t* halo = sXHalo + ((c + 1) & 1) * (3 * 72);
            float v[8];
#pragma unroll
            for (int j = 0; j < 8; ++j) v[j] = cb[j];
#pragma unroll
            for (int i = 0; i < 4; ++i) {
                const int r = dl - 3 + i;
                const u32x4 w = (r >= 0) ? *(const LAS u32x4*)(sXR + r * 72 + dp8) : *(const LAS u32x4*)(halo + (r + 3) * 72 + dp8);
                v[0] += cw[i][0] * bflo(w.x); v[1] += cw[i][1] * bfhi(w.x); v[2] += cw[i][2] * bflo(w.y); v[3] += cw[i][3] * bfhi(w.y);
                v[4] += cw[i][4] * bflo(w.z); v[5] += cw[i][5] * bfhi(w.z); v[6] += cw[i][6] * bflo(w.w); v[7] += cw[i][7] * bfhi(w.w);
            }
#pragma unroll
            for (int j = 0; j < 8; ++j) v[j] = siluf_(v[j]);
            const float dd = cDt[dl] * __expf(cAcs[63] - cAcs[dl]);
            u32x4 o1; o1.x = cvt_pk_bf16(v[0], v[1]); o1.y = cvt_pk_bf16(v[2], v[3]); o1.z = cvt_pk_bf16(v[4], v[5]); o1.w = cvt_pk_bf16(v[6], v[7]);
            u32x4 o3; o3.x = cvt_pk_bf16(v[0] * dd, v[1] * dd); o3.y = cvt_pk_bf16(v[2] * dd, v[3] * dd); o3.z = cvt_pk_bf16(v[4] * dd, v[5] * dd); o3.w = cvt_pk_bf16(v[6] * dd, v[7] * dd);
            *(LAS u32x4*)(sXH + dl * 72 + dp8) = o1;
            *(LAS u32x4*)(sXD + dl * 72 + dp8) = o3;
        }
        const int lt = wid >> 1, ph = wid & 1;
        f32x4 accY[2];
        {
            bf16x8 aC[4];
#pragma unroll
            for (int ks = 0; ks < 4; ++ks) aC[ks] = *(const LAS bf16x8*)(sC + (lt * 16 + fr) * 136 + ks * 32 + fq * 8);
#pragma unroll
            for (int tt = 0; tt < 2; ++tt) {
                const int st = ph * 2 + tt;
                f32x4 accG = {0.f, 0.f, 0.f, 0.f};
#pragma unroll
                for (int ks = 0; ks < 4; ++ks) { const bf16x8 bb = *(const LAS bf16x8*)(sB + (st * 16 + fr) * 136 + ks * 32 + fq * 8); accG = MFMA16(aC[ks], bb, accG); }
                const int s_idx = st * 16 + fr; const float acs_s = cAcs[s_idx], dt_s = cDt[s_idx];
#pragma unroll
                for (int j = 0; j < 4; ++j) {
                    const int l = lt * 16 + fq * 4 + j;
                    const float val = (s_idx <= l) ? accG[j] * __expf(cAcs[l] - acs_s) * dt_s : 0.f;
                    sM[l * 72 + s_idx] = f2bf(val);
                }
            }
#pragma unroll
            for (int tt = 0; tt < 2; ++tt) {
                const int pt = ph * 2 + tt;
                f32x4 a = {0.f, 0.f, 0.f, 0.f};
#pragma unroll
                for (int ks = 0; ks < 4; ++ks) { const bf16x8 bb = *(const LAS bf16x8*)(sS + (pt * 16 + fr) * 136 + ks * 32 + fq * 8); a = MFMA16(aC[ks], bb, a); }
#pragma unroll
                for (int j = 0; j < 4; ++j) a[j] *= __expf(cAcs[lt * 16 + fq * 4 + j]);
                accY[tt] = a;
            }
        }
        __syncthreads();
        {
#pragma unroll
            for (int tt = 0; tt < 2; ++tt) {
                const int pt = ph * 2 + tt;
#pragma unroll
                for (int ks = 0; ks < 2; ++ks) {
                    const bf16x8 am = *(const LAS bf16x8*)(sM + (lt * 16 + fr) * 72 + ks * 32 + fq * 8);
                    const bf16x8 bx = tr_frag(sXH, 72, ks * 32, pt * 16, fr, fq);
                    accY[tt] = MFMA16(am, bx, accY[tt]);
                }
#pragma unroll
                for (int j = 0; j < 4; ++j) sY[(lt * 16 + fq * 4 + j) * 68 + pt * 16 + fr] = accY[tt][j];
            }
            const float dec = __expf(cAcs[63]);
            const int pt2 = wid >> 1;
            bf16x8 ax[2];
#pragma unroll
            for (int ks = 0; ks < 2; ++ks) ax[ks] = tr_frag(sXD, 72, ks * 32, pt2 * 16, fr, fq);
#pragma unroll
            for (int q = 0; q < 4; ++q) {
                const int nt = ph * 4 + q;
                f32x4 a = accS[q] * dec;
#pragma unroll
                for (int ks = 0; ks < 2; ++ks) { const bf16x8 bb = tr_frag(sB, 136, ks * 32, nt * 16, fr, fq); a = MFMA16(ax[ks], bb, a); }
                accS[q] = a;
#pragma unroll
                for (int j = 0; j < 4; ++j) sS[(pt2 * 16 + fq * 4 + j) * 136 + nt * 16 + fr] = f2bf(a[j]);
            }
        }
        __syncthreads();
        {
            const u32x4 xw = *(const LAS u32x4*)(sXH + dl * 72 + dp8);
            const f32x4 y0 = *(const LAS f32x4*)(sY + dl * 68 + dp8), y1 = *(const LAS f32x4*)(sY + dl * 68 + dp8 + 4);
            float y[8];
            y[0] = (y0[0] + d_h * bflo(xw.x)) * siluf_(bflo(zw.x)); y[1] = (y0[1] + d_h * bfhi(xw.x)) * siluf_(bfhi(zw.x));
            y[2] = (y0[2] + d_h * bflo(xw.y)) * siluf_(bflo(zw.y)); y[3] = (y0[3] + d_h * bfhi(xw.y)) * siluf_(bfhi(zw.y));
            y[4] = (y1[0] + d_h * bflo(xw.z)) * siluf_(bflo(zw.z)); y[5] = (y1[1] + d_h * bfhi(xw.z)) * siluf_(bfhi(zw.z));
            y[6] = (y1[2] + d_h * bflo(xw.w)) * siluf_(bflo(zw.w)); y[7] = (y1[3] + d_h * bfhi(xw.w)) * siluf_(bfhi(zw.w));
            float q = 0.f;
#pragma unroll
            for (int j = 0; j < 8; ++j) q += y[j] * y[j];
            q += dpp_<0xB1>(q); q += dpp_<0x4E>(q); q += dpp_<0x141>(q);
            if ((tid & 7) == 0) SSQ[(size_t)(t0 + dl) * 16 + h] = q;
            u32x4 o; o.x = cvt_pk_bf16(y[0], y[1]); o.y = cvt_pk_bf16(y[2], y[3]); o.z = cvt_pk_bf16(y[4], y[5]); o.w = cvt_pk_bf16(y[6], y[7]);
            *(u32x4*)(proj + ga) = o;
        }
        if (c + 1 < 64) {
#pragma unroll
            for (int it = 0; it < 5; ++it) {
                *(LAS u32x4*)(sC + loff[it]) = raw[it];
                const int i_ = it * NTHREADS + tid, row_ = i_ / 40, c2_ = i_ % 40;
                if (c2_ < 8 && row_ >= 61) *(LAS u32x4*)(sXHalo + ((c + 1) & 1) * (3 * 72) + (row_ - 61) * 72 + c2_ * 8) = raw[it];
            }
        }
        __syncthreads();
    }
}

__device__ void rglru_tile(const Params& P, int layer, int b, int n, LAS unsigned char* lds) {
    const int tid = otid(), lane = tid & 63, wid = tid >> 6, fr = lane & 15, fq = lane >> 4;
    bf16_t* proj = (bf16_t*)(P.ws + WS_PROJ);
    LAS bf16_t* sXC = (LAS bf16_t*)lds;
    LAS bf16_t* sWa = sXC + 64 * 72;
    LAS bf16_t* sWx = sWa + 64 * 72;
    LAS float* sA = (LAS float*)(sWx + 64 * 72);
    LAS float* sU = sA + 64 * 64;
    LAS float* sPs = sU + 64 * 64;
    LAS float* sHs = sPs + 8 * 64;
    LAS float* sCar = sHs + 8 * 64;
    LAS bf16_t* sR = (LAS bf16_t*)(sCar + 64);
    LAS bf16_t* sRHalo = sR + 64 * 72;
    {
        const int d = tid >> 3, c8 = (tid & 7) * 8;
        const bf16_t* wa = (const bf16_t*)(P.ws + WS_WA) + (size_t)(layer * 8 + n) * 4096;
        const bf16_t* wx = (const bf16_t*)(P.ws + WS_WX) + (size_t)(layer * 8 + n) * 4096;
        *(LAS u32x4*)(sWa + d * 72 + c8) = *(const u32x4*)(wa + d * 64 + c8);
        *(LAS u32x4*)(sWx + d * 72 + c8) = *(const u32x4*)(wx + d * 64 + c8);
    }
    if (tid < 64) sCar[tid] = 0.f;
    for (int i = tid; i < 3 * 72 / 2; i += NTHREADS) ((LAS unsigned*)(sRHalo + 3 * 72))[i] = 0u;
    const int cg = tid & 7, crow = tid >> 3, ch0 = n * 64 + cg * 8;
    float cw[4][8], cb[8];
#pragma unroll
    for (int j = 0; j < 8; ++j) {
        cb[j] = P.rg_conv_b[layer * 512 + ch0 + j];
#pragma unroll
        for (int i = 0; i < 4; ++i) cw[i][j] = P.rg_conv_w[(layer * 4 + i) * 512 + ch0 + j];
    }
    const int tt = wid & 3, dpair = wid >> 2;
    float ba[2], bx[2], sp[2];
#pragma unroll
    for (int dd = 0; dd < 2; ++dd) {
        const int ch = layer * 512 + n * 64 + (dpair * 2 + dd) * 16 + fr;
        ba[dd] = P.rg_ba[ch]; bx[dd] = P.rg_bx[ch]; sp[dd] = softplusf_(-P.rg_lambda[ch]);
    }
    const int sc = tid & 63, seg = wid;
    const bf16_t* pbase = proj + (size_t)b * SEQ * PROJ_LD;
    const int goff = crow * PROJ_LD + C_RGX + ch0;
#define RG_CONV(cc) do { const LAS bf16_t* halo_ = sRHalo + (((cc) + 1) & 1) * (3 * 72); float v_[8]; \
        _Pragma("unroll") for (int j_ = 0; j_ < 8; ++j_) v_[j_] = cb[j_]; \
        _Pragma("unroll") for (int i_ = 0; i_ < 4; ++i_) { const int r_ = crow - 3 + i_; \
            const u32x4 w_ = (r_ >= 0) ? *(const LAS u32x4*)(sR + r_ * 72 + cg * 8) : *(const LAS u32x4*)(halo_ + (r_ + 3) * 72 + cg * 8); \
            v_[0] += cw[i_][0] * bflo(w_.x); v_[1] += cw[i_][1] * bfhi(w_.x); v_[2] += cw[i_][2] * bflo(w_.y); v_[3] += cw[i_][3] * bfhi(w_.y); \
            v_[4] += cw[i_][4] * bflo(w_.z); v_[5] += cw[i_][5] * bfhi(w_.z); v_[6] += cw[i_][6] * bflo(w_.w); v_[7] += cw[i_][7] * bfhi(w_.w); } \
        u32x4 o_; o_.x = cvt_pk_bf16(v_[0], v_[1]); o_.y = cvt_pk_bf16(v_[2], v_[3]); o_.z = cvt_pk_bf16(v_[4], v_[5]); o_.w = cvt_pk_bf16(v_[6], v_[7]); \
        *(LAS u32x4*)(sXC + crow * 72 + cg * 8) = o_; } while (0)
    u32x4 raw = *(const u32x4*)(pbase + goff);
    *(LAS u32x4*)(sR + crow * 72 + cg * 8) = raw;
    if (crow >= 61) *(LAS u32x4*)(sRHalo + (crow - 61) * 72 + cg * 8) = raw;
    __syncthreads();
    RG_CONV(0);
    __syncthreads();
    for (int c = 0; c < 64; ++c) {
        const int t0 = b * SEQ + c * 64;
        if (c + 1 < 64) raw = *(const u32x4*)(pbase + (size_t)(c + 1) * 64 * PROJ_LD + goff);
        const size_t ga = (size_t)(t0 + crow) * PROJ_LD + C_GATE + ch0;
        const u32x4 gw = *(const u32x4*)(proj + ga);
        {
            bf16x8 ax[2];
#pragma unroll
            for (int ks = 0; ks < 2; ++ks) ax[ks] = *(const LAS bf16x8*)(sXC + (tt * 16 + fr) * 72 + ks * 32 + fq * 8);
#pragma unroll
            for (int dd = 0; dd < 2; ++dd) {
                const int dt_ = dpair * 2 + dd;
                f32x4 accA = {0.f, 0.f, 0.f, 0.f}, accX = {0.f, 0.f, 0.f, 0.f};
#pragma unroll
                for (int ks = 0; ks < 2; ++ks) {
                    const bf16x8 wa = *(const LAS bf16x8*)(sWa + (dt_ * 16 + fr) * 72 + ks * 32 + fq * 8);
                    const bf16x8 wx = *(const LAS bf16x8*)(sWx + (dt_ * 16 + fr) * 72 + ks * 32 + fq * 8);
                    accA = MFMA16(ax[ks], wa, accA); accX = MFMA16(ax[ks], wx, accX);
                }
#pragma unroll
                for (int j = 0; j < 4; ++j) {
                    const int t = tt * 16 + fq * 4 + j, d = dt_ * 16 + fr;
                    const float r = sigmoidf_(accA[j] + ba[dd]), ig = sigmoidf_(accX[j] + bx[dd]);
                    const float a = __expf(-8.f * r * sp[dd]);
                    const float mult = sqrtf(fmaxf(1.f - a * a, 0.f));
                    sA[t * 64 + d] = a;
                    sU[t * 64 + d] = mult * ig * bf2f(sXC[t * 72 + d]);
                }
            }
        }
        __syncthreads();
        {
            float Pl = 1.f, Hl = 0.f;
#pragma unroll
            for (int i = 0; i < 8; ++i) { const float a = sA[(seg * 8 + i) * 64 + sc], u = sU[(seg * 8 + i) * 64 + sc]; Hl = a * Hl + u; Pl *= a; }
            sPs[seg * 64 + sc] = Pl; sHs[seg * 64 + sc] = Hl;
        }
        __syncthreads();
        float H = sCar[sc];
        for (int s2 = 0; s2 < seg; ++s2) H = sPs[s2 * 64 + sc] * H + sHs[s2 * 64 + sc];
#pragma unroll
        for (int i = 0; i < 8; ++i) {
            const int t = seg * 8 + i;
            H = sA[t * 64 + sc] * H + sU[t * 64 + sc];
            sU[t * 64 + sc] = H;
        }
        __syncthreads();
        if (seg == 7) sCar[sc] = H;
        {
            const f32x4 h0 = *(const LAS f32x4*)(sU + crow * 64 + cg * 8), h1 = *(const LAS f32x4*)(sU + crow * 64 + cg * 8 + 4);
            u32x4 o;
            o.x = cvt_pk_bf16(gelu_tanhf_(bflo(gw.x)) * h0[0], gelu_tanhf_(bfhi(gw.x)) * h0[1]);
            o.y = cvt_pk_bf16(gelu_tanhf_(bflo(gw.y)) * h0[2], gelu_tanhf_(bfhi(gw.y)) * h0[3]);
            o.z = cvt_pk_bf16(gelu_tanhf_(bflo(gw.z)) * h1[0], gelu_tanhf_(bfhi(gw.z)) * h1[1]);
            o.w = cvt_pk_bf16(gelu_tanhf_(bflo(gw.w)) * h1[2], gelu_tanhf_(bfhi(gw.w)) * h1[3]);
            *(u32x4*)(proj + ga) = o;
        }
        if (c + 1 < 64) {
            *(LAS u32x4*)(sR + crow * 72 + cg * 8) = raw;
            if (crow >= 61) *(LAS u32x4*)(sRHalo + ((c + 1) & 1) * (3 * 72) + (crow - 61) * 72 + cg * 8) = raw;
        }
        __syncthreads();
        if (c + 1 < 64) RG_CONV(c + 1);
        __syncthreads();
    }
#undef RG_CONV
}

__device__ void attn_tile(const Params& P, int layer, int b, int qb, int kvh, LAS unsigned char* lds) {
    const int tid = otid(), lane = tid & 63, wid = tid >> 6, fr = lane & 15, fq = lane >> 4;
    bf16_t* proj = (bf16_t*)(P.ws + WS_PROJ);
    LAS bf16_t* sK = (LAS bf16_t*)lds;
    LAS bf16_t* sVT = sK + 256 * 72;
    LAS bf16_t* sP = sVT + 64 * 280 + wid * (16 * 168);
    const int tb = b * SEQ + qb * 128;
#pragma unroll
    for (int it = 0; it < 4; ++it) {
        const int idx = it * NTHREADS + tid;
        { const int kk = idx >> 3, dg = idx & 7;
          u32x4 v = {0u, 0u, 0u, 0u};
          if (qb > 0 || kk >= 128) v = *(const u32x4*)(proj + (size_t)(tb - 128 + kk) * PROJ_LD + C_K + kvh * 64 + dg * 8);
          *(LAS u32x4*)(sK + kk * 72 + dg * 8) = v; }
        { const int kk = idx & 255, dg = idx >> 8;
          u32x4 v = {0u, 0u, 0u, 0u};
          if (qb > 0 || kk >= 128) v = *(const u32x4*)(proj + (size_t)(tb - 128 + kk) * PROJ_LD + C_V + kvh * 64 + dg * 8);
          const unsigned wv[4] = {v.x, v.y, v.z, v.w};
#pragma unroll
          for (int j = 0; j < 4; ++j) { sVT[(dg * 8 + 2 * j) * 280 + kk] = (bf16_t)(wv[j] & 0xffffu); sVT[(dg * 8 + 2 * j + 1) * 280 + kk] = (bf16_t)(wv[j] >> 16); } }
    }
    if (tid < 192) { const int d = tid / 3, part = tid % 3; *(LAS u32x4*)(sVT + d * 280 + 256 + part * 8) = (u32x4){0u, 0u, 0u, 0u}; }
    __syncthreads();
    const int q0 = wid * 16;
    for (int r = 0; r < 4; ++r) {
        const int hq = kvh * 4 + r;
        const float sink = P.attn_sinks[layer * 8 + hq];
        bf16x8 qf[2];
#pragma unroll
        for (int ks = 0; ks < 2; ++ks) qf[ks] = *(const bf16x8*)(proj + (size_t)(tb + q0 + fr) * PROJ_LD + C_Q + hq * 64 + ks * 32 + fq * 8);
        f32x4 S[9];
#pragma unroll
        for (int kt = 0; kt < 9; ++kt) {
            f32x4 a = {0.f, 0.f, 0.f, 0.f};
#pragma unroll
            for (int ks = 0; ks < 2; ++ks) { const bf16x8 kf = *(const LAS bf16x8*)(sK + ((wid + kt) * 16 + fr) * 72 + ks * 32 + fq * 8); a = MFMA16(qf[ks], kf, a); }
            S[kt] = a;
        }
        float mx[4], sm[4];
#pragma unroll
        for (int j = 0; j < 4; ++j) mx[j] = -INFINITY;
#pragma unroll
        for (int kt = 0; kt < 9; ++kt)
#pragma unroll
            for (int j = 0; j < 4; ++j) {
                const int qi = q0 + fq * 4 + j, kk = (wid + kt) * 16 + fr, kj = kk - 128;
                const bool valid = (kj <= qi) && (kj > qi - 128) && (qb > 0 || kk >= 128);
                const float s = valid ? S[kt][j] * 0.125f : -INFINITY;
                S[kt][j] = s; mx[j] = fmaxf(mx[j], s);
            }
#pragma unroll
        for (int j = 0; j < 4; ++j) {
            float m = mx[j];
            m = fmaxf(m, __shfl_xor(m, 1)); m = fmaxf(m, __shfl_xor(m, 2)); m = fmaxf(m, __shfl_xor(m, 4)); m = fmaxf(m, __shfl_xor(m, 8));
            mx[j] = fmaxf(m, sink); sm[j] = 0.f;
        }
#pragma unroll
        for (int kt = 0; kt < 9; ++kt)
#pragma unroll
            for (int j = 0; j < 4; ++j) { const float p = __expf(S[kt][j] - mx[j]); S[kt][j] = p; sm[j] += p; }
#pragma unroll
        for (int j = 0; j < 4; ++j) {
            float s = sm[j];
            s += __shfl_xor(s, 1); s += __shfl_xor(s, 2); s += __shfl_xor(s, 4); s += __shfl_xor(s, 8);
            sm[j] = 1.f / (s + __expf(sink - mx[j]));
        }
#pragma unroll
        for (int kt = 0; kt < 9; ++kt)
#pragma unroll
            for (int j = 0; j < 4; ++j) sP[(fq * 4 + j) * 168 + kt * 16 + fr] = f2bf(S[kt][j] * sm[j]);
#pragma unroll
        for (int j = 0; j < 4; ++j) sP[(fq * 4 + j) * 168 + 144 + fr] = 0;
        f32x4 O[4];
#pragma unroll
        for (int dt_ = 0; dt_ < 4; ++dt_) O[dt_] = (f32x4){0.f, 0.f, 0.f, 0.f};
#pragma unroll
        for (int ks = 0; ks < 5; ++ks) {
            const bf16x8 pa = *(const LAS bf16x8*)(sP + fr * 168 + ks * 32 + fq * 8);
#pragma unroll
            for (int dt_ = 0; dt_ < 4; ++dt_) { const bf16x8 vb = *(const LAS bf16x8*)(sVT + (dt_ * 16 + fr) * 280 + wid * 16 + ks * 32 + fq * 8); O[dt_] = MFMA16(pa, vb, O[dt_]); }
        }
#pragma unroll
        for (int dt_ = 0; dt_ < 4; ++dt_)
#pragma unroll
            for (int j = 0; j < 4; ++j) proj[(size_t)(tb + q0 + fq * 4 + j) * PROJ_LD + C_Q + hq * 64 + dt_ * 16 + fr] = f2bf(O[dt_][j]);
    }
    __syncthreads();
}

__device__ void phase_mixers(const Params& P, int layer, LAS unsigned char* lds) {
    unsigned* ctr = (unsigned*)(P.ws + WS_CTL) + 64 * (1 + layer);
    LAS int* sTile = (LAS int*)(lds + LDS_BYTES - 16);
    for (;;) {
        if (otid() == 0) *sTile = (int)atomicAdd(ctr, 1u);
        __syncthreads();
        const int tile = *sTile;
        __syncthreads();
        if (tile >= 256 + 128 + 1024) break;
#ifdef TS_SUB
        const unsigned long long tq0 = __builtin_amdgcn_s_memrealtime();
#endif
        if (tile < 256) { if (MIX_MASK & 1) ssd_tile(P, layer, tile >> 4, tile & 15, lds); }
        else if (tile < 384) { const int j = tile - 256; if (MIX_MASK & 2) rglru_tile(P, layer, j >> 3, j & 7, lds); }
        else { const int j = tile - 384; if (MIX_MASK & 4) attn_tile(P, layer, j >> 6, (j >> 1) & 31, j & 1, lds); }
#ifdef TS_SUB
        if (obid() == 0 && otid() == 0) { unsigned long long* pr = (unsigned long long*)(P.ws + WS_CTL + 40960); const int cat = tile < 256 ? 9 : (tile < 384 ? 10 : 11); pr[cat] += __builtin_amdgcn_s_memrealtime() - tq0; }
#endif
    }
}

__device__ void phase_ssdnorm(const Params& P) {
    const int lane = otid() & 63, wid = otid() >> 6;
    bf16_t* proj = (bf16_t*)(P.ws + WS_PROJ);
    const float* SSQ = (const float*)(P.ws + WS_SSQ);
    const int k0 = lane * 32;
    const int soff = (lane < 16) ? C_GATE + k0 : (lane < 48) ? C_Z + (k0 - 512) : C_Q + (k0 - 1536);
    const bool isb = (lane >= 16 && lane < 48);
    const int g = (lane - 16) >> 4;
    constexpr int NR = 4;
    for (int t0 = (obid() * 8 + wid) * NR; t0 < T_TOK; t0 += gridDim.x * 8 * NR) {
        u32x4 in[NR][4]; f32x4 s0[NR], s1[NR];
#pragma unroll
        for (int k = 0; k < NR; ++k) {
            const bf16_t* src = proj + (size_t)(t0 + k) * PROJ_LD + soff;
#pragma unroll
            for (int i = 0; i < 4; ++i) in[k][i] = *(const u32x4*)(src + 8 * i);
            if (isb) { s0[k] = *(const f32x4*)(SSQ + (size_t)(t0 + k) * 16 + g * 8); s1[k] = *(const f32x4*)(SSQ + (size_t)(t0 + k) * 16 + g * 8 + 4); }
        }
        u32x4 o[NR][2];
#pragma unroll
        for (int k = 0; k < NR; ++k) {
            float sc = 1.f;
            if (isb) sc = rsqrtf(((s0[k][0] + s0[k][1]) + (s0[k][2] + s0[k][3]) + (s1[k][0] + s1[k][1]) + (s1[k][2] + s1[k][3])) * (1.f / 512.f) + LN_EPS);
#pragma unroll
            for (int i = 0; i < 4; ++i) {
                float v[8];
#pragma unroll
                for (int c = 0; c < 4; ++c) { v[2 * c] = bflo(in[k][i][c]); v[2 * c + 1] = bfhi(in[k][i][c]); }
                const u32x2 w = cvt8_fp8(v, sc);
                if (i & 1) { o[k][i >> 1].z = w.x; o[k][i >> 1].w = w.y; } else { o[k][i >> 1].x = w.x; o[k][i >> 1].y = w.y; }
            }
        }
        asm volatile("s_waitcnt vmcnt(0)" ::: "memory");
#pragma unroll
        for (int k = 0; k < NR; ++k) {
            unsigned char* dst = (unsigned char*)(proj + (size_t)(t0 + k) * PROJ_LD) + k0;
            *(u32x4*)dst = o[k][0]; *(u32x4*)(dst + 16) = o[k][1];
        }
    }
}

__device__ void phase_ssdnorm_bf16(const Params& P) {
    bf16_t* proj = (bf16_t*)(P.ws + WS_PROJ);
    const float* SSQ = (const float*)(P.ws + WS_SSQ);
    for (size_t i = (size_t)obid() * NTHREADS + otid(); i < (size_t)T_TOK * 128; i += (size_t)gridDim.x * NTHREADS) {
        const size_t t = i >> 7; const int c8 = (int)(i & 127) * 8, g = c8 >> 9;
        const f32x4 s0 = *(const f32x4*)(SSQ + t * 16 + g * 8), s1 = *(const f32x4*)(SSQ + t * 16 + g * 8 + 4);
        const float ss = s0[0] + s0[1] + s0[2] + s0[3] + s1[0] + s1[1] + s1[2] + s1[3];
        const float sc = rsqrtf(ss * (1.f / 512.f) + LN_EPS);
        u32x4* p = (u32x4*)(proj + t * PROJ_LD + C_Z + c8);
        const u32x4 w = *p;
        u32x4 o; o.x = cvt_pk_bf16(bflo(w.x) * sc, bfhi(w.x) * sc); o.y = cvt_pk_bf16(bflo(w.y) * sc, bfhi(w.y) * sc);
        o.z = cvt_pk_bf16(bflo(w.z) * sc, bfhi(w.z) * sc); o.w = cvt_pk_bf16(bflo(w.w) * sc, bfhi(w.w) * sc);
        *p = o;
    }
}

__device__ __forceinline__ unsigned mono_(float f) { const unsigned u = __float_as_uint(f); return (u & 0x80000000u) ? ~u : (u | 0x80000000u); }
__device__ __forceinline__ float unmono_(unsigned u) { return __uint_as_float((u & 0x80000000u) ? (u ^ 0x80000000u) : ~u); }

__device__ void phase_peer_topk(const Params& P, int layer, LAS unsigned char* lds) {
    const int tid = otid(), lane = tid & 63, wid = tid >> 6, fr = lane & 15, fq = lane >> 4;
    const bf16_t* QP = (const bf16_t*)(P.ws + WS_QP);
    const bf16_t* keys = (const bf16_t*)(P.ws + WS_KEYS) + (size_t)layer * 2 * 128 * 64;
    unsigned short* IDX = (unsigned short*)(P.ws + WS_IDX);
    float* GATE = (float*)(P.ws + WS_GATE);
    LAS float* sSc = (LAS float*)lds;
    LAS unsigned* sTop = (LAS unsigned*)lds;
#define CE_D(a, b) do { const unsigned hi_ = umax_(a, b), lo_ = umin_(a, b); a = hi_; b = lo_; } while (0)
#define CE_A(a, b) do { const unsigned hi_ = umax_(a, b), lo_ = umin_(a, b); a = lo_; b = hi_; } while (0)
    for (int tile = obid(); tile < T_TOK / 32; tile += gridDim.x) {
        const int tok0 = tile * 32;
        unsigned top[16];
#pragma unroll
        for (int k = 0; k < 16; ++k) top[k] = 0u;
        bf16x8 qa[2][2][2];
#pragma unroll
        for (int i = 0; i < 2; ++i)
#pragma unroll
            for (int mt = 0; mt < 2; ++mt)
#pragma unroll
                for (int ks = 0; ks < 2; ++ks) qa[i][mt][ks] = *(const bf16x8*)(QP + (size_t)(tok0 + mt * 16 + fr) * DM + wid * 128 + i * 64 + ks * 32 + fq * 8);
        for (int ps = 0; ps < 2; ++ps) {
            bf16x8 kb[2][4][2];
#pragma unroll
            for (int i = 0; i < 2; ++i)
#pragma unroll
                for (int nt = 0; nt < 4; ++nt)
#pragma unroll
                    for (int ks = 0; ks < 2; ++ks) kb[i][nt][ks] = *(const bf16x8*)(keys + (size_t)(i * 128 + ps * 64 + nt * 16 + fr) * 64 + ks * 32 + fq * 8);
#pragma unroll
            for (int i = 0; i < 2; ++i)
#pragma unroll
                for (int mt = 0; mt < 2; ++mt)
#pragma unroll
                    for (int nt = 0; nt < 4; ++nt) {
                        f32x4 acc = {0.f, 0.f, 0.f, 0.f};
#pragma unroll
                        for (int ks = 0; ks < 2; ++ks) acc = MFMA16(qa[i][mt][ks], kb[i][nt][ks], acc);
#pragma unroll
                        for (int j = 0; j < 4; ++j) sSc[((wid * 2 + i) * 32 + mt * 16 + fq * 4 + j) * 65 + nt * 16 + fr] = acc[j];
                    }
            __syncthreads();
#pragma unroll 1
            for (int gq = 0; gq < 4; ++gq) {
                unsigned g_[16];
#pragma unroll
                for (int e = 0; e < 16; ++e) { const float sv_ = sSc[tid * 65 + gq * 16 + e]; g_[e] = (mono_(sv_) & ~0x7Fu) | (unsigned)(127 - (ps * 64 + gq * 16 + e)); }
                CE_D(g_[0], g_[1]); CE_A(g_[2], g_[3]); CE_D(g_[4], g_[5]); CE_A(g_[6], g_[7]); CE_D(g_[8], g_[9]); CE_A(g_[10], g_[11]); CE_D(g_[12], g_[13]); CE_A(g_[14], g_[15]); CE_D(g_[0], g_[2]); CE_D(g_[1], g_[3]); CE_A(g_[4], g_[6]); CE_A(g_[5], g_[7]); CE_D(g_[8], g_[10]); CE_D(g_[9], g_[11]); CE_A(g_[12], g_[14]); CE_A(g_[13], g_[15]); CE_D(g_[0], g_[1]); CE_D(g_[2], g_[3]); CE_A(g_[4], g_[5]); CE_A(g_[6], g_[7]); CE_D(g_[8], g_[9]); CE_D(g_[10], g_[11]); CE_A(g_[12], g_[13]); CE_A(g_[14], g_[15]); CE_D(g_[0], g_[4]); CE_D(g_[1], g_[5]); CE_D(g_[2], g_[6]); CE_D(g_[3], g_[7]); CE_A(g_[8], g_[12]); CE_A(g_[9], g_[13]); CE_A(g_[10], g_[14]); CE_A(g_[11], g_[15]); CE_D(g_[0], g_[2]); CE_D(g_[1], g_[3]); CE_D(g_[4], g_[6]); CE_D(g_[5], g_[7]); CE_A(g_[8], g_[10]); CE_A(g_[9], g_[11]); CE_A(g_[12], g_[14]); CE_A(g_[13], g_[15]); CE_D(g_[0], g_[1]); CE_D(g_[2], g_[3]); CE_D(g_[4], g_[5]); CE_D(g_[6], g_[7]); CE_A(g_[8], g_[9]); CE_A(g_[10], g_[11]); CE_A(g_[12], g_[13]); CE_A(g_[14], g_[15]); CE_D(g_[0], g_[8]); CE_D(g_[1], g_[9]); CE_D(g_[2], g_[10]); CE_D(g_[3], g_[11]); CE_D(g_[4], g_[12]); CE_D(g_[5], g_[13]); CE_D(g_[6], g_[14]); CE_D(g_[7], g_[15]); CE_D(g_[0], g_[4]); CE_D(g_[1], g_[5]); CE_D(g_[2], g_[6]); CE_D(g_[3], g_[7]); CE_D(g_[8], g_[12]); CE_D(g_[9], g_[13]); CE_D(g_[10], g_[14]); CE_D(g_[11], g_[15]); CE_D(g_[0], g_[2]); CE_D(g_[1], g_[3]); CE_D(g_[4], g_[6]); CE_D(g_[5], g_[7]); CE_D(g_[8], g_[10]); CE_D(g_[9], g_[11]); CE_D(g_[12], g_[14]); CE_D(g_[13], g_[15]); CE_D(g_[0], g_[1]); CE_D(g_[2], g_[3]); CE_D(g_[4], g_[5]); CE_D(g_[6], g_[7]); CE_D(g_[8], g_[9]); CE_D(g_[10], g_[11]); CE_D(g_[12], g_[13]); CE_D(g_[14], g_[15]);
#pragma unroll
                for (int e = 0; e < 16; ++e) top[e] = umax_(top[e], g_[15 - e]);
                CE_D(top[0], top[8]); CE_D(top[1], top[9]); CE_D(top[2], top[10]); CE_D(top[3], top[11]); CE_D(top[4], top[12]); CE_D(top[5], top[13]); CE_D(top[6], top[14]); CE_D(top[7], top[15]); CE_D(top[0], top[4]); CE_D(top[1], top[5]); CE_D(top[2], top[6]); CE_D(top[3], top[7]); CE_D(top[8], top[12]); CE_D(top[9], top[13]); CE_D(top[10], top[14]); CE_D(top[11], top[15]); CE_D(top[0], top[2]); CE_D(top[1], top[3]); CE_D(top[4], top[6]); CE_D(top[5], top[7]); CE_D(top[8], top[10]); CE_D(top[9], top[11]); CE_D(top[12], top[14]); CE_D(top[13], top[15]); CE_D(top[0], top[1]); CE_D(top[2], top[3]); CE_D(top[4], top[5]); CE_D(top[6], top[7]); CE_D(top[8], top[9]); CE_D(top[10], top[11]); CE_D(top[12], top[13]); CE_D(top[14], top[15]);
            }
            __syncthreads();
        }
#pragma unroll
        for (int q = 0; q < 4; ++q) *(LAS u32x4*)(sTop + tid * 16 + q * 4) = (u32x4){top[q * 4], top[q * 4 + 1], top[q * 4 + 2], top[q * 4 + 3]};
        __syncthreads();
        if (tid < 256) {
            const int token = tid & 31, h = tid >> 5;
            const int row1 = (h * 2) * 32 + token, row2 = (h * 2 + 1) * 32 + token;
            float s1[16], s2[16];
#pragma unroll
            for (int q = 0; q < 4; ++q) {
                const u32x4 a = *(const LAS u32x4*)(sTop + row1 * 16 + q * 4), bq = *(const LAS u32x4*)(sTop + row2 * 16 + q * 4);
#pragma unroll
                for (int e = 0; e < 4; ++e) { s1[q * 4 + e] = unmono_(a[e] & ~0x7Fu); s2[q * 4 + e] = unmono_(bq[e] & ~0x7Fu); }
            }
            unsigned best[16];
#pragma unroll
            for (int k = 0; k < 16; ++k) best[k] = 0u;
#pragma unroll
            for (int a = 0; a < 16; ++a)
#pragma unroll
                for (int bb = 0; bb < 16; ++bb) {
                    if ((a + 1) * (bb + 1) <= 16) {
                        unsigned x = (mono_(s1[a] + s2[bb]) & ~0xFFu) | (unsigned)(255 - (a * 16 + bb));
#pragma unroll
                        for (int q = 0; q < 16; ++q) { const unsigned hi = umax_(best[q], x); x = umin_(best[q], x); best[q] = hi; }
                    }
                }
            float val[16], gsum = 0.f;
            const float vmax = unmono_(best[0] & ~0xFFu);
#pragma unroll
            for (int k = 0; k < 16; ++k) { val[k] = __expf(unmono_(best[k] & ~0xFFu) - vmax); gsum += val[k]; }
            const float ginv = 1.f / gsum;
            const size_t ob = (size_t)(tok0 + token) * 128 + h * 16;
#pragma unroll
            for (int k = 0; k < 16; ++k) {
                const int code = 255 - (int)(best[k] & 0xFFu), a = code >> 4, bb = code & 15;
                const int i1 = 127 - (int)(sTop[row1 * 16 + a] & 0x7Fu), i2 = 127 - (int)(sTop[row2 * 16 + bb] & 0x7Fu);
                IDX[ob + k] = (unsigned short)(i1 * 128 + i2);
                GATE[ob + k] = val[k] * ginv;
            }
        }
        __syncthreads();
    }
}

#define FP4_PAIR(word, b) __builtin_amdgcn_cvt_scalef32_pk_f32_fp4((word), 1.0f, (b))
typedef _Float16 h16x2 __attribute__((ext_vector_type(2)));
#define FP4_H2(word, b) __builtin_amdgcn_cvt_scalef32_pk_f16_fp4((word), 1.0f, (b))
template <int CTLW>
__device__ __forceinline__ int peer_pull(const Params& P, int layer, int slice, int lane) {
    int tq = 0;
    if (lane == 0) tq = (int)atomicAdd((unsigned*)(P.ws + WS_CTL) + CTLW + 64 * (layer * 8 + slice), 16u);
    return __builtin_amdgcn_readfirstlane(tq);
}
template <int QW> __device__ void phase_peer_e1(const Params& P, int layer) {
    const int lane = otid() & 63, es = lane >> 3, ck = lane & 7;
    const bf16_t* hb = (const bf16_t*)(P.ws + WS_HB);
    const unsigned char* U4 = P.ws + WS_U8 + (size_t)layer * 16384 * 512;
    const unsigned short* IDX = (const unsigned short*)(P.ws + WS_IDX);
    unsigned* PD = (unsigned*)(P.ws + WS_PD);
    const int myx = (int)(xb_xcc_id() & 3u);
    const int src = (lane & 7) * 8 + (lane >> 3);
#define E1_IDX(dst, u) do { const unsigned short* ip_ = IDX + (size_t)(tq + (u)) * 128 + es; _Pragma("unroll") for (int i_ = 0; i_ < 16; ++i_) dst[i_] = (int)ip_[i_ * 8]; } while (0)
#define E1_ROWS(dst, ix) do { _Pragma("unroll") for (int i_ = 0; i_ < 16; ++i_) dst[i_] = *(const u32x4*)(Us + (size_t)ix[i_] * 128); } while (0)
#define E1_X(dst, u) do { const bf16_t* xp_ = hb + (size_t)(tq + (u)) * DM + j * 256 + ck * 32; _Pragma("unroll") for (int i_ = 0; i_ < 4; ++i_) dst[i_] = *(const u32x4*)(xp_ + 8 * i_); } while (0)
#define E1_COMPUTE(wv, xr, u) do { h16x2 X_[16]; _Pragma("unroll") for (int a_ = 0; a_ < 4; ++a_) _Pragma("unroll") for (int i_ = 0; i_ < 4; ++i_) X_[4 * a_ + i_] = (h16x2){(_Float16)bflo(xr[a_][i_]), (_Float16)bfhi(xr[a_][i_])}; \
        float k0_ = 0.f, k1_ = 0.f; \
        _Pragma("unroll") for (int i_ = 0; i_ < 16; ++i_) { \
            float d0_ = 0.f, d1_ = 0.f; \
            _Pragma("unroll") for (int q_ = 0; q_ < 4; ++q_) { d0_ = __builtin_amdgcn_fdot2(FP4_H2(wv[i_][q_], 0), X_[4 * q_], d0_, false); d1_ = __builtin_amdgcn_fdot2(FP4_H2(wv[i_][q_], 1), X_[4 * q_ + 1], d1_, false); \
                d0_ = __builtin_amdgcn_fdot2(FP4_H2(wv[i_][q_], 2), X_[4 * q_ + 2], d0_, false); d1_ = __builtin_amdgcn_fdot2(FP4_H2(wv[i_][q_], 3), X_[4 * q_ + 3], d1_, false); } \
            float d_ = d0_ + d1_; \
            d_ += dpp_<0xB1>(d_); d_ += dpp_<0x4E>(d_); d_ += dpp_<0x141>(d_); \
            if (i_ < 8) k0_ = (ck == i_) ? d_ : k0_; else k1_ = (ck == i_ - 8) ? d_ : k1_; } \
        PD[((size_t)(tq + (u)) * 4 + j) * 64 + lane] = cvt_pk_bf16(__shfl(k0_, src), __shfl(k1_, src)); } while (0)
    for (int k = 0; k < 4; ++k) {
        const int j = (myx + k) & 3;
        const unsigned char* Us = U4 + (size_t)j * (16384 * 128) + ck * 16;
        for (;;) {
            int tq = 0;
            if (lane == 0) tq = (int)atomicAdd((unsigned*)(P.ws + WS_CTL) + QW + 64 * (layer * 8 + j), 16u);
            tq = __builtin_amdgcn_readfirstlane(tq);
            if (tq >= T_TOK) break;
            int ix[16];
            E1_IDX(ix, 0);
            for (int u = 0; u < 16; ++u) {
                u32x4 wA[16], xA[4];
                E1_X(xA, u);
                E1_ROWS(wA, ix);
                if (u + 1 < 16) E1_IDX(ix, u + 1);
                E1_COMPUTE(wA, xA, u);
            }
        }
    }
#undef E1_IDX
#undef E1_ROWS
#undef E1_X
#undef E1_COMPUTE
}
template <bool DUMMY2> __device__ void phase_peer_e2(const Params& P, int layer) {
    const unsigned* PD = (const unsigned*)(P.ws + WS_PD);
    const unsigned short* IDX = (const unsigned short*)(P.ws + WS_IDX);
    float* GATE = (float*)(P.ws + WS_GATE);
    unsigned* IW = DUMMY2 ? (unsigned*)(P.ws + WS_STAT + (size_t)T_TOK * 64) : (unsigned*)GATE;
    const float* SU = (const float*)(P.ws + WS_SU) + layer * 16384;
    const float* SV = (const float*)(P.ws + WS_SV) + layer * 16384;
    for (size_t i4 = (size_t)obid() * NTHREADS + otid(); i4 < (size_t)T_TOK * 16; i4 += (size_t)gridDim.x * NTHREADS) {
        const size_t t = i4 >> 4; const int e = (int)(i4 & 15) * 4;
        f32x4 dlo = {0.f, 0.f, 0.f, 0.f}, dhi = {0.f, 0.f, 0.f, 0.f};
#pragma unroll
        for (int j = 0; j < 4; ++j) { const u32x4 w = *(const u32x4*)(PD + (t * 4 + j) * 64 + e);
#pragma unroll
            for (int c = 0; c < 4; ++c) { dlo[c] += bflo(w[c]); dhi[c] += bfhi(w[c]); } }
        const u32x2 ia = *(const u32x2*)(IDX + t * 128 + e), ib = *(const u32x2*)(IDX + t * 128 + 64 + e);
        const int il[4] = {(int)(ia.x & 0xffffu), (int)(ia.x >> 16), (int)(ia.y & 0xffffu), (int)(ia.y >> 16)};
        const int ih[4] = {(int)(ib.x & 0xffffu), (int)(ib.x >> 16), (int)(ib.y & 0xffffu), (int)(ib.y >> 16)};
        const f32x4 gl = *(const f32x4*)(GATE + t * 128 + e), gh = *(const f32x4*)(GATE + t * 128 + 64 + e);
        u32x4 ol, oh;
#pragma unroll
        for (int c = 0; c < 4; ++c) {
            const float wl = gl[c] * SV[il[c]] * gelu_cdf_(SU[il[c]] * dlo[c]), wh = gh[c] * SV[ih[c]] * gelu_cdf_(SU[ih[c]] * dhi[c]);
            ol[c] = (cvt_pk_bf16(0.f, wl) & 0xffff0000u) | (unsigned)il[c];
            oh[c] = (cvt_pk_bf16(0.f, wh) & 0xffff0000u) | (unsigned)ih[c];
        }
        *(u32x4*)(IW + t * 128 + e) = ol; *(u32x4*)(IW + t * 128 + 64 + e) = oh;
    }
}
template <int QW, bool DUMMY> __device__ void phase_peer_e3(const Params& P, int layer) {
    const int lane = otid() & 63, es = lane >> 3, ck = lane & 7;
    const unsigned char* V4 = P.ws + WS_V8 + (size_t)layer * 16384 * 512;
    const unsigned* IW = (const unsigned*)(P.ws + WS_GATE);
    float* STAT = (float*)(P.ws + WS_STAT);
    const int myx = (int)(xb_xcc_id() & 3u);
    const bool b5 = (lane & 32) != 0, b4 = (lane & 16) != 0, b3 = (lane & 8) != 0;
    for (int k = 0; k < 4; ++k) {
        const int j = (myx + k) & 3;
        const unsigned char* Vs = V4 + (size_t)j * (16384 * 128) + ck * 16;
        for (;;) {
            const int tq = peer_pull<QW>(P, layer, j, lane);
            if (tq >= T_TOK) break;
            unsigned iwn[16];
#pragma unroll
            for (int i = 0; i < 16; ++i) iwn[i] = IW[(size_t)tq * 128 + i * 8 + es];
            for (int t = tq; t < tq + 16; ++t) {
                int idx[16]; float wg[16];
#pragma unroll
                for (int i = 0; i < 16; ++i) { idx[i] = (int)(iwn[i] & 0xffffu); wg[i] = __uint_as_float(iwn[i] & 0xffff0000u); }
                u32x4 w[16];
#pragma unroll
                for (int i = 0; i < 16; ++i) w[i] = *(const u32x4*)(Vs + (size_t)idx[i] * 128);
                if (t + 1 < tq + 16) {
#pragma unroll
                    for (int i = 0; i < 16; ++i) iwn[i] = IW[(size_t)(t + 1) * 128 + i * 8 + es];
                }
                bf16_t* hrow = (bf16_t*)(P.ws + WS_HB) + (size_t)t * DM + j * 256 + ck * 32 + es * 4;
                bf16_t* yrow = DUMMY ? (bf16_t*)(P.ws + WS_PD) + (size_t)t * DM + j * 256 + ck * 32 + es * 4 : hrow;
                float* strow = DUMMY ? (float*)(P.ws + WS_PD) + (size_t)T_TOK * DM : STAT;
                const u32x2 hv = *(const u32x2*)hrow;
                h16x2 acc[16];
#pragma unroll
                for (int c = 0; c < 16; ++c) acc[c] = (h16x2){(_Float16)0.f, (_Float16)0.f};
#pragma unroll
                for (int i = 0; i < 16; ++i) {
                    const _Float16 wh = (_Float16)wg[i]; const h16x2 w2 = {wh, wh};
#pragma unroll
                    for (int q = 0; q < 4; ++q) { acc[4 * q] += FP4_H2(w[i][q], 0) * w2; acc[4 * q + 1] += FP4_H2(w[i][q], 1) * w2; acc[4 * q + 2] += FP4_H2(w[i][q], 2) * w2; acc[4 * q + 3] += FP4_H2(w[i][q], 3) * w2; }
                }
                h16x2 r16[8];
#pragma unroll
                for (int c = 0; c < 8; ++c) {
                    const h16x2 keep = b5 ? acc[8 + c] : acc[c], send = b5 ? acc[c] : acc[8 + c];
                    r16[c] = keep + __builtin_bit_cast(h16x2, __shfl_xor(__builtin_bit_cast(int, send), 32));
                }
                h16x2 r8[4];
#pragma unroll
                for (int c = 0; c < 4; ++c) {
                    const h16x2 keep = b4 ? r16[4 + c] : r16[c], send = b4 ? r16[c] : r16[4 + c];
                    r8[c] = keep + __builtin_bit_cast(h16x2, __shfl_xor(__builtin_bit_cast(int, send), 16));
                }
                f32x2 r4[2];
#pragma unroll
                for (int c = 0; c < 2; ++c) {
                    const h16x2 keep = b3 ? r8[2 + c] : r8[c], send = b3 ? r8[c] : r8[2 + c];
                    const h16x2 got = __builtin_bit_cast(h16x2, __builtin_amdgcn_mov_dpp(__builtin_bit_cast(int, send), 0x128, 0xf, 0xf, true));
                    r4[c] = (f32x2){(float)keep[0] + (float)got[0], (float)keep[1] + (float)got[1]};
                }
                float y[4];
                y[0] = DN_ALPHA * bflo(hv.x) + r4[0][0]; y[1] = DN_ALPHA * bfhi(hv.x) + r4[0][1]; y[2] = DN_ALPHA * bflo(hv.y) + r4[1][0]; y[3] = DN_ALPHA * bfhi(hv.y) + r4[1][1];
                u32x2 ov; ov.x = cvt_pk_bf16(y[0], y[1]); ov.y = cvt_pk_bf16(y[2], y[3]);
                *(u32x2*)yrow = ov;
                float s1 = (y[0] + y[1]) + (y[2] + y[3]), s2 = (y[0] * y[0] + y[1] * y[1]) + (y[2] * y[2] + y[3] * y[3]);
                s1 = wave_sum_dpp(s1); s2 = wave_sum_dpp(s2);
                if (lane == 0) { strow[((size_t)t * 4 + j) * 2] = s1; strow[((size_t)t * 4 + j) * 2 + 1] = s2; }
            }
        }
    }
}
__device__ void phase_peer_e4(const Params& P, int layer) {
    ln_rows_bf16<true>((bf16_t*)(P.ws + WS_HB), P.ws + WS_HB8, (layer == DEPTH - 1) ? P.out : nullptr, (const float*)(P.ws + WS_STAT), P.ln2_g + layer * DM, P.ln2_b + layer * DM);
}

constexpr int N_SUB = 12;
constexpr int N_PHASES = 1 + N_SUB * DEPTH;
__global__ void __launch_bounds__(NTHREADS, 2) fwd_megakernel(Params P) {
    extern __shared__ __attribute__((aligned(16))) unsigned char lds_raw[];
    LAS unsigned char* lds = (LAS unsigned char*)lds_raw;
    cg::grid_group grid = cg::this_grid();
    unsigned char* ws = P.ws;
    volatile LAS unsigned* xb_st = (volatile LAS unsigned*)(lds + LDS_BYTES - 32);
    if (otid() < 2) xb_st[otid()] = 0u;
    __syncthreads();
    const XcdBarrier xbar = xcd_barrier_post((unsigned*)(ws + WS_CTL + 4096), xb_st);
#ifdef DEBUG_COPY
    const int ph_end = P.ph_hi + 1;
#else
    const int ph_end = P.ph_hi;
#endif
    for (int ph = P.ph_lo; ph < ph_end; ++ph) {
        if (ph > P.ph_lo) {
            if (ph == 1) {
                asm volatile("s_waitcnt vmcnt(0)" ::: "memory");
                __syncthreads();
                grid.sync();
                if (otid() < 64) { __builtin_amdgcn_fence(__ATOMIC_ACQUIRE, "agent"); asm volatile("s_waitcnt vmcnt(0)" ::: "memory"); }
                __syncthreads();
            } else {
                xcd_barrier(xbar);
            }
        }
#ifdef TS_SUB
        if (obid() == 0 && otid() == 0) ((unsigned long long*)(ws + WS_CTL + 32768))[ph] = __builtin_amdgcn_s_memrealtime();
#endif
        if (ph == 0) { phase_prep(P, lds); continue; }
#ifdef DEBUG_COPY
        if (ph == P.ph_hi) {
            const bf16_t* proj = (const bf16_t*)(ws + WS_PROJ);
            const float* DTp = (const float*)(ws + WS_DT);
            for (size_t i = (size_t)obid() * NTHREADS + otid(); i < (size_t)T_TOK * 1024; i += (size_t)gridDim.x * NTHREADS) {
                const size_t t = i >> 10; const int c = (int)(i & 1023);
                float v;
                if (c < 256) v = bf2f(proj[t * PROJ_LD + C_K + c]);
                else if (c < 1008) v = bf2f(proj[t * PROJ_LD + C_XBC + (c - 256) * 2]);
                else v = DTp[t * 16 + (c - 1008)];
                P.out[i] = v;
            }
            continue;
        }
#endif
        const int layer = (ph - 1) / N_SUB, sub = (ph - 1) % N_SUB;
        if (sub == 0 || sub == 4 || sub == 6) {
            pg8::Gemm g; pg8::Epi E; int N; bool f8;
            if (sub == 0) {
                f8 = FP8_IN;
                if (FP8_IN) g = pg8::Gemm{(const bf16_t*)(ws + WS_HB8), (const bf16_t*)(ws + WS_WIN8 + (size_t)layer * N_IN * 1024), T_TOK, N_IN, 512, 512, 1 << 30, 0};
                else g = pg8::Gemm{(const bf16_t*)(ws + WS_HB), (const bf16_t*)(ws + WS_WIN) + (size_t)layer * N_IN * 1024, T_TOK, N_IN, 1024, 1024, 1 << 30, 0};
                E.mode = 0; E.eb = pg8::EpiBf16{(bf16_t*)(ws + WS_PROJ), PROJ_LD, 3584, (size_t)3600, FP8_IN ? 1.f / 32.f : 1.f}; E.er = pg8::EpiResBf16{nullptr, 0, 0.f, 1.f}; N = N_IN;
            } else if (sub == 4) {
                f8 = FP8_OUT;
                if (FP8_OUT) g = pg8::Gemm{(const bf16_t*)(ws + WS_PROJ), (const bf16_t*)(ws + WS_WOUT8 + (size_t)layer * 1024 * MIXW), T_TOK, 1024, 1024, PROJ_LD, 1 << 30, 0};
                else g = pg8::Gemm{(const bf16_t*)(ws + WS_PROJ) + C_GATE, (const bf16_t*)(ws + WS_WOUT) + (size_t)layer * 1024 * MIXW, T_TOK, 1024, MIXW, PROJ_LD, 24, (C_Q - (C_GATE + 1536)) * 2};
                E.mode = 1; E.eb = pg8::EpiBf16{nullptr, 0, 0, (size_t)0, 1.f}; E.er = pg8::EpiResBf16{(bf16_t*)(ws + WS_HB), DM, DN_ALPHA, FP8_OUT ? 1.f / 64.f : 1.f}; N = 1024;
            } else {
                f8 = FP8_Q;
                if (FP8_Q) g = pg8::Gemm{(const bf16_t*)(ws + WS_HB8), (const bf16_t*)(ws + WS_WQ8 + (size_t)layer * 1024 * 1024), T_TOK, 1024, 512, 512, 1 << 30, 0};
                else g = pg8::Gemm{(const bf16_t*)(ws + WS_HB), (const bf16_t*)(ws + WS_WQ) + (size_t)layer * 1024 * 1024, T_TOK, 1024, 1024, 1024, 1 << 30, 0};
                E.mode = 0; E.eb = pg8::EpiBf16{(bf16_t*)(ws + WS_QP), DM, 0, (size_t)0, FP8_Q ? 1.f / 32.f : 1.f}; E.er = pg8::EpiResBf16{nullptr, 0, 0.f, 1.f}; N = 1024;
            }
            pg8::StaticOrder S; S.init(T_TOK, N, (int)gridDim.x, (int)obid());
            __syncthreads();
            if (f8) pg8::gemm_phase<true>(lds, g, S, E); else pg8::gemm_phase<false>(lds, g, S, E);
#ifdef EXP_GEMM_TWICE
            if (sub == EXP_GEMM_TWICE) { xcd_barrier(xbar); __syncthreads(); if (f8) pg8::gemm_phase<true>(lds, g, S, E); else pg8::gemm_phase<false>(lds, g, S, E); }
#endif
            if (sub == 0) phase_dt(P, layer);
        } else if (sub == 1) {
            phase_conv(P, layer);
        } else if (sub == 2) {
#ifndef SKIP_MIX
            phase_mixers(P, layer, lds);
#endif
        } else if (sub == 3) {
            if (FP8_OUT) phase_ssdnorm(P); else phase_ssdnorm_bf16(P);
        } else if (sub == 5) {
            ln_rows_bf16<false>((bf16_t*)(ws + WS_HB), ws + WS_HB8, nullptr, nullptr, P.ln1_g + layer * DM, P.ln1_b + layer * DM);
        } else if (sub == 7) {
            phase_peer_topk(P, layer, lds);
#ifdef EXP_TOPK_TWICE
            xcd_barrier(xbar);
            phase_peer_topk(P, layer, lds);
#endif
        } else if (sub == 8) {
            phase_peer_e1<CTLW_QE1>(P, layer);
#ifdef EXP_E1_TWICE
            xcd_barrier(xbar);
            phase_peer_e1<7168>(P, layer);
#endif
        } else if (sub == 9) {
#ifdef EXP_E2_DUMMY
            phase_peer_e2<true>(P, layer);
            xcd_barrier(xbar);
#endif
            phase_peer_e2<false>(P, layer);
        } else if (sub == 10) {
#ifdef EXP_E3_DUMMY
            phase_peer_e3<7168, true>(P, layer);
            xcd_barrier(xbar);
#endif
            phase_peer_e3<CTLW_QE3, false>(P, layer);
        } else {
            phase_peer_e4(P, layer);
        }
    }
#ifdef TS_SUB
    if (obid() == 0 && otid() == 0) {
        unsigned long long* ts = (unsigned long long*)(ws + WS_CTL + 32768);
        const unsigned long long now = __builtin_amdgcn_s_memrealtime();
        ts[P.ph_hi] = now;
        unsigned long long d = 0;
        for (int ph = 0; ph < P.ph_hi; ++ph) {
            const bool sel = (TS_SUB == 20) ? (ph == 0) : (ph > 0 && ((ph - 1) % N_SUB) == TS_SUB);
            if (sel) d += ts[ph + 1] - ts[ph];
        }
        if (TS_SUB == 21) d = (ts[P.ph_hi] - ts[0]) / TS_AMP;
        if (TS_SUB >= 9 && TS_SUB < 20) d = ((unsigned long long*)(ws + WS_CTL + 40960))[TS_SUB];
        d *= TS_AMP;
        while (__builtin_amdgcn_s_memrealtime() - now < d) __builtin_amdgcn_s_sleep(32);
    }
#endif
}

extern "C" void kernel_launch(void* const* d_in, const int* in_sizes, int n_in, void* d_out, int out_size, void* d_ws, size_t ws_size, hipStream_t stream) {
    static int grid_blocks = 0;
    if (grid_blocks == 0) {
        if (n_in != 27 || out_size != T_TOK * DM || ws_size < WS_END) { fprintf(stderr, "kernel_launch: unexpected shapes (n_in %d out %d ws %zu need %zu)\n", n_in, out_size, ws_size, (size_t)WS_END); grid_blocks = -1; return; }
        int dev = 0, cus = 0, per_cu = 0;
        hipGetDevice(&dev);
        hipDeviceGetAttribute(&cus, hipDeviceAttributeMultiprocessorCount, dev);
        if (hipFuncSetAttribute((const void*)fwd_megakernel, hipFuncAttributeMaxDynamicSharedMemorySize, LDS_BYTES) != hipSuccess) { fprintf(stderr, "kernel_launch: hipFuncSetAttribute failed\n"); grid_blocks = -1; return; }
        hipOccupancyMaxActiveBlocksPerMultiprocessor(&per_cu, (const void*)fwd_megakernel, NTHREADS, LDS_BYTES);
        if (per_cu < 1) { fprintf(stderr, "kernel_launch: occupancy query says %d blocks per CU\n", per_cu); grid_blocks = -1; return; }
        grid_blocks = cus;
    }
    if (grid_blocks < 0) return;
    hipMemsetAsync((char*)d_ws + WS_CTL, 0, 65536, stream);
    Params p{};
    const float** pp = (const float**)&p;
    for (int i = 0; i < 27; ++i) pp[i] = (const float*)d_in[i];
    p.out = (float*)d_out; p.ws = (unsigned char*)d_ws; p.ph_lo = 0; p.ph_hi = PH_HI;
    void* args[] = {&p};
    hipError_t e = hipLaunchCooperativeKernel((const void*)fwd_megakernel, dim3(grid_blocks), dim3(NTHREADS), args, LDS_BYTES, stream);
    if (e != hipSuccess) fprintf(stderr, "cooperative launch failed: %s (grid %d)\n", hipGetErrorString(e), grid_blocks);
}
```

```cpp
#include <hip/hip_runtime.h>
#include <hip/hip_cooperative_groups.h>
#include <cstdio>
#include <cstdint>
namespace cg = cooperative_groups;
#ifndef PH_HI
#define PH_HI N_PHASES
#endif
#ifdef TS_SUB
#ifndef TS_AMP
#define TS_AMP 4
#endif
#endif
#ifndef FP8_IN
#define FP8_IN 0
#endif
#ifndef FP8_OUT
#define FP8_OUT 1
#endif
#ifndef FP8_Q
#define FP8_Q 0
#endif
#if FP8_OUT && (FP8_IN || FP8_Q)
#error "the fp8 mix buffer shares workspace with the fp8 copies of the other GEMMs"
#endif
#ifndef MIX_MASK
#define MIX_MASK 7
#endif

#define LAS __attribute__((address_space(3)))
typedef unsigned short bf16_t;
typedef short bf16x8 __attribute__((ext_vector_type(8)));
typedef float f32x4 __attribute__((ext_vector_type(4)));
typedef float f32x2 __attribute__((ext_vector_type(2)));
typedef unsigned u32x4 __attribute__((ext_vector_type(4)));
typedef unsigned u32x2 __attribute__((ext_vector_type(2)));
using bf16x2v = __attribute__((ext_vector_type(2))) __bf16;

constexpr int T_TOK = 65536, DM = 1024, SEQ = 4096, NBATCH = 16, DEPTH = 2;
constexpr int PROJ_LD = 4368;
constexpr int C_RGX = 0, C_GATE = 512, C_Z = 1024, C_XBC = 2048, C_DT = 3584, C_Q = 3600, C_K = 4112, C_V = 4240;
constexpr int N_IN = 4352;
constexpr int MIXW = 2048;
constexpr float DN_ALPHA = 1.41421356237f;
constexpr float LN_EPS = 1e-5f;
constexpr int NTHREADS = 512;
constexpr int LDS_BYTES = 147456;

constexpr size_t WS_CTL  = 0;
constexpr size_t WS_WIN  = 65536;
constexpr size_t WS_WDT  = WS_WIN  + (size_t)2 * N_IN * 1024 * 2;
constexpr size_t WS_WOUT = WS_WDT  + (size_t)2 * 16 * 1024 * 2;
constexpr size_t WS_WQ   = WS_WOUT + (size_t)2 * 1024 * 2048 * 2;
constexpr size_t WS_KEYS = WS_WQ   + (size_t)2 * 1024 * 1024 * 2;
constexpr size_t WS_WA   = WS_KEYS + (size_t)2 * 2 * 128 * 64 * 2;
constexpr size_t WS_WX   = WS_WA   + (size_t)2 * 8 * 64 * 64 * 2;
constexpr size_t WS_U    = WS_WX   + (size_t)2 * 8 * 64 * 64 * 2;
constexpr size_t WS_V    = WS_U    + (size_t)2 * 16384 * 1024 * 2;
constexpr size_t WS_HB   = WS_V    + (size_t)2 * 16384 * 1024 * 2;
constexpr size_t WS_DT   = WS_HB   + (size_t)T_TOK * 1024 * 2;
constexpr size_t WS_SSQ  = WS_DT   + (size_t)T_TOK * 16 * 4;
constexpr size_t WS_PROJ = WS_SSQ  + (size_t)T_TOK * 16 * 4;
constexpr size_t WS_PEND = WS_PROJ + (size_t)T_TOK * PROJ_LD * 2;
constexpr size_t WS_HB8  = WS_PEND;
constexpr size_t WS_WIN8 = WS_HB8 + (size_t)T_TOK * 1024;
constexpr size_t WS_WQ8  = WS_WIN8 + (size_t)2 * N_IN * 1024;
constexpr size_t WS_MIX8 = WS_PEND;
constexpr size_t WS_WOUT8 = WS_MIX8 + (size_t)T_TOK * MIXW;
constexpr size_t WS_END  = WS_WOUT8 + (size_t)2 * 1024 * MIXW;
constexpr size_t WS_U8 = WS_U, WS_SU = WS_U + (size_t)2 * 16384 * 1024;
constexpr size_t WS_V8 = WS_V, WS_SV = WS_V + (size_t)2 * 16384 * 1024;
constexpr size_t WS_QP   = WS_PROJ;
constexpr size_t WS_IDX  = WS_QP  + (size_t)T_TOK * 1024 * 2;
constexpr size_t WS_GATE = WS_IDX + (size_t)T_TOK * 128 * 4;
constexpr size_t WS_PD   = WS_GATE + (size_t)T_TOK * 128 * 4;
constexpr size_t WS_STAT = WS_PD + (size_t)T_TOK * 8 * 128 * 4;
static_assert(WS_STAT + (size_t)T_TOK * 8 * 2 * 4 <= WS_PEND, "PEER buffers must fit inside the proj region");
static_assert(WS_END <= ((size_t)1 << 30), "workspace must fit 1 GiB");
constexpr int CTLW_QE1 = 5120, CTLW_QE3 = 6144;

struct Params {
    const float* x; const float* emb_g; const float* emb_b; const float* w_in; const float* rg_conv_w; const float* rg_conv_b;
    const float* rg_wa; const float* rg_ba; const float* rg_wx; const float* rg_bx; const float* rg_lambda;
    const float* ssm_conv_w; const float* ssm_conv_b; const float* ssm_dt_bias; const float* ssm_a_log; const float* ssm_d; const float* ssm_norm_g;
    const float* attn_sinks; const float* w_out; const float* ln1_g; const float* ln1_b;
    const float* peer_wq; const float* peer_keys; const float* peer_u; const float* peer_v; const float* ln2_g; const float* ln2_b;
    float* out; unsigned char* ws; int ph_lo, ph_hi;
};

typedef __bf16 bf16x2n __attribute__((ext_vector_type(2)));
__device__ __forceinline__ unsigned cvt_pk_bf16(float lo, float hi) { const f32x2 v = {lo, hi}; const bf16x2n r = __builtin_convertvector(v, bf16x2n); return __builtin_bit_cast(unsigned, r); }
__device__ __forceinline__ bf16_t f2bf(float f) { return (bf16_t)(cvt_pk_bf16(f, 0.f) & 0xffffu); }
__device__ __forceinline__ float bf2f(bf16_t b) { return __uint_as_float(((unsigned)b) << 16); }
__device__ __forceinline__ float bflo(unsigned w) { return __uint_as_float(w << 16); }
__device__ __forceinline__ float bfhi(unsigned w) { return __uint_as_float(w & 0xffff0000u); }
__device__ __forceinline__ float sigmoidf_(float x) { return 1.f / (1.f + __expf(-x)); }
__device__ __forceinline__ float siluf_(float x) { return x / (1.f + __expf(-x)); }
__device__ __forceinline__ float softplusf_(float x) { return x > 20.f ? x : log1pf(__expf(x)); }
__device__ __forceinline__ float gelu_tanhf_(float x) { const float u = 0.7978845608028654f * (x + 0.044715f * x * x * x); const float t = 1.f - 2.f / (__expf(2.f * u) + 1.f); return 0.5f * x * (1.f + t); }
__device__ __forceinline__ float gelu_erff_(float x) { return 0.5f * x * (1.f + erff(x * 0.70710678118654752f)); }
__device__ __forceinline__ float wave_sum(float v) {
#pragma unroll
    for (int o = 32; o > 0; o >>= 1) v += __shfl_xor(v, o);
    return v;
}
template <int CTRL> __device__ __forceinline__ float dpp_(float x) { return __builtin_bit_cast(float, __builtin_amdgcn_mov_dpp(__builtin_bit_cast(int, x), CTRL, 0xf, 0xf, true)); }
__device__ __forceinline__ float row_sum16(float x) { x += dpp_<0xB1>(x); x += dpp_<0x4E>(x); x += dpp_<0x141>(x); x += dpp_<0x128>(x); return x; }
__device__ __forceinline__ float rdlane(float x, int l) { return __builtin_bit_cast(float, __builtin_amdgcn_readlane(__builtin_bit_cast(int, x), l)); }
__device__ __forceinline__ float wave_sum_dpp(float x) { x = row_sum16(x); return (rdlane(x, 0) + rdlane(x, 16)) + (rdlane(x, 32) + rdlane(x, 48)); }
__device__ __forceinline__ float gelu_cdf_(float v) {
    const float av = fabsf(v), t = __builtin_amdgcn_rcpf(av * 0.2316418882f + 1.0f);
    float q = t * 0.5307027145f + (-0.7265760135f); q = q * t + 0.7107068705f; q = q * t + (-0.142248368f); q = q * t + 0.127414796f; q = q * t;
    const float e = __builtin_amdgcn_exp2f(v * v * (-0.72134752044f));
    const float m = v * (q * e), r = v - m;
    return v < 0.f ? m : r;
}
__device__ __forceinline__ float dot2bf(unsigned a, unsigned b, float acc) { return __builtin_amdgcn_fdot2_f32_bf16(__builtin_bit_cast(bf16x2v, a), __builtin_bit_cast(bf16x2v, b), acc, false); }
__device__ __forceinline__ unsigned umax_(unsigned a, unsigned b) { return a > b ? a : b; }
__device__ __forceinline__ unsigned umin_(unsigned a, unsigned b) { return a < b ? a : b; }
__device__ __forceinline__ u32x2 cvt8_fp8(const float* v, float sc) {
    int a = 0, b = 0;
    a = __builtin_amdgcn_cvt_pk_fp8_f32(v[0] * sc, v[1] * sc, a, false); a = __builtin_amdgcn_cvt_pk_fp8_f32(v[2] * sc, v[3] * sc, a, true);
    b = __builtin_amdgcn_cvt_pk_fp8_f32(v[4] * sc, v[5] * sc, b, false); b = __builtin_amdgcn_cvt_pk_fp8_f32(v[6] * sc, v[7] * sc, b, true);
    u32x2 r; r.x = (unsigned)a; r.y = (unsigned)b; return r;
}
__device__ __forceinline__ int otid() { int t = (int)threadIdx.x; asm volatile("" : "+v"(t)); return t; }
__device__ __forceinline__ int obid() { int b = (int)blockIdx.x; asm volatile("" : "+s"(b)); return b; }
#define MFMA16(a, b, c) __builtin_amdgcn_mfma_f32_16x16x32_bf16((a), (b), (c), 0, 0, 0)

#define XB_TMO      128
#define XB_XCNT(j)  (256  + 64 * (j))
#define XB_XSUB(j)  (1280 + 64 * (j))
#define XB_XGEN(j)  (2304 + 64 * (j))
#define XB_TOP      3328
#define XB_TOPGEN   3392
#define XCD_BAR_WORDS 3456
#define XB_SPIN_CAP (1u << 22)
__device__ __forceinline__ unsigned xb_ld(unsigned* p)              { return __hip_atomic_load(p, __ATOMIC_RELAXED, __HIP_MEMORY_SCOPE_AGENT); }
__device__ __forceinline__ unsigned xb_add(unsigned* p, unsigned v) { return __hip_atomic_fetch_add(p, v, __ATOMIC_RELAXED, __HIP_MEMORY_SCOPE_AGENT); }
__device__ __forceinline__ unsigned xb_xcc_id() { return (unsigned)__builtin_amdgcn_s_getreg((3 << 11) | 20) & 0xFu; }
#define XB_SPIN(cond, bar) do { unsigned _sp = 0; while (cond) { __builtin_amdgcn_s_sleep(1); \
    if ((++_sp & 255u) == 0u) { if (xb_ld(&(bar)[XB_TMO])) break; if (_sp > XB_SPIN_CAP) { atomicAdd(&(bar)[XB_TMO], 1u); break; } } } } while (0)
struct XcdBarrier { unsigned* bar; unsigned x; volatile LAS unsigned* st; };
__device__ __forceinline__ XcdBarrier xcd_barrier_post(unsigned* bar, volatile LAS unsigned* st) {
    XcdBarrier b; b.bar = bar; b.x = xb_xcc_id(); b.st = st;
    if (otid() == 0) (void)xb_add(&bar[XB_XCNT(b.x)], 1u);
    return b;
}
__device__ __forceinline__ void xcd_barrier_complete(unsigned* bar, unsigned x, unsigned& nloc, unsigned& nx) {
    const unsigned G = gridDim.x * gridDim.y * gridDim.z;
    unsigned sum, cnt, mine, sp = 0u;
    for (;;) {
        sum = 0u; cnt = 0u; mine = 0u;
#pragma unroll
        for (unsigned j = 0; j < 16; ++j) { const unsigned c = xb_ld(&bar[XB_XCNT(j)]); sum += c; cnt += (c > 0u) ? 1u : 0u; mine = (j == x) ? c : mine; }
        if (sum == G) break;
        __builtin_amdgcn_s_sleep(1);
        if ((++sp & 255u) == 0u) { if (xb_ld(&bar[XB_TMO])) break; if (sp > XB_SPIN_CAP) { atomicAdd(&bar[XB_TMO], 1u); break; } }
    }
    nloc = mine > 0u ? mine : 1u; nx = cnt > 0u ? cnt : 1u;
}
__device__ __forceinline__ void xcd_barrier(const XcdBarrier& b) {
    asm volatile("s_waitcnt vmcnt(0)" ::: "memory");
    __syncthreads();
    if (otid() == 0) {
        unsigned* bar = b.bar;
        __builtin_amdgcn_s_waitcnt(0);
        unsigned nloc = b.st[0], nx = b.st[1];
        if (nloc == 0u) { xcd_barrier_complete(bar, b.x, nloc, nx); b.st[0] = nloc; b.st[1] = nx; }
        const unsigned old = xb_add(&bar[XB_XSUB(b.x)], 1u);
        const unsigned gen = old / nloc;
        if (old + 1u == (gen + 1u) * nloc) {
            __builtin_amdgcn_fence(__ATOMIC_RELEASE, "agent");
            asm volatile("s_waitcnt vmcnt(0)" ::: "memory");
            const unsigned og = xb_add(&bar[XB_TOP], 1u);
            const unsigned tg = og / nx;
            if (og + 1u == (tg + 1u) * nx) xb_add(&bar[XB_TOPGEN], 1u);
            else XB_SPIN(xb_ld(&bar[XB_TOPGEN]) == tg, bar);
            __builtin_amdgcn_fence(__ATOMIC_ACQUIRE, "agent");
            xb_add(&bar[XB_XGEN(b.x)], 1u);
            asm volatile("s_waitcnt vmcnt(0)" ::: "memory");
        } else {
            XB_SPIN(xb_ld(&bar[XB_XGEN(b.x)]) == gen, bar);
            __builtin_amdgcn_fence(__ATOMIC_ACQUIRE, "agent");
            asm volatile("s_waitcnt vmcnt(0)" ::: "memory");
        }
    }
    __syncthreads();
}

namespace pg8 {
typedef int v8i32_t __attribute__((ext_vector_type(8)));
typedef int v4i32_t __attribute__((ext_vector_type(4)));
constexpr int BM = 256, BK = 64, HALF = 128, HTB = HALF * BK * 2, STAGE_BYTES = 8 * HTB, NXCD = 8, WGM = 4;
__device__ __forceinline__ int lds_byte(int r, int c) { const int st = (r >> 4) * 2 + (c >> 5), rr = r & 15, cc = c & 31, ob = rr * 64 + cc * 2; return st * 1024 + (ob ^ (((ob >> 9) & 1) << 5)); }
__device__ __forceinline__ void stage_rc(int b, int& R, int& C) { const int st = b / 1024, sb = b % 1024, swz = sb ^ (((sb >> 9) & 1) << 5); R = (st >> 1) * 16 + swz / 64; C = (st & 1) * 32 + (swz % 64) / 2; }
__device__ __forceinline__ int perm32(int rho) { const int n = rho >> 4, i = rho & 15; return 8 * (i >> 2) + 4 * n + (i & 3); }
struct Unit { int pm, pn; };
struct Gemm { const bf16_t* A; const bf16_t* Bt; int M, N, K, lda, ksplit, kextra; };
struct StaticOrder {
    int nM, nN, nwg, G, c;
    __device__ void init(int M, int N, int G_, int c_) { nM = M / BM; nN = N / BM; nwg = nM * nN; G = G_; c = c_; }
    __device__ bool next(int i, Unit& u) const {
        const long L = (long)i * G + c; if (L >= nwg) return false;
        int wgid = (int)L; { const int q = nwg / NXCD, r = nwg % NXCD, xcd = wgid % NXCD, off = wgid / NXCD; wgid = (xcd < r ? xcd * (q + 1) : r * (q + 1) + (xcd - r) * q) + off; }
        const int nig = WGM * nN, gid = wgid / nig, fm = gid * WGM, gsz = (nM - fm) < WGM ? (nM - fm) : WGM;
        u.pm = fm + ((wgid % nig) % gsz); u.pn = (wgid % nig) / gsz; return true;
    }
};
struct EpiBf16 {
    static constexpr bool PERM = true;
    bf16_t* O; int ldc; int split_cols; size_t split_stride; float oscale;
    __device__ __forceinline__ void operator()(const f32x4 (&acc)[2][2][4][2], const Unit& u, int wr, int wc, int fr, int fq) const {
        const int row0 = u.pm * BM + wr * 64 + fr; int colt = u.pn * BM; bf16_t* base = O;
        if (split_cols) { const int t = colt / split_cols; base += (size_t)t * split_stride; colt -= t * split_cols; }
        const int col0 = colt + wc * 32 + 8 * fq;
#pragma unroll
        for (int ai = 0; ai < 2; ++ai)
#pragma unroll
            for (int m = 0; m < 4; ++m) { bf16_t* rowp = base + (size_t)(row0 + ai * HALF + m * 16) * ldc + col0;
#pragma unroll
                for (int bj = 0; bj < 2; ++bj) { const f32x4 v0 = acc[ai][bj][m][0] * oscale, v1 = acc[ai][bj][m][1] * oscale;
                    u32x4 w; w.x = cvt_pk_bf16(v0[0], v0[1]); w.y = cvt_pk_bf16(v0[2], v0[3]); w.z = cvt_pk_bf16(v1[0], v1[1]); w.w = cvt_pk_bf16(v1[2], v1[3]);
                    *(u32x4*)(rowp + bj * HALF) = w; } }
    }
};
struct EpiResBf16 {
    bf16_t* H; int ldc; float alpha; float oscale;
    __device__ __forceinline__ void operator()(const f32x4 (&acc)[2][2][4][2], const Unit& u, int wr, int wc, int fr, int fq) const {
        const int row0 = u.pm * BM + wr * 64 + fr, col0 = u.pn * BM + wc * 32 + 8 * fq;
#pragma unroll
        for (int ai = 0; ai < 2; ++ai)
#pragma unroll
            for (int m = 0; m < 4; ++m) { bf16_t* rowp = H + (size_t)(row0 + ai * HALF + m * 16) * ldc + col0;
#pragma unroll
                for (int bj = 0; bj < 2; ++bj) { u32x4* p = (u32x4*)(rowp + bj * HALF); const u32x4 h = *p; const f32x4 v0 = acc[ai][bj][m][0] * oscale, v1 = acc[ai][bj][m][1] * oscale;
                    u32x4 w; w.x = cvt_pk_bf16(alpha * bflo(h.x) + v0[0], alpha * bfhi(h.x) + v0[1]); w.y = cvt_pk_bf16(alpha * bflo(h.y) + v0[2], alpha * bfhi(h.y) + v0[3]);
                    w.z = cvt_pk_bf16(alpha * bflo(h.z) + v1[0], alpha * bfhi(h.z) + v1[1]); w.w = cvt_pk_bf16(alpha * bflo(h.w) + v1[2], alpha * bfhi(h.w) + v1[3]);
                    *p = w; } }
    }
};
struct Epi {
    int mode; EpiBf16 eb; EpiResBf16 er;
};
template <bool FP8>
__device__ __forceinline__ void gemm_phase(LAS unsigned char* lds, const Gemm g, const StaticOrder& S, const Epi& E) {
    const int tid = otid(), wid = __builtin_amdgcn_readfirstlane(tid >> 6), lane = tid & 63, wr = wid >> 2, wc = wid & 3, fr = lane & 15, fq = lane >> 4;
    const int K = g.K, nt = K / BK, lda = g.lda;
    unsigned voffA[2], voffB[2];
#pragma unroll
    for (int i = 0; i < 2; ++i) { int R, C; stage_rc(tid * 16 + i * 8192, R, C); const int Rb = (R & ~31) + perm32(R & 31);
        voffA[i] = (unsigned)(R * lda + C) * 2u; voffB[i] = (unsigned)(Rb * K + C) * 2u; }
    const size_t kstep = (size_t)(BK * 2);
    const size_t hstepA = (size_t)HALF * lda * 2, hstepB = (size_t)HALF * K * 2;
    const size_t tstepA = 2 * hstepA, tstepB = 2 * hstepB;
    const int ksplit = g.ksplit; const size_t kextra = (size_t)g.kextra;
#define PG8_AKOFF(t) ((size_t)(t) * kstep + (((t) >= ksplit) ? kextra : (size_t)0))
    const unsigned ldsw = (unsigned)wid * 1024u;
    const int aoff = lds_byte(wr * 64 + fr, fq * 8), boff = lds_byte(wc * 32 + fr, fq * 8);
#define PG8_SA(b, h) (((b) * 2 + (h)) * HTB)
#define PG8_SB(b, h) ((4 + (b) * 2 + (h)) * HTB)
#define PG8_STAGE(bufoff, gbase, voff) do { _Pragma("unroll") for (int _i = 0; _i < 2; ++_i) \
        __builtin_amdgcn_global_load_lds((const unsigned*)((const char*)(gbase) + (voff)[_i]), (LAS unsigned*)(lds + (bufoff) + ldsw + _i * 8192), 16, 0, 0); } while (0)
#define PG8_LDA(dst, b, h) do { _Pragma("unroll") for (int m = 0; m < 4; ++m) dst[m] = __builtin_shufflevector(*(const LAS v4i32_t*)(lds + PG8_SA(b, h) + aoff + m * 2048), *(const LAS v4i32_t*)(lds + PG8_SA(b, h) + aoff + m * 2048 + 1024), 0, 1, 2, 3, 4, 5, 6, 7); } while (0)
#define PG8_LDB(dst, b, h) do { _Pragma("unroll") for (int n = 0; n < 2; ++n) dst[n] = __builtin_shufflevector(*(const LAS v4i32_t*)(lds + PG8_SB(b, h) + boff + n * 2048), *(const LAS v4i32_t*)(lds + PG8_SB(b, h) + boff + n * 2048 + 1024), 0, 1, 2, 3, 4, 5, 6, 7); } while (0)
#define PG8_MMA8(ai, bj, At, Bt) do { __builtin_amdgcn_s_setprio(1); _Pragma("unroll") for (int m = 0; m < 4; ++m) _Pragma("unroll") for (int n = 0; n < 2; ++n) \
        asm volatile("s_nop 1\n\tv_mfma_scale_f32_16x16x128_f8f6f4 %0, %1, %2, %0, %3, %3 op_sel_hi:[0,0,0]" : "+v"(acc[ai][bj][m][n]) : "v"(Bt[n]), "v"(At[m]), "v"(mxscale)); \
        __builtin_amdgcn_s_setprio(0); } while (0)
#define PG8_MMA16(ai, bj, At, Bt) do { __builtin_amdgcn_s_setprio(1); _Pragma("unroll") for (int m = 0; m < 4; ++m) _Pragma("unroll") for (int n = 0; n < 2; ++n) { \
        acc[ai][bj][m][n] = __builtin_amdgcn_mfma_f32_16x16x32_bf16(__builtin_bit_cast(bf16x8, __builtin_shufflevector(Bt[n], Bt[n], 0, 1, 2, 3)), __builtin_bit_cast(bf16x8, __builtin_shufflevector(At[m], At[m], 0, 1, 2, 3)), acc[ai][bj][m][n], 0, 0, 0); \
        acc[ai][bj][m][n] = __builtin_amdgcn_mfma_f32_16x16x32_bf16(__builtin_bit_cast(bf16x8, __builtin_shufflevector(Bt[n], Bt[n], 4, 5, 6, 7)), __builtin_bit_cast(bf16x8, __builtin_shufflevector(At[m], At[m], 4, 5, 6, 7)), acc[ai][bj][m][n], 0, 0, 0); } \
        __builtin_amdgcn_s_setprio(0); } while (0)
#define PG8_MM(ai, bj, At, Bt) do { if (FP8) PG8_MMA8(ai, bj, At, Bt); else PG8_MMA16(ai, bj, At, Bt); } while (0)
#define PG8_WAIT_V(n) asm volatile("s_waitcnt vmcnt(" #n ")" ::: "memory")
#define PG8_WAIT_L(n) asm volatile("s_waitcnt lgkmcnt(" #n ")" ::: "memory")
#define PG8_BAR __builtin_amdgcn_s_barrier()
#define PG8_SCHED __builtin_amdgcn_sched_barrier(0)
    Unit cur, nxt; int ui = 0;
    if (!S.next(0, cur)) return;
    f32x4 acc[2][2][4][2];
#pragma unroll
    for (int a = 0; a < 2; ++a)
#pragma unroll
        for (int b = 0; b < 2; ++b)
#pragma unroll
            for (int m = 0; m < 4; ++m)
#pragma unroll
                for (int n = 0; n < 2; ++n) acc[a][b][m][n] = (f32x4){0.f, 0.f, 0.f, 0.f};
    v8i32_t At[4], B0[2], B1[2];
    const int mxscale = 0x7F7F7F7F;
    const char* cA = (const char*)g.A + (size_t)cur.pm * tstepA; const char* cB = (const char*)g.Bt + (size_t)cur.pn * tstepB;
    PG8_STAGE(PG8_SB(0, 0), cB, voffB); PG8_STAGE(PG8_SA(0, 0), cA, voffA); PG8_STAGE(PG8_SB(0, 1), cB + hstepB, voffB); PG8_STAGE(PG8_SA(0, 1), cA + hstepA, voffA);
    if (wr == 1) PG8_BAR;
    PG8_WAIT_V(4); PG8_BAR;
    PG8_STAGE(PG8_SB(1, 0), cB + kstep, voffB); PG8_STAGE(PG8_SA(1, 0), cA + PG8_AKOFF(1), voffA); PG8_STAGE(PG8_SB(1, 1), cB + hstepB + kstep, voffB);
    PG8_WAIT_V(6); PG8_BAR;
    for (;;) {
        const bool has_next = S.next(ui + 1, nxt);
        const char* nA = has_next ? (const char*)g.A + (size_t)nxt.pm * tstepA : cA; const char* nB = has_next ? (const char*)g.Bt + (size_t)nxt.pn * tstepB : cB;
        for (int t = 0; t < nt; t += 2) {
            const bool last = (t == nt - 2);
            const char* a1 = cA + PG8_AKOFF(t + 1);
            const char* a2 = last ? nA : cA + PG8_AKOFF(t + 2); const char* b2 = last ? nB : cB + (size_t)(t + 2) * kstep;
            const char* a3 = last ? nA + PG8_AKOFF(1) : cA + PG8_AKOFF(t + 3); const char* b3 = b2 + kstep;
            PG8_LDB(B0, 0, 0); PG8_SCHED; PG8_LDA(At, 0, 0); PG8_STAGE(PG8_SA(1, 1), a1 + hstepA, voffA);
            PG8_WAIT_L(8); PG8_BAR; PG8_WAIT_L(0); PG8_MM(0, 0, At, B0); PG8_BAR; PG8_SCHED;
            PG8_LDB(B1, 0, 1); PG8_STAGE(PG8_SB(0, 0), b2, voffB);
            PG8_BAR; PG8_WAIT_L(0); PG8_MM(0, 1, At, B1); PG8_BAR;
            PG8_LDA(At, 0, 1); PG8_STAGE(PG8_SA(0, 0), a2, voffA);
            PG8_BAR; PG8_WAIT_L(0); PG8_MM(1, 0, At, B0); PG8_BAR; PG8_SCHED;
            PG8_STAGE(PG8_SB(0, 1), b2 + hstepB, voffB);
            PG8_WAIT_V(6); PG8_BAR; PG8_MM(1, 1, At, B1); PG8_BAR;
            PG8_LDB(B0, 1, 0); PG8_SCHED; PG8_LDA(At, 1, 0); PG8_STAGE(PG8_SA(0, 1), a2 + hstepA, voffA);
            PG8_WAIT_L(8); PG8_BAR; PG8_WAIT_L(0); PG8_MM(0, 0, At, B0); PG8_BAR; PG8_SCHED;
            PG8_LDB(B1, 1, 1); PG8_STAGE(PG8_SB(1, 0), b3, voffB);
            PG8_BAR; PG8_WAIT_L(0); PG8_MM(0, 1, At, B1); PG8_BAR;
            PG8_LDA(At, 1, 1); PG8_STAGE(PG8_SA(1, 0), a3, voffA);
            PG8_BAR; PG8_WAIT_L(0); PG8_MM(1, 0, At, B0); PG8_BAR; PG8_SCHED;
            PG8_STAGE(PG8_SB(1, 1), b3 + hstepB, voffB);
            PG8_WAIT_V(6); PG8_BAR; PG8_MM(1, 1, At, B1); PG8_BAR;
        }
        asm volatile("s_nop 15\n\ts_nop 15" ::: "memory");
        if (E.mode == 0) E.eb(acc, cur, wr, wc, fr, fq); else E.er(acc, cur, wr, wc, fr, fq);
        if (!has_next) break;
#pragma unroll
        for (int a = 0; a < 2; ++a)
#pragma unroll
            for (int b = 0; b < 2; ++b)
#pragma unroll
                for (int m = 0; m < 4; ++m)
#pragma unroll
                    for (int n = 0; n < 2; ++n) acc[a][b][m][n] = (f32x4){0.f, 0.f, 0.f, 0.f};
        cur = nxt; cA = nA; cB = nB; ++ui;
    }
    PG8_WAIT_V(0);
    if (wr == 0) PG8_BAR;
    PG8_BAR;
#undef PG8_AKOFF
#undef PG8_SA
#undef PG8_SB
#undef PG8_STAGE
#undef PG8_LDA
#undef PG8_LDB
#undef PG8_MMA8
#undef PG8_MMA16
#undef PG8_MM
#undef PG8_WAIT_V
#undef PG8_WAIT_L
#undef PG8_BAR
#undef PG8_SCHED
}
}

__device__ __forceinline__ void tr_tile(LAS float* s, const float* src, int ld_src, int k0, int c0, bf16_t* dst, int ld_dst, int n0, const float* scale, unsigned char* dst8 = nullptr, float sc8 = 32.f) {
    const int tid = otid();
    {
        const int r = tid >> 4, c4 = (tid & 15) * 4;
#pragma unroll
        for (int p = 0; p < 2; ++p) {
            const int rr = r + p * 32;
            f32x4 v = *(const f32x4*)(src + (size_t)(k0 + rr) * ld_src + c0 + c4);
            if (scale) { const float sc = scale[rr]; v = v * sc; }
            s[rr * 65 + c4 + 0] = v[0]; s[rr * 65 + c4 + 1] = v[1]; s[rr * 65 + c4 + 2] = v[2]; s[rr * 65 + c4 + 3] = v[3];
        }
    }
    __syncthreads();
    {
        const int n = tid >> 3, kq = (tid & 7) * 8;
        float v[8];
#pragma unroll
        for (int j = 0; j < 8; ++j) v[j] = s[(kq + j) * 65 + n];
        u32x4 w; w.x = cvt_pk_bf16(v[0], v[1]); w.y = cvt_pk_bf16(v[2], v[3]); w.z = cvt_pk_bf16(v[4], v[5]); w.w = cvt_pk_bf16(v[6], v[7]);
        *(u32x4*)(dst + (size_t)(n0 + n) * ld_dst + k0 + kq) = w;
        if (dst8) *(u32x2*)(dst8 + (size_t)(n0 + n) * ld_dst + k0 + kq) = cvt8_fp8(v, sc8);
    }
    __syncthreads();
}

__device__ __forceinline__ void convert_rows(const float* src, bf16_t* dst, size_t n_elems) {
    const size_t n8 = n_elems / 8;
    for (size_t i = (size_t)obid() * NTHREADS + otid(); i < n8; i += (size_t)gridDim.x * NTHREADS) {
        const f32x4 a = *(const f32x4*)(src + i * 8), b = *(const f32x4*)(src + i * 8 + 4);
        u32x4 w; w.x = cvt_pk_bf16(a[0], a[1]); w.y = cvt_pk_bf16(a[2], a[3]); w.z = cvt_pk_bf16(b[0], b[1]); w.w = cvt_pk_bf16(b[2], b[3]);
        *(u32x4*)(dst + i * 8) = w;
    }
}

__device__ __forceinline__ void ln_rows_f32(const float* in, bf16_t* hb, unsigned char* hb8, const float* g, const float* bta) {
    const int lane = otid() & 63, wid = otid() >> 6;
    f32x4 gg[4], bb[4];
#pragma unroll
    for (int i = 0; i < 4; ++i) { gg[i] = ((const f32x4*)g)[lane + 64 * i]; bb[i] = ((const f32x4*)bta)[lane + 64 * i]; }
    for (int r = obid() * 8 + wid; r < T_TOK; r += gridDim.x * 8) {
        const f32x4* xr = (const f32x4*)(in + (size_t)r * DM);
        f32x4 v[4]; float s = 0.f;
#pragma unroll
        for (int i = 0; i < 4; ++i) { v[i] = xr[lane + 64 * i]; s += v[i][0] + v[i][1] + v[i][2] + v[i][3]; }
        s = wave_sum(s);
        const float mu = s * (1.f / DM);
        float q = 0.f;
#pragma unroll
        for (int i = 0; i < 4; ++i) { v[i] = v[i] - mu; q += v[i][0] * v[i][0] + v[i][1] * v[i][1] + v[i][2] * v[i][2] + v[i][3] * v[i][3]; }
        q = wave_sum(q);
        const float rs = rsqrtf(q * (1.f / DM) + LN_EPS);
        u32x2* hrow = (u32x2*)(hb + (size_t)r * DM);
#pragma unroll
        for (int i = 0; i < 4; ++i) {
            const f32x4 o = v[i] * rs * gg[i] + bb[i];
            u32x2 w; w.x = cvt_pk_bf16(o[0], o[1]); w.y = cvt_pk_bf16(o[2], o[3]);
            hrow[lane + 64 * i] = w;
            if (FP8_IN || FP8_Q) { int d8 = 0; d8 = __builtin_amdgcn_cvt_pk_fp8_f32(o[0], o[1], d8, false); d8 = __builtin_amdgcn_cvt_pk_fp8_f32(o[2], o[3], d8, true);
                ((unsigned*)(hb8 + (size_t)r * DM))[lane + 64 * i] = (unsigned)d8; }
        }
    }
}
template <bool HAVE_STAT>
__device__ __forceinline__ void ln_rows_bf16(bf16_t* hb, unsigned char* hb8, float* out_f32, const float* STAT, const float* g, const float* bta) {
    const int lane = otid() & 63, wid = otid() >> 6;
    f32x4 gg[4], bb[4];
#pragma unroll
    for (int i = 0; i < 2; ++i) { gg[2 * i] = *(const f32x4*)(g + i * 512 + lane * 8); gg[2 * i + 1] = *(const f32x4*)(g + i * 512 + lane * 8 + 4);
        bb[2 * i] = *(const f32x4*)(bta + i * 512 + lane * 8); bb[2 * i + 1] = *(const f32x4*)(bta + i * 512 + lane * 8 + 4); }
    constexpr int NR = 4;
    for (int r0 = (obid() * 8 + wid) * NR; r0 < T_TOK; r0 += gridDim.x * 8 * NR) {
        u32x4 ra[NR], rb[NR]; f32x4 st[NR][2];
#pragma unroll
        for (int k = 0; k < NR; ++k) {
            const bf16_t* hrow = hb + (size_t)(r0 + k) * DM;
            ra[k] = *(const u32x4*)(hrow + lane * 8); rb[k] = *(const u32x4*)(hrow + 512 + lane * 8);
            if (HAVE_STAT) {
#pragma unroll
                for (int q = 0; q < 2; ++q) st[k][q] = *(const f32x4*)(STAT + (size_t)(r0 + k) * 8 + 4 * q);
            }
        }
#pragma unroll
        for (int k = 0; k < NR; ++k) {
            const int r = r0 + k;
            bf16_t* hrow = hb + (size_t)r * DM;
            float v[16];
#pragma unroll
            for (int i = 0; i < 4; ++i) { v[2 * i] = bflo(ra[k][i]); v[2 * i + 1] = bfhi(ra[k][i]); v[8 + 2 * i] = bflo(rb[k][i]); v[8 + 2 * i + 1] = bfhi(rb[k][i]); }
            float mu, rs;
            if (HAVE_STAT) {
                const float s1 = (st[k][0][0] + st[k][0][2]) + (st[k][1][0] + st[k][1][2]);
                const float s2 = (st[k][0][1] + st[k][0][3]) + (st[k][1][1] + st[k][1][3]);
                mu = s1 * (1.f / DM);
                rs = rsqrtf(fmaxf(s2 * (1.f / DM) - mu * mu, 0.f) + LN_EPS);
            } else {
                float sm = 0.f;
#pragma unroll
                for (int i = 0; i < 16; ++i) sm += v[i];
                sm = wave_sum(sm);
                mu = sm * (1.f / DM);
                float q = 0.f;
#pragma unroll
                for (int i = 0; i < 16; ++i) { const float d = v[i] - mu; q += d * d; }
                q = wave_sum(q);
                rs = rsqrtf(q * (1.f / DM) + LN_EPS);
            }
            float o[16];
#pragma unroll
            for (int i = 0; i < 4; ++i)
#pragma unroll
                for (int c = 0; c < 4; ++c) o[4 * i + c] = (v[4 * i + c] - mu) * rs * gg[i][c] + bb[i][c];
            u32x4 w0, w1;
            w0.x = cvt_pk_bf16(o[0], o[1]); w0.y = cvt_pk_bf16(o[2], o[3]); w0.z = cvt_pk_bf16(o[4], o[5]); w0.w = cvt_pk_bf16(o[6], o[7]);
            w1.x = cvt_pk_bf16(o[8], o[9]); w1.y = cvt_pk_bf16(o[10], o[11]); w1.z = cvt_pk_bf16(o[12], o[13]); w1.w = cvt_pk_bf16(o[14], o[15]);
            *(u32x4*)(hrow + lane * 8) = w0; *(u32x4*)(hrow + 512 + lane * 8) = w1;
            if (FP8_IN || FP8_Q) { *(u32x2*)(hb8 + (size_t)r * DM + lane * 8) = cvt8_fp8(o, 1.f); *(u32x2*)(hb8 + (size_t)r * DM + 512 + lane * 8) = cvt8_fp8(o + 8, 1.f); }
            if (out_f32) {
                float* orow = out_f32 + (size_t)r * DM;
                *(f32x4*)(orow + lane * 8) = (f32x4){o[0], o[1], o[2], o[3]}; *(f32x4*)(orow + lane * 8 + 4) = (f32x4){o[4], o[5], o[6], o[7]};
                *(f32x4*)(orow + 512 + lane * 8) = (f32x4){o[8], o[9], o[10], o[11]}; *(f32x4*)(orow + 512 + lane * 8 + 4) = (f32x4){o[12], o[13], o[14], o[15]};
            }
        }
    }
}

__device__ void phase_prep(const Params& P, LAS unsigned char* lds) {
    unsigned char* ws = P.ws;
#ifdef TS_SUB
    if (obid() == 0 && otid() < 16) ((unsigned long long*)(ws + WS_CTL + 40960))[otid()] = 0ull;
#endif
    if (obid() == 0 && otid() < 2 * DEPTH) __hip_atomic_store((unsigned*)(ws + WS_CTL) + 64 * (1 + otid()), 0u, __ATOMIC_RELAXED, __HIP_MEMORY_SCOPE_AGENT);
    if (obid() == 0 && otid() < 32) __hip_atomic_store((unsigned*)(ws + WS_CTL) + ((otid() < 16) ? CTLW_QE1 : CTLW_QE3 - 16 * 64) + 64 * otid(), 0u, __ATOMIC_RELAXED, __HIP_MEMORY_SCOPE_AGENT);
    LAS float* s = (LAS float*)lds;
    const int n_win = 2 * 68 * 16, n_wout = 2 * 16 * 32, n_wq = 2 * 16 * 16, n_g = 2 * 8 * 2;
    const int total = n_win + n_wout + n_wq + n_g;
    for (int j = obid(); j < total; j += gridDim.x) {
        if (j < n_win) {
            const int l = j / (68 * 16), r = j % (68 * 16), nt = r / 16, kt = r % 16;
            const int n0 = nt * 64, c0 = n0 < 3584 ? n0 : n0 + 16;
            tr_tile(s, P.w_in + (size_t)l * 1024 * PROJ_LD, PROJ_LD, kt * 64, c0, (bf16_t*)(ws + WS_WIN) + (size_t)l * N_IN * 1024, 1024, n0, nullptr, FP8_IN ? ws + WS_WIN8 + (size_t)l * N_IN * 1024 : nullptr);
        } else if (j < n_win + n_wout) {
            const int jj = j - n_win, l = jj / (16 * 32), r = jj % (16 * 32), nt = r / 32, kt = r % 32;
            const int k0 = kt * 64;
            const float* sc = (k0 >= 512 && k0 < 1536) ? P.ssm_norm_g + l * 1024 + (k0 - 512) : nullptr;
            tr_tile(s, P.w_out + (size_t)l * MIXW * 1024, 1024, k0, nt * 64, (bf16_t*)(ws + WS_WOUT) + (size_t)l * 1024 * MIXW, MIXW, nt * 64, sc, FP8_OUT ? ws + WS_WOUT8 + (size_t)l * 1024 * MIXW : nullptr, 64.f);
        } else if (j < n_win + n_wout + n_wq) {
            const int jj = j - n_win - n_wout, l = jj / 256, r = jj % 256, nt = r / 16, kt = r % 16;
            tr_tile(s, P.peer_wq + (size_t)l * 1024 * 1024, 1024, kt * 64, nt * 64, (bf16_t*)(ws + WS_WQ) + (size_t)l * 1024 * 1024, 1024, nt * 64, nullptr, FP8_Q ? ws + WS_WQ8 + (size_t)l * 1024 * 1024 : nullptr);
        } else {
            const int jj = j - n_win - n_wout - n_wq, which = jj / 16, lb = jj % 16;
            const float* src = (which ? P.rg_wx : P.rg_wa) + (size_t)lb * 4096;
            bf16_t* dst = (bf16_t*)(ws + (which ? WS_WX : WS_WA)) + (size_t)lb * 4096;
            tr_tile(s, src, 64, 0, 0, dst, 64, 0, nullptr);
        }
    }
    for (int i = obid() * NTHREADS + otid(); i < 2 * 16 * 1024; i += gridDim.x * NTHREADS) {
        const int l = i >> 14, j = (i >> 10) & 15, k = i & 1023;
        ((bf16_t*)(ws + WS_WDT))[i] = f2bf(P.w_in[((size_t)l * 1024 + k) * PROJ_LD + C_DT + j]);
    }
    convert_rows(P.peer_keys, (bf16_t*)(ws + WS_KEYS), (size_t)2 * 2 * 128 * 64);
    {
        const int lane = otid() & 63, wid = otid() >> 6;
        for (int r = obid() * 8 + wid; r < 2 * 2 * 16384; r += gridDim.x * 8) {
            const int which = r >> 15, row = r & 32767;
            const float* src = (which ? P.peer_v : P.peer_u) + (size_t)row * DM + lane * 16;
            f32x4 v[4]; float amax = 0.f;
#pragma unroll
            for (int i = 0; i < 4; ++i) { v[i] = *(const f32x4*)(src + 4 * i); amax = fmaxf(amax, fmaxf(fmaxf(fabsf(v[i][0]), fabsf(v[i][1])), fmaxf(fabsf(v[i][2]), fabsf(v[i][3])))); }
#pragma unroll
            for (int o = 32; o > 0; o >>= 1) amax = fmaxf(amax, __shfl_xor(amax, o));
            const float inv = amax > 0.f ? 6.f / amax : 0.f;
            u32x2 w;
#pragma unroll
            for (int i = 0; i < 2; ++i) { unsigned q = 0;
                q = __builtin_amdgcn_cvt_scalef32_pk_fp4_f32(q, v[2 * i][0] * inv, v[2 * i][1] * inv, 1.0f, 0); q = __builtin_amdgcn_cvt_scalef32_pk_fp4_f32(q, v[2 * i][2] * inv, v[2 * i][3] * inv, 1.0f, 1);
                q = __builtin_amdgcn_cvt_scalef32_pk_fp4_f32(q, v[2 * i + 1][0] * inv, v[2 * i + 1][1] * inv, 1.0f, 2); q = __builtin_amdgcn_cvt_scalef32_pk_fp4_f32(q, v[2 * i + 1][2] * inv, v[2 * i + 1][3] * inv, 1.0f, 3);
                w[i] = q; }
            *(u32x2*)(ws + (which ? WS_V8 : WS_U8) + (size_t)(row >> 14) * (16384 * 512) + (size_t)(lane >> 4) * (16384 * 128) + (size_t)(row & 16383) * 128 + (lane & 15) * 8) = w;
            if (lane == 0) ((float*)(ws + (which ? WS_SV : WS_SU)))[row] = amax * (1.f / 6.f);
        }
    }
    ln_rows_f32(P.x, (bf16_t*)(ws + WS_HB), ws + WS_MIX8, P.emb_g, P.emb_b);
}

__device__ void phase_dt(const Params& P, int layer) {
    const int lane = otid() & 63, wid = otid() >> 6;
    const bf16_t* hb = (const bf16_t*)(P.ws + WS_HB);
    const bf16_t* wdt = (const bf16_t*)(P.ws + WS_WDT) + (size_t)layer * 16 * 1024;
    float* DT = (float*)(P.ws + WS_DT);
    const float bias = P.ssm_dt_bias[layer * 16 + (lane & 15)];
    for (int task = obid() * 8 + wid; task < T_TOK / 16; task += gridDim.x * 8) {
        const int t0 = task * 16;
        f32x4 acc = {0.f, 0.f, 0.f, 0.f};
        const bf16_t* ap = hb + (size_t)(t0 + (lane & 15)) * DM + (lane >> 4) * 8;
        const bf16_t* bp = wdt + (size_t)(lane & 15) * DM + (lane >> 4) * 8;
#pragma unroll 8
        for (int ks = 0; ks < 32; ++ks) {
            const bf16x8 a = *(const bf16x8*)(ap + ks * 32), b = *(const bf16x8*)(bp + ks * 32);
            acc = MFMA16(a, b, acc);
        }
#pragma unroll
        for (int j = 0; j < 4; ++j) DT[(size_t)(t0 + (lane >> 4) * 4 + j) * 16 + (lane & 15)] = softplusf_(acc[j] + bias);
    }
}

__device__ void phase_conv(const Params& P, int layer) {
    const int tid = otid();
    bf16_t* proj = (bf16_t*)(P.ws + WS_PROJ);
    for (int tile = obid(); tile < 128; tile += gridDim.x) {
        const int b = tile >> 3, slab = tile & 7;
        const int cg = tid & 7, chx = 1024 + slab * 64 + cg * 8;
        float cw[4][8], cb[8];
#pragma unroll
        for (int j = 0; j < 8; ++j) {
            cb[j] = P.ssm_conv_b[layer * 1536 + chx + j];
#pragma unroll
            for (int i = 0; i < 4; ++i) cw[i][j] = P.ssm_conv_w[(layer * 4 + i) * 1536 + chx + j];
        }
        bf16_t* base = proj + (size_t)b * SEQ * PROJ_LD + C_XBC + chx;
        const int r0 = tid >> 3;
        u32x4 tap[4][4];
#define CONV_LOAD(c) do { _Pragma("unroll") for (int it = 0; it < 4; ++it) _Pragma("unroll") for (int i = 0; i < 4; ++i) { \
            const int pos = (c) * 256 + r0 + it * 64 - 3 + i; \
            tap[it][i] = (pos >= 0) ? *(const u32x4*)(base + (size_t)pos * PROJ_LD) : (u32x4){0u, 0u, 0u, 0u}; } } while (0)
        CONV_LOAD(15);
        for (int c = 15; c >= 0; --c) {
            u32x4 res[4];
#pragma unroll
            for (int it = 0; it < 4; ++it) {
                float v[8];
#pragma unroll
                for (int j = 0; j < 8; ++j) v[j] = cb[j];
#pragma unroll
                for (int i = 0; i < 4; ++i) {
                    const u32x4 w = tap[it][i];
                    v[0] += cw[i][0] * bflo(w.x); v[1] += cw[i][1] * bfhi(w.x); v[2] += cw[i][2] * bflo(w.y); v[3] += cw[i][3] * bfhi(w.y);
                    v[4] += cw[i][4] * bflo(w.z); v[5] += cw[i][5] * bfhi(w.z); v[6] += cw[i][6] * bflo(w.w); v[7] += cw[i][7] * bfhi(w.w);
                }
#pragma unroll
                for (int j = 0; j < 8; ++j) v[j] = siluf_(v[j]);
                res[it].x = cvt_pk_bf16(v[0], v[1]); res[it].y = cvt_pk_bf16(v[2], v[3]); res[it].z = cvt_pk_bf16(v[4], v[5]); res[it].w = cvt_pk_bf16(v[6], v[7]);
            }
            if (c > 0) CONV_LOAD(c - 1);
            __syncthreads();
#pragma unroll
            for (int it = 0; it < 4; ++it) *(u32x4*)(base + (size_t)(c * 256 + r0 + it * 64) * PROJ_LD) = res[it];
        }
#undef CONV_LOAD
        __syncthreads();
    }
}

typedef short v4i16_t __attribute__((ext_vector_type(4)));
__device__ __forceinline__ bf16x8 tr_frag(const LAS bf16_t* base, int stride, int kbase, int n0, int fr, int fq) {
    const LAS bf16_t* p = base + (kbase + fq * 8 + (fr >> 2)) * stride + n0 + (fr & 3) * 4;
    const v4i16_t lo = __builtin_amdgcn_ds_read_tr16_b64_v4i16((LAS v4i16_t*)p);
    const v4i16_t hi = __builtin_amdgcn_ds_read_tr16_b64_v4i16((LAS v4i16_t*)(p + 4 * stride));
    return (bf16x8){lo[0], lo[1], lo[2], lo[3], hi[0], hi[1], hi[2], hi[3]};
}

__device__ void ssd_tile(const Params& P, int layer, int b, int h, LAS unsigned char* lds) {
    const int tid = otid(), lane = tid & 63, wid = tid >> 6, fr = lane & 15, fq = lane >> 4;
    bf16_t* proj = (bf16_t*)(P.ws + WS_PROJ);
    const float* DT = (const float*)(P.ws + WS_DT);
    float* SSQ = (float*)(P.ws + WS_SSQ);
    const int g = h >> 3;
    LAS bf16_t* sC = (LAS bf16_t*)lds;
    LAS bf16_t* sB = sC + 64 * 136;
    LAS bf16_t* sS = sB + 64 * 136;
    LAS bf16_t* sXH = sS + 64 * 136;
    LAS bf16_t* sXD = sXH + 64 * 72;
    LAS bf16_t* sM = sXD + 64 * 72;
    LAS float* sY = (LAS float*)(sM + 64 * 72);
    LAS float* sAcs = sY + 64 * 68;
    LAS float* sDt = sAcs + 128;
    LAS bf16_t* sXR = (LAS bf16_t*)(sDt + 128);
    LAS bf16_t* sXHalo = sXR + 64 * 72;
    const float a_h = -__expf(P.ssm_a_log[layer * 16 + h]);
    const float d_h = P.ssm_d[layer * 16 + h];
    int goff[5], loff[5];
#pragma unroll
    for (int it = 0; it < 5; ++it) {
        const int i = it * NTHREADS + tid, row = i / 40, c2 = i % 40;
        int ch, lo;
        if (c2 < 8) { ch = h * 64 + c2 * 8; lo = (int)(sXR - sC) + row * 72 + c2 * 8; }
        else if (c2 < 24) { ch = 1024 + g * 128 + (c2 - 8) * 8; lo = (int)(sB - sC) + row * 136 + (c2 - 8) * 8; }
        else { ch = 1280 + g * 128 + (c2 - 24) * 8; lo = row * 136 + (c2 - 24) * 8; }
        goff[it] = row * PROJ_LD + C_XBC + ch; loff[it] = lo;
    }
    const bf16_t* pbase = proj + (size_t)b * SEQ * PROJ_LD;
    float cw[4][8], cb[8];
#pragma unroll
    for (int j = 0; j < 8; ++j) {
        const int ch = h * 64 + (tid & 7) * 8 + j;
        cb[j] = P.ssm_conv_b[layer * 1536 + ch];
#pragma unroll
        for (int i = 0; i < 4; ++i) cw[i][j] = P.ssm_conv_w[(layer * 4 + i) * 1536 + ch];
    }
    for (int i = tid; i < 3 * 72 / 2; i += NTHREADS) ((LAS unsigned*)(sXHalo + 3 * 72))[i] = 0u;
    for (int i = tid; i < 64 * 136 / 2; i += NTHREADS) ((LAS unsigned*)sS)[i] = 0u;
    f32x4 accS[4];
#pragma unroll
    for (int q = 0; q < 4; ++q) accS[q] = (f32x4){0.f, 0.f, 0.f, 0.f};
    u32x4 raw[5];
#pragma unroll
    for (int it = 0; it < 5; ++it) raw[it] = *(const u32x4*)(pbase + goff[it]);
    float dtn = 0.f, dtc = 0.f;
    if (wid == 0) { dtc = DT[(size_t)(b * SEQ + lane) * 16 + h]; dtn = DT[(size_t)(b * SEQ + 64 + lane) * 16 + h]; }
#pragma unroll
    for (int it = 0; it < 5; ++it) {
        *(LAS u32x4*)(sC + loff[it]) = raw[it];
        const int i_ = it * NTHREADS + tid, row_ = i_ / 40, c2_ = i_ % 40;
        if (c2_ < 8 && row_ >= 61) *(LAS u32x4*)(sXHalo + (row_ - 61) * 72 + c2_ * 8) = raw[it];
    }
    if (wid == 0) {
        float v = dtc * a_h;
#pragma unroll
        for (int o = 1; o < 64; o <<= 1) { const float n = __shfl_up(v, o); if (lane >= o) v += n; }
        sDt[lane] = dtc; sAcs[lane] = v;
    }
    __syncthreads();
    const int dl = tid >> 3, dp8 = (tid & 7) * 8;
    for (int c = 0; c < 64; ++c) {
        const int t0 = b * SEQ + c * 64;
        if (c + 1 < 64) {
            const bf16_t* nb = pbase + (size_t)(c + 1) * 64 * PROJ_LD;
#pragma unroll
            for (int it = 0; it < 5; ++it) raw[it] = *(const u32x4*)(nb + goff[it]);
            if (wid == 0) {
                float v = dtn * a_h;
#pragma unroll
                for (int o = 1; o < 64; o <<= 1) { const float n = __shfl_up(v, o); if (lane >= o) v += n; }
                sDt[((c + 1) & 1) * 64 + lane] = dtn; sAcs[((c + 1) & 1) * 64 + lane] = v;
                if (c + 2 < 64) dtn = DT[(size_t)(t0 + 128 + lane) * 16 + h];
            }
        }
        const LAS float* cAcs = sAcs + (c & 1) * 64; const LAS float* cDt = sDt + (c & 1) * 64;
        const size_t ga = (size_t)(t0 + dl) * PROJ_LD + C_Z + h * 64 + dp8;
        const u32x4 zw = *(const u32x4*)(proj + ga);
        {
            const LAS bf16_t* halo = sXHalo + ((c + 1) & 1) * (3 * 72);
            float v[8];
#pragma unroll
            for (int j = 0; j < 8; ++j) v[j] = cb[j];
#pragma unroll
            for (int i = 0; i < 4; ++i) {
                const int r = dl - 3 + i;
                const u32x4 w = (r >= 0) ? *(const LAS u32x4*)(sXR + r * 72 + dp8) : *(const LAS u32x4*)(halo + (r + 3) * 72 + dp8);
                v[0] += cw[i][0] * bflo(w.x); v[1] += cw[i][1] * bfhi(w.x); v[2] += cw[i][2] * bflo(w.y); v[3] += cw[i][3] * bfhi(w.y);
                v[4] += cw[i][4] * bflo(w.z); v[5] += cw[i][5] * bfhi(w.z); v[6] += cw[i][6] * bflo(w.w); v[7] += cw[i][7] * bfhi(w.w);
            }
#pragma unroll
            for (int j = 0; j < 8; ++j) v[j] = siluf_(v[j]);
            const float dd = cDt[dl] * __expf(cAcs[63] - cAcs[dl]);
            u32x4 o1; o1.x = cvt_pk_bf16(v[0], v[1]); o1.y = cvt_pk_bf16(v[2], v[3]); o1.z = cvt_pk_bf16(v[4], v[5]); o1.w = cvt_pk_bf16(v[6], v[7]);
            u32x4 o3; o3.x = cvt_pk_bf16(v[0] * dd, v[1] * dd); o3.y = cvt_pk_bf16(v[2] * dd, v[3] * dd); o3.z = cvt_pk_bf16(v[4] * dd, v[5] * dd); o3.w = cvt_pk_bf16(v[6] * dd, v[7] * dd);
            *(LAS u32x4*)(sXH + dl * 72 + dp8) = o1;
            *(LAS u32x4*)(sXD + dl * 72 + dp8) = o3;
        }
        const int lt = wid >> 1, ph = wid & 1;
        f32x4 accY[2];
        {
            bf16x8 aC[4];
#pragma unroll
            for (int ks = 0; ks < 4; ++ks) aC[ks] = *(const LAS bf16x8*)(sC + (lt * 16 + fr) * 136 + ks * 32 + fq * 8);
#pragma unroll
            for (int tt = 0; tt < 2; ++tt) {
                const int st = ph * 2 + tt;
                f32x4 accG = {0.f, 0.f, 0.f, 0.f};
#pragma unroll
                for (int ks = 0; ks < 4; ++ks) { const bf16x8 bb = *(const LAS bf16x8*)(sB + (st * 16 + fr) * 136 + ks * 32 + fq * 8); accG = MFMA16(aC[ks], bb, accG); }
                const int s_idx = st * 16 + fr; const float acs_s = cAcs[s_idx], dt_s = cDt[s_idx];
#pragma unroll
                for (int j = 0; j < 4; ++j) {
                    const int l = lt * 16 + fq * 4 + j;
                    const float val = (s_idx <= l) ? accG[j] * __expf(cAcs[l] - acs_s) * dt_s : 0.f;
                    sM[l * 72 + s_idx] = f2bf(val);
                }
            }
#pragma unroll
            for (int tt = 0; tt < 2; ++tt) {
                const int pt = ph * 2 + tt;
                f32x4 a = {0.f, 0.f, 0.f, 0.f};
#pragma unroll
                for (int ks = 0; ks < 4; ++ks) { const bf16x8 bb = *(const LAS bf16x8*)(sS + (pt * 16 + fr) * 136 + ks * 32 + fq * 8); a = MFMA16(aC[ks], bb, a); }
#pragma unroll
                for (int j = 0; j < 4; ++j) a[j] *= __expf(cAcs[lt * 16 + fq * 4 + j]);
                accY[tt] = a;
            }
        }
        __syncthreads();
        {
#pragma unroll
            for (int tt = 0; tt < 2; ++tt) {
                const int pt = ph * 2 + tt;
#pragma unroll
                for (int ks = 0; ks < 2; ++ks) {
                    const bf16x8 am = *(const LAS bf16x8*)(sM + (lt * 16 + fr) * 72 + ks * 32 + fq * 8);
                    const bf16x8 bx = tr_frag(sXH, 72, ks * 32, pt * 16, fr, fq);
                    accY[tt] = MFMA16(am, bx, accY[tt]);
                }
#pragma unroll
                for (int j = 0; j < 4; ++j) sY[(lt * 16 + fq * 4 + j) * 68 + pt * 16 + fr] = accY[tt][j];
            }
            const float dec = __expf(cAcs[63]);
            const int pt2 = wid >> 1;
            bf16x8 ax[2];
#pragma unroll
            for (int ks = 0; ks < 2; ++ks) ax[ks] = tr_frag(sXD, 72, ks * 32, pt2 * 16, fr, fq);
#pragma unroll
            for (int q = 0; q < 4; ++q) {
                const int nt = ph * 4 + q;
                f32x4 a = accS[q] * dec;
#pragma unroll
                for (int ks = 0; ks < 2; ++ks) { const bf16x8 bb = tr_frag(sB, 136, ks * 32, nt * 16, fr, fq); a = MFMA16(ax[ks], bb, a); }
                accS[q] = a;
#pragma unroll
                for (int j = 0; j < 4; ++j) sS[(pt2 * 16 + fq * 4 + j) * 136 + nt * 16 + fr] = f2bf(a[j]);
            }
        }
        __syncthreads();
        {
            const u32x4 xw = *(const LAS u32x4*)(sXH + dl * 72 + dp8);
            const f32x4 y0 = *(const LAS f32x4*)(sY + dl * 68 + dp8), y1 = *(const LAS f32x4*)(sY + dl * 68 + dp8 + 4);
            float y[8];
            y[0] = (y0[0] + d_h * bflo(xw.x)) * siluf_(bflo(zw.x)); y[1] = (y0[1] + d_h * bfhi(xw.x)) * siluf_(bfhi(zw.x));
            y[2] = (y0[2] + d_h * bflo(xw.y)) * siluf_(bflo(zw.y)); y[3] = (y0[3] + d_h * bfhi(xw.y)) * siluf_(bfhi(zw.y));
            y[4] = (y1[0] + d_h * bflo(xw.z)) * siluf_(bflo(zw.z)); y[5] = (y1[1] + d_h * bfhi(xw.z)) * siluf_(bfhi(zw.z));
            y[6] = (y1[2] + d_h * bflo(xw.w)) * siluf_(bflo(zw.w)); y[7] = (y1[3] + d_h * bfhi(xw.w)) * siluf_(bfhi(zw.w));
            float q = 0.f;
#pragma unroll
            for (int j = 0; j < 8; ++j) q += y[j] * y[j];
            q += dpp_<0xB1>(q); q += dpp_<0x4E>(q); q += dpp_<0x141>(q);
            if ((tid & 7) == 0) SSQ[(size_t)(t0 + dl) * 16 + h] = q;
            u32x4 o; o.x = cvt_pk_bf16(y[0], y[1]); o.y = cvt_pk_bf16(y[2], y[3]); o.z = cvt_pk_bf16(y[4], y[5]); o.w = cvt_pk_bf16(y[6], y[7]);
            *(u32x4*)(proj + ga) = o;
        }
        if (c + 1 < 64) {
#pragma unroll
            for (int it = 0; it < 5; ++it) {
                *(LAS u32x4*)(sC + loff[it]) = raw[it];
                const int i_ = it * NTHREADS + tid, row_ = i_ / 40, c2_ = i_ % 40;
                if (c2_ < 8 && row_ >= 61) *(LAS u32x4*)(sXHalo + ((c + 1) & 1) * (3 * 72) + (row_ - 61) * 72 + c2_ * 8) = raw[it];
            }
        }
        __syncthreads();
    }
}

__device__ void rglru_tile(const Params& P, int layer, int b, int n, LAS unsigned char* lds) {
    const int tid = otid(), lane = tid & 63, wid = tid >> 6, fr = lane & 15, fq = lane >> 4;
    bf16_t* proj = (bf16_t*)(P.ws + WS_PROJ);
    LAS bf16_t* sXC = (LAS bf16_t*)lds;
    LAS bf16_t* sWa = sXC + 64 * 72;
    LAS bf16_t* sWx = sWa + 64 * 72;
    LAS float* sA = (LAS float*)(sWx + 64 * 72);
    LAS float* sU = sA + 64 * 64;
    LAS float* sPs = sU + 64 * 64;
    LAS float* sHs = sPs + 8 * 64;
    LAS float* sCar = sHs + 8 * 64;
    LAS bf16_t* sR = (LAS bf16_t*)(sCar + 64);
    LAS bf16_t* sRHalo = sR + 64 * 72;
    {
        const int d = tid >> 3, c8 = (tid & 7) * 8;
        const bf16_t* wa = (const bf16_t*)(P.ws + WS_WA) + (size_t)(layer * 8 + n) * 4096;
        const bf16_t* wx = (const bf16_t*)(P.ws + WS_WX) + (size_t)(layer * 8 + n) * 4096;
        *(LAS u32x4*)(sWa + d * 72 + c8) = *(const u32x4*)(wa + d * 64 + c8);
        *(LAS u32x4*)(sWx + d * 72 + c8) = *(const u32x4*)(wx + d * 64 + c8);
    }
    if (tid < 64) sCar[tid] = 0.f;
    for (int i = tid; i < 3 * 72 / 2; i += NTHREADS) ((LAS unsigned*)(sRHalo + 3 * 72))[i] = 0u;
    const int cg = tid & 7, crow = tid >> 3, ch0 = n * 64 + cg * 8;
    float cw[4][8], cb[8];
#pragma unroll
    for (int j = 0; j < 8; ++j) {
        cb[j] = P.rg_conv_b[layer * 512 + ch0 + j];
#pragma unroll
        for (int i = 0; i < 4; ++i) cw[i][j] = P.rg_conv_w[(layer * 4 + i) * 512 + ch0 + j];
    }
    const int tt = wid & 3, dpair = wid >> 2;
    float ba[2], bx[2], sp[2];
#pragma unroll
    for (int dd = 0; dd < 2; ++dd) {
        const int ch = layer * 512 + n * 64 + (dpair * 2 + dd) * 16 + fr;
        ba[dd] = P.rg_ba[ch]; bx[dd] = P.rg_bx[ch]; sp[dd] = softplusf_(-P.rg_lambda[ch]);
    }
    const int sc = tid & 63, seg = wid;
    const bf16_t* pbase = proj + (size_t)b * SEQ * PROJ_LD;
    const int goff = crow * PROJ_LD + C_RGX + ch0;
#define RG_CONV(cc) do { const LAS bf16_t* halo_ = sRHalo + (((cc) + 1) & 1) * (3 * 72); float v_[8]; \
        _Pragma("unroll") for (int j_ = 0; j_ < 8; ++j_) v_[j_] = cb[j_]; \
        _Pragma("unroll") for (int i_ = 0; i_ < 4; ++i_) { const int r_ = crow - 3 + i_; \
            const u32x4 w_ = (r_ >= 0) ? *(const LAS u32x4*)(sR + r_ * 72 + cg * 8) : *(const LAS u32x4*)(halo_ + (r_ + 3) * 72 + cg * 8); \
            v_[0] += cw[i_][0] * bflo(w_.x); v_[1] += cw[i_][1] * bfhi(w_.x); v_[2] += cw[i_][2] * bflo(w_.y); v_[3] += cw[i_][3] * bfhi(w_.y); \
            v_[4] += cw[i_][4] * bflo(w_.z); v_[5] += cw[i_][5] * bfhi(w_.z); v_[6] += cw[i_][6] * bflo(w_.w); v_[7] += cw[i_][7] * bfhi(w_.w); } \
        u32x4 o_; o_.x = cvt_pk_bf16(v_[0], v_[1]); o_.y = cvt_pk_bf16(v_[2], v_[3]); o_.z = cvt_pk_bf16(v_[4], v_[5]); o_.w = cvt_pk_bf16(v_[6], v_[7]); \
        *(LAS u32x4*)(sXC + crow * 72 + cg * 8) = o_; } while (0)
    u32x4 raw = *(const u32x4*)(pbase + goff);
    *(LAS u32x4*)(sR + crow * 72 + cg * 8) = raw;
    if (crow >= 61) *(LAS u32x4*)(sRHalo + (crow - 61) * 72 + cg * 8) = raw;
    __syncthreads();
    RG_CONV(0);
    __syncthreads();
    for (int c = 0; c < 64; ++c) {
        const int t0 = b * SEQ + c * 64;
        if (c + 1 < 64) raw = *(const u32x4*)(pbase + (size_t)(c + 1) * 64 * PROJ_LD + goff);
        const size_t ga = (size_t)(t0 + crow) * PROJ_LD + C_GATE + ch0;
        const u32x4 gw = *(const u32x4*)(proj + ga);
        {
            bf16x8 ax[2];
#pragma unroll
            for (int ks = 0; ks < 2; ++ks) ax[ks] = *(const LAS bf16x8*)(sXC + (tt * 16 + fr) * 72 + ks * 32 + fq * 8);
#pragma unroll
            for (int dd = 0; dd < 2; ++dd) {
                const int dt_ = dpair * 2 + dd;
                f32x4 accA = {0.f, 0.f, 0.f, 0.f}, accX = {0.f, 0.f, 0.f, 0.f};
#pragma unroll
                for (int ks = 0; ks < 2; ++ks) {
                    const bf16x8 wa = *(const LAS bf16x8*)(sWa + (dt_ * 16 + fr) * 72 + ks * 32 + fq * 8);
                    const bf16x8 wx = *(const LAS bf16x8*)(sWx + (dt_ * 16 + fr) * 72 + ks * 32 + fq * 8);
                    accA = MFMA16(ax[ks], wa, accA); accX = MFMA16(ax[ks], wx, accX);
                }
#pragma unroll
                for (int j = 0; j < 4; ++j) {
                    const int t = tt * 16 + fq * 4 + j, d = dt_ * 16 + fr;
                    const float r = sigmoidf_(accA[j] + ba[dd]), ig = sigmoidf_(accX[j] + bx[dd]);
                    const float a = __expf(-8.f * r * sp[dd]);
                    const float mult = sqrtf(fmaxf(1.f - a * a, 0.f));
                    sA[t * 64 + d] = a;
                    sU[t * 64 + d] = mult * ig * bf2f(sXC[t * 72 + d]);
                }
            }
        }
        __syncthreads();
        {
            float Pl = 1.f, Hl = 0.f;
#pragma unroll
            for (int i = 0; i < 8; ++i) { const float a = sA[(seg * 8 + i) * 64 + sc], u = sU[(seg * 8 + i) * 64 + sc]; Hl = a * Hl + u; Pl *= a; }
            sPs[seg * 64 + sc] = Pl; sHs[seg * 64 + sc] = Hl;
        }
        __syncthreads();
        float H = sCar[sc];
        for (int s2 = 0; s2 < seg; ++s2) H = sPs[s2 * 64 + sc] * H + sHs[s2 * 64 + sc];
#pragma unroll
        for (int i = 0; i < 8; ++i) {
            const int t = seg * 8 + i;
            H = sA[t * 64 + sc] * H + sU[t * 64 + sc];
            sU[t * 64 + sc] = H;
        }
        __syncthreads();
        if (seg == 7) sCar[sc] = H;
        {
            const f32x4 h0 = *(const LAS f32x4*)(sU + crow * 64 + cg * 8), h1 = *(const LAS f32x4*)(sU + crow * 64 + cg * 8 + 4);
            u32x4 o;
            o.x = cvt_pk_bf16(gelu_tanhf_(bflo(gw.x)) * h0[0], gelu_tanhf_(bfhi(gw.x)) * h0[1]);
            o.y = cvt_pk_bf16(gelu_tanhf_(bflo(gw.y)) * h0[2], gelu_tanhf_(bfhi(gw.y)) * h0[3]);
            o.z = cvt_pk_bf16(gelu_tanhf_(bflo(gw.z)) * h1[0], gelu_tanhf_(bfhi(gw.z)) * h1[1]);
            o.w = cvt_pk_bf16(gelu_tanhf_(bflo(gw.w)) * h1[2], gelu_tanhf_(bfhi(gw.w)) * h1[3]);
            if (FP8_OUT) {
                float yv[8] = {bflo(o.x), bfhi(o.x), bflo(o.y), bfhi(o.y), bflo(o.z), bfhi(o.z), bflo(o.w), bfhi(o.w)};
                *(u32x2*)(P.ws + WS_MIX8 + (size_t)(t0 + crow) * MIXW + ch0) = cvt8_fp8(yv, 1.f);
            } else *(u32x4*)(proj + ga) = o;
        }
        if (c + 1 < 64) {
            *(LAS u32x4*)(sR + crow * 72 + cg * 8) = raw;
            if (crow >= 61) *(LAS u32x4*)(sRHalo + ((c + 1) & 1) * (3 * 72) + (crow - 61) * 72 + cg * 8) = raw;
        }
        __syncthreads();
        if (c + 1 < 64) RG_CONV(c + 1);
        __syncthreads();
    }
#undef RG_CONV
}

__device__ void attn_tile(const Params& P, int layer, int b, int qb, int kvh, LAS unsigned char* lds) {
    const int tid = otid(), lane = tid & 63, wid = tid >> 6, fr = lane & 15, fq = lane >> 4;
    bf16_t* proj = (bf16_t*)(P.ws + WS_PROJ);
    LAS bf16_t* sK = (LAS bf16_t*)lds;
    LAS bf16_t* sVT = sK + 256 * 72;
    LAS bf16_t* sP = sVT + 64 * 280 + wid * (16 * 168);
    const int tb = b * SEQ + qb * 128;
#pragma unroll
    for (int it = 0; it < 4; ++it) {
        const int idx = it * NTHREADS + tid;
        { const int kk = idx >> 3, dg = idx & 7;
          u32x4 v = {0u, 0u, 0u, 0u};
          if (qb > 0 || kk >= 128) v = *(const u32x4*)(proj + (size_t)(tb - 128 + kk) * PROJ_LD + C_K + kvh * 64 + dg * 8);
          *(LAS u32x4*)(sK + kk * 72 + dg * 8) = v; }
        { const int kk = idx & 255, dg = idx >> 8;
          u32x4 v = {0u, 0u, 0u, 0u};
          if (qb > 0 || kk >= 128) v = *(const u32x4*)(proj + (size_t)(tb - 128 + kk) * PROJ_LD + C_V + kvh * 64 + dg * 8);
          const unsigned wv[4] = {v.x, v.y, v.z, v.w};
#pragma unroll
          for (int j = 0; j < 4; ++j) { sVT[(dg * 8 + 2 * j) * 280 + kk] = (bf16_t)(wv[j] & 0xffffu); sVT[(dg * 8 + 2 * j + 1) * 280 + kk] = (bf16_t)(wv[j] >> 16); } }
    }
    if (tid < 192) { const int d = tid / 3, part = tid % 3; *(LAS u32x4*)(sVT + d * 280 + 256 + part * 8) = (u32x4){0u, 0u, 0u, 0u}; }
    __syncthreads();
    const int q0 = wid * 16;
    for (int r = 0; r < 4; ++r) {
        const int hq = kvh * 4 + r;
        const float sink = P.attn_sinks[layer * 8 + hq];
        bf16x8 qf[2];
#pragma unroll
        for (int ks = 0; ks < 2; ++ks) qf[ks] = *(const bf16x8*)(proj + (size_t)(tb + q0 + fr) * PROJ_LD + C_Q + hq * 64 + ks * 32 + fq * 8);
        f32x4 S[9];
#pragma unroll
        for (int kt = 0; kt < 9; ++kt) {
            f32x4 a = {0.f, 0.f, 0.f, 0.f};
#pragma unroll
            for (int ks = 0; ks < 2; ++ks) { const bf16x8 kf = *(const LAS bf16x8*)(sK + ((wid + kt) * 16 + fr) * 72 + ks * 32 + fq * 8); a = MFMA16(qf[ks], kf, a); }
            S[kt] = a;
        }
        float mx[4], sm[4];
#pragma unroll
        for (int j = 0; j < 4; ++j) mx[j] = -INFINITY;
#pragma unroll
        for (int kt = 0; kt < 9; ++kt)
#pragma unroll
            for (int j = 0; j < 4; ++j) {
                const int qi = q0 + fq * 4 + j, kk = (wid + kt) * 16 + fr, kj = kk - 128;
                const bool valid = (kj <= qi) && (kj > qi - 128) && (qb > 0 || kk >= 128);
                const float s = valid ? S[kt][j] * 0.125f : -INFINITY;
                S[kt][j] = s; mx[j] = fmaxf(mx[j], s);
            }
#pragma unroll
        for (int j = 0; j < 4; ++j) {
            float m = mx[j];
            m = fmaxf(m, __shfl_xor(m, 1)); m = fmaxf(m, __shfl_xor(m, 2)); m = fmaxf(m, __shfl_xor(m, 4)); m = fmaxf(m, __shfl_xor(m, 8));
            mx[j] = fmaxf(m, sink); sm[j] = 0.f;
        }
#pragma unroll
        for (int kt = 0; kt < 9; ++kt)
#pragma unroll
            for (int j = 0; j < 4; ++j) { const float p = __expf(S[kt][j] - mx[j]); S[kt][j] = p; sm[j] += p; }
#pragma unroll
        for (int j = 0; j < 4; ++j) {
            float s = sm[j];
            s += __shfl_xor(s, 1); s += __shfl_xor(s, 2); s += __shfl_xor(s, 4); s += __shfl_xor(s, 8);
            sm[j] = 1.f / (s + __expf(sink - mx[j]));
        }
#pragma unroll
        for (int kt = 0; kt < 9; ++kt)
#pragma unroll
            for (int j = 0; j < 4; ++j) sP[(fq * 4 + j) * 168 + kt * 16 + fr] = f2bf(S[kt][j] * sm[j]);
#pragma unroll
        for (int j = 0; j < 4; ++j) sP[(fq * 4 + j) * 168 + 144 + fr] = 0;
        f32x4 O[4];
#pragma unroll
        for (int dt_ = 0; dt_ < 4; ++dt_) O[dt_] = (f32x4){0.f, 0.f, 0.f, 0.f};
#pragma unroll
        for (int ks = 0; ks < 5; ++ks) {
            const bf16x8 pa = *(const LAS bf16x8*)(sP + fr * 168 + ks * 32 + fq * 8);
#pragma unroll
            for (int dt_ = 0; dt_ < 4; ++dt_) { const bf16x8 vb = *(const LAS bf16x8*)(sVT + (dt_ * 16 + fr) * 280 + wid * 16 + ks * 32 + fq * 8); O[dt_] = MFMA16(pa, vb, O[dt_]); }
        }
        if (FP8_OUT) {
            LAS unsigned char* sO = (LAS unsigned char*)sP;
#pragma unroll
            for (int dt_ = 0; dt_ < 4; ++dt_)
#pragma unroll
                for (int j = 0; j < 4; ++j) { const int d8 = __builtin_amdgcn_cvt_pk_fp8_f32(O[dt_][j], 0.f, 0, false); sO[(fq * 4 + j) * 80 + dt_ * 16 + fr] = (unsigned char)(d8 & 0xff); }
            const int orow = lane >> 2, och = lane & 3;
            const u32x4 ov = *(const LAS u32x4*)(sO + orow * 80 + och * 16);
            *(u32x4*)(P.ws + WS_MIX8 + (size_t)(tb + q0 + orow) * MIXW + 1536 + hq * 64 + och * 16) = ov;
        } else {
#pragma unroll
            for (int dt_ = 0; dt_ < 4; ++dt_)
#pragma unroll
                for (int j = 0; j < 4; ++j) proj[(size_t)(tb + q0 + fq * 4 + j) * PROJ_LD + C_Q + hq * 64 + dt_ * 16 + fr] = f2bf(O[dt_][j]);
        }
    }
    __syncthreads();
}

__device__ void phase_mixers(const Params& P, int layer, LAS unsigned char* lds) {
    unsigned* ctr = (unsigned*)(P.ws + WS_CTL) + 64 * (1 + layer);
    LAS int* sTile = (LAS int*)(lds + LDS_BYTES - 16);
    for (;;) {
        if (otid() == 0) *sTile = (int)atomicAdd(ctr, 1u);
        __syncthreads();
        const int tile = *sTile;
        __syncthreads();
        if (tile >= 256 + 128 + 1024) break;
#ifdef TS_SUB
        const unsigned long long tq0 = __builtin_amdgcn_s_memrealtime();
#endif
        if (tile < 256) { if (MIX_MASK & 1) ssd_tile(P, layer, tile >> 4, tile & 15, lds); }
        else if (tile < 384) { const int j = tile - 256; if (MIX_MASK & 2) rglru_tile(P, layer, j >> 3, j & 7, lds); }
        else { const int j = tile - 384; if (MIX_MASK & 4) attn_tile(P, layer, j >> 6, (j >> 1) & 31, j & 1, lds); }
#ifdef TS_SUB
        if (obid() == 0 && otid() == 0) { unsigned long long* pr = (unsigned long long*)(P.ws + WS_CTL + 40960); const int cat = tile < 256 ? 9 : (tile < 384 ? 10 : 11); pr[cat] += __builtin_amdgcn_s_memrealtime() - tq0; }
#endif
    }
}

__device__ void phase_ssdnorm(const Params& P) {
    const int lane = otid() & 63, wid = otid() >> 6;
    const bf16_t* proj = (const bf16_t*)(P.ws + WS_PROJ);
    const float* SSQ = (const float*)(P.ws + WS_SSQ);
    const int g = lane >> 5;
    constexpr int NR = 8;
    for (int t0 = (obid() * 8 + wid) * NR; t0 < T_TOK; t0 += gridDim.x * 8 * NR) {
        u32x4 in[NR][2]; f32x4 s0[NR], s1[NR];
#pragma unroll
        for (int k = 0; k < NR; ++k) {
            const bf16_t* src = proj + (size_t)(t0 + k) * PROJ_LD + C_Z + lane * 16;
            in[k][0] = *(const u32x4*)src; in[k][1] = *(const u32x4*)(src + 8);
            s0[k] = *(const f32x4*)(SSQ + (size_t)(t0 + k) * 16 + g * 8); s1[k] = *(const f32x4*)(SSQ + (size_t)(t0 + k) * 16 + g * 8 + 4);
        }
#pragma unroll
        for (int k = 0; k < NR; ++k) {
            const float sc = rsqrtf(((s0[k][0] + s0[k][1]) + (s0[k][2] + s0[k][3]) + (s1[k][0] + s1[k][1]) + (s1[k][2] + s1[k][3])) * (1.f / 512.f) + LN_EPS);
            u32x4 o;
#pragma unroll
            for (int i = 0; i < 2; ++i) {
                float v[8];
#pragma unroll
                for (int c = 0; c < 4; ++c) { v[2 * c] = bflo(in[k][i][c]); v[2 * c + 1] = bfhi(in[k][i][c]); }
                const u32x2 w = cvt8_fp8(v, sc);
                if (i) { o.z = w.x; o.w = w.y; } else { o.x = w.x; o.y = w.y; }
            }
            *(u32x4*)(P.ws + WS_MIX8 + (size_t)(t0 + k) * MIXW + 512 + lane * 16) = o;
        }
    }
}

__device__ void phase_ssdnorm_bf16(const Params& P) {
    bf16_t* proj = (bf16_t*)(P.ws + WS_PROJ);
    const float* SSQ = (const float*)(P.ws + WS_SSQ);
    for (size_t i = (size_t)obid() * NTHREADS + otid(); i < (size_t)T_TOK * 128; i += (size_t)gridDim.x * NTHREADS) {
        const size_t t = i >> 7; const int c8 = (int)(i & 127) * 8, g = c8 >> 9;
        const f32x4 s0 = *(const f32x4*)(SSQ + t * 16 + g * 8), s1 = *(const f32x4*)(SSQ + t * 16 + g * 8 + 4);
        const float ss = s0[0] + s0[1] + s0[2] + s0[3] + s1[0] + s1[1] + s1[2] + s1[3];
        const float sc = rsqrtf(ss * (1.f / 512.f) + LN_EPS);
        u32x4* p = (u32x4*)(proj + t * PROJ_LD + C_Z + c8);
        const u32x4 w = *p;
        u32x4 o; o.x = cvt_pk_bf16(bflo(w.x) * sc, bfhi(w.x) * sc); o.y = cvt_pk_bf16(bflo(w.y) * sc, bfhi(w.y) * sc);
        o.z = cvt_pk_bf16(bflo(w.z) * sc, bfhi(w.z) * sc); o.w = cvt_pk_bf16(bflo(w.w) * sc, bfhi(w.w) * sc);
        *p = o;
    }
}

__device__ __forceinline__ unsigned mono_(float f) { const unsigned u = __float_as_uint(f); return (u & 0x80000000u) ? ~u : (u | 0x80000000u); }
__device__ __forceinline__ float unmono_(unsigned u) { return __uint_as_float((u & 0x80000000u) ? (u ^ 0x80000000u) : ~u); }

__device__ void phase_peer_topk(const Params& P, int layer, LAS unsigned char* lds) {
    const int tid = otid(), lane = tid & 63, wid = tid >> 6, fr = lane & 15, fq = lane >> 4;
    const bf16_t* QP = (const bf16_t*)(P.ws + WS_QP);
    const bf16_t* keys = (const bf16_t*)(P.ws + WS_KEYS) + (size_t)layer * 2 * 128 * 64;
    unsigned short* IDX = (unsigned short*)(P.ws + WS_IDX);
    float* GATE = (float*)(P.ws + WS_GATE);
    LAS float* sSc = (LAS float*)lds;
    LAS unsigned* sTop = (LAS unsigned*)lds;
#define CE_D(a, b) do { const unsigned hi_ = umax_(a, b), lo_ = umin_(a, b); a = hi_; b = lo_; } while (0)
#define CE_A(a, b) do { const unsigned hi_ = umax_(a, b), lo_ = umin_(a, b); a = lo_; b = hi_; } while (0)
    for (int tile = obid(); tile < T_TOK / 32; tile += gridDim.x) {
        const int tok0 = tile * 32;
        unsigned top[16];
#pragma unroll
        for (int k = 0; k < 16; ++k) top[k] = 0u;
        bf16x8 qa[2][2][2];
#pragma unroll
        for (int i = 0; i < 2; ++i)
#pragma unroll
            for (int mt = 0; mt < 2; ++mt)
#pragma unroll
                for (int ks = 0; ks < 2; ++ks) qa[i][mt][ks] = *(const bf16x8*)(QP + (size_t)(tok0 + mt * 16 + fr) * DM + wid * 128 + i * 64 + ks * 32 + fq * 8);
        for (int ps = 0; ps < 2; ++ps) {
            bf16x8 kb[2][4][2];
#pragma unroll
            for (int i = 0; i < 2; ++i)
#pragma unroll
                for (int nt = 0; nt < 4; ++nt)
#pragma unroll
                    for (int ks = 0; ks < 2; ++ks) kb[i][nt][ks] = *(const bf16x8*)(keys + (size_t)(i * 128 + ps * 64 + nt * 16 + fr) * 64 + ks * 32 + fq * 8);
#pragma unroll
            for (int i = 0; i < 2; ++i)
#pragma unroll
                for (int mt = 0; mt < 2; ++mt)
#pragma unroll
                    for (int nt = 0; nt < 4; ++nt) {
                        f32x4 acc = {0.f, 0.f, 0.f, 0.f};
#pragma unroll
                        for (int ks = 0; ks < 2; ++ks) acc = MFMA16(qa[i][mt][ks], kb[i][nt][ks], acc);
#pragma unroll
                        for (int j = 0; j < 4; ++j) sSc[((wid * 2 + i) * 32 + mt * 16 + fq * 4 + j) * 65 + nt * 16 + fr] = acc[j];
                    }
            __syncthreads();
#pragma unroll 1
            for (int gq = 0; gq < 4; ++gq) {
                unsigned g_[16];
#pragma unroll
                for (int e = 0; e < 16; ++e) { const float sv_ = sSc[tid * 65 + gq * 16 + e]; g_[e] = (mono_(sv_) & ~0x7Fu) | (unsigned)(127 - (ps * 64 + gq * 16 + e)); }
                CE_D(g_[0], g_[1]); CE_A(g_[2], g_[3]); CE_D(g_[4], g_[5]); CE_A(g_[6], g_[7]); CE_D(g_[8], g_[9]); CE_A(g_[10], g_[11]); CE_D(g_[12], g_[13]); CE_A(g_[14], g_[15]); CE_D(g_[0], g_[2]); CE_D(g_[1], g_[3]); CE_A(g_[4], g_[6]); CE_A(g_[5], g_[7]); CE_D(g_[8], g_[10]); CE_D(g_[9], g_[11]); CE_A(g_[12], g_[14]); CE_A(g_[13], g_[15]); CE_D(g_[0], g_[1]); CE_D(g_[2], g_[3]); CE_A(g_[4], g_[5]); CE_A(g_[6], g_[7]); CE_D(g_[8], g_[9]); CE_D(g_[10], g_[11]); CE_A(g_[12], g_[13]); CE_A(g_[14], g_[15]); CE_D(g_[0], g_[4]); CE_D(g_[1], g_[5]); CE_D(g_[2], g_[6]); CE_D(g_[3], g_[7]); CE_A(g_[8], g_[12]); CE_A(g_[9], g_[13]); CE_A(g_[10], g_[14]); CE_A(g_[11], g_[15]); CE_D(g_[0], g_[2]); CE_D(g_[1], g_[3]); CE_D(g_[4], g_[6]); CE_D(g_[5], g_[7]); CE_A(g_[8], g_[10]); CE_A(g_[9], g_[11]); CE_A(g_[12], g_[14]); CE_A(g_[13], g_[15]); CE_D(g_[0], g_[1]); CE_D(g_[2], g_[3]); CE_D(g_[4], g_[5]); CE_D(g_[6], g_[7]); CE_A(g_[8], g_[9]); CE_A(g_[10], g_[11]); CE_A(g_[12], g_[13]); CE_A(g_[14], g_[15]); CE_D(g_[0], g_[8]); CE_D(g_[1], g_[9]); CE_D(g_[2], g_[10]); CE_D(g_[3], g_[11]); CE_D(g_[4], g_[12]); CE_D(g_[5], g_[13]); CE_D(g_[6], g_[14]); CE_D(g_[7], g_[15]); CE_D(g_[0], g_[4]); CE_D(g_[1], g_[5]); CE_D(g_[2], g_[6]); CE_D(g_[3], g_[7]); CE_D(g_[8], g_[12]); CE_D(g_[9], g_[13]); CE_D(g_[10], g_[14]); CE_D(g_[11], g_[15]); CE_D(g_[0], g_[2]); CE_D(g_[1], g_[3]); CE_D(g_[4], g_[6]); CE_D(g_[5], g_[7]); CE_D(g_[8], g_[10]); CE_D(g_[9], g_[11]); CE_D(g_[12], g_[14]); CE_D(g_[13], g_[15]); CE_D(g_[0], g_[1]); CE_D(g_[2], g_[3]); CE_D(g_[4], g_[5]); CE_D(g_[6], g_[7]); CE_D(g_[8], g_[9]); CE_D(g_[10], g_[11]); CE_D(g_[12], g_[13]); CE_D(g_[14], g_[15]);
#pragma unroll
                for (int e = 0; e < 16; ++e) top[e] = umax_(top[e], g_[15 - e]);
                CE_D(top[0], top[8]); CE_D(top[1], top[9]); CE_D(top[2], top[10]); CE_D(top[3], top[11]); CE_D(top[4], top[12]); CE_D(top[5], top[13]); CE_D(top[6], top[14]); CE_D(top[7], top[15]); CE_D(top[0], top[4]); CE_D(top[1], top[5]); CE_D(top[2], top[6]); CE_D(top[3], top[7]); CE_D(top[8], top[12]); CE_D(top[9], top[13]); CE_D(top[10], top[14]); CE_D(top[11], top[15]); CE_D(top[0], top[2]); CE_D(top[1], top[3]); CE_D(top[4], top[6]); CE_D(top[5], top[7]); CE_D(top[8], top[10]); CE_D(top[9], top[11]); CE_D(top[12], top[14]); CE_D(top[13], top[15]); CE_D(top[0], top[1]); CE_D(top[2], top[3]); CE_D(top[4], top[5]); CE_D(top[6], top[7]); CE_D(top[8], top[9]); CE_D(top[10], top[11]); CE_D(top[12], top[13]); CE_D(top[14], top[15]);
            }
            __syncthreads();
        }
#pragma unroll
        for (int q = 0; q < 4; ++q) *(LAS u32x4*)(sTop + tid * 16 + q * 4) = (u32x4){top[q * 4], top[q * 4 + 1], top[q * 4 + 2], top[q * 4 + 3]};
        __syncthreads();
        if (tid < 256) {
            const int token = tid & 31, h = tid >> 5;
            const int row1 = (h * 2) * 32 + token, row2 = (h * 2 + 1) * 32 + token;
            float s1[16], s2[16];
#pragma unroll
            for (int q = 0; q < 4; ++q) {
                const u32x4 a = *(const LAS u32x4*)(sTop + row1 * 16 + q * 4), bq = *(const LAS u32x4*)(sTop + row2 * 16 + q * 4);
#pragma unroll
                for (int e = 0; e < 4; ++e) { s1[q * 4 + e] = unmono_(a[e] & ~0x7Fu); s2[q * 4 + e] = unmono_(bq[e] & ~0x7Fu); }
            }
            unsigned best[16];
#pragma unroll
            for (int k = 0; k < 16; ++k) best[k] = 0u;
#pragma unroll
            for (int a = 0; a < 16; ++a)
#pragma unroll
                for (int bb = 0; bb < 16; ++bb) {
                    if ((a + 1) * (bb + 1) <= 16) {
                        unsigned x = (mono_(s1[a] + s2[bb]) & ~0xFFu) | (unsigned)(255 - (a * 16 + bb));
#pragma unroll
                        for (int q = 0; q < 16; ++q) { const unsigned hi = umax_(best[q], x); x = umin_(best[q], x); best[q] = hi; }
                    }
                }
            float val[16], gsum = 0.f;
            const float vmax = unmono_(best[0] & ~0xFFu);
#pragma unroll
            for (int k = 0; k < 16; ++k) { val[k] = __expf(unmono_(best[k] & ~0xFFu) - vmax); gsum += val[k]; }
            const float ginv = 1.f / gsum;
            const size_t ob = (size_t)(tok0 + token) * 128 + h * 16;
#pragma unroll
            for (int k = 0; k < 16; ++k) {
                const int code = 255 - (int)(best[k] & 0xFFu), a = code >> 4, bb = code & 15;
                const int i1 = 127 - (int)(sTop[row1 * 16 + a] & 0x7Fu), i2 = 127 - (int)(sTop[row2 * 16 + bb] & 0x7Fu);
                IDX[ob + k] = (unsigned short)(i1 * 128 + i2);
                GATE[ob + k] = val[k] * ginv;
            }
        }
        __syncthreads();
    }
}

#define FP4_PAIR(word, b) __builtin_amdgcn_cvt_scalef32_pk_f32_fp4((word), 1.0f, (b))
typedef _Float16 h16x2 __attribute__((ext_vector_type(2)));
#define FP4_H2(word, b) __builtin_amdgcn_cvt_scalef32_pk_f16_fp4((word), 1.0f, (b))
template <int CTLW>
__device__ __forceinline__ int peer_pull(const Params& P, int layer, int slice, int lane) {
    int tq = 0;
    if (lane == 0) tq = (int)atomicAdd((unsigned*)(P.ws + WS_CTL) + CTLW + 64 * (layer * 8 + slice), 16u);
    return __builtin_amdgcn_readfirstlane(tq);
}
template <int QW> __device__ void phase_peer_e1(const Params& P, int layer) {
    const int lane = otid() & 63, es = lane >> 3, ck = lane & 7;
    const bf16_t* hb = (const bf16_t*)(P.ws + WS_HB);
    const unsigned char* U4 = P.ws + WS_U8 + (size_t)layer * 16384 * 512;
    const unsigned short* IDX = (const unsigned short*)(P.ws + WS_IDX);
    unsigned* PD = (unsigned*)(P.ws + WS_PD);
    const int myx = (int)(xb_xcc_id() & 3u);
    const int src = (lane & 7) * 8 + (lane >> 3);
#define E1_IDX(dst, u) do { const unsigned short* ip_ = IDX + (size_t)(tq + (u)) * 128 + es; _Pragma("unroll") for (int i_ = 0; i_ < 16; ++i_) dst[i_] = (int)ip_[i_ * 8]; } while (0)
#define E1_ROWS(dst, ix) do { _Pragma("unroll") for (int i_ = 0; i_ < 16; ++i_) dst[i_] = *(const u32x4*)(Us + (size_t)ix[i_] * 128); } while (0)
#define E1_X(dst, u) do { const bf16_t* xp_ = hb + (size_t)(tq + (u)) * DM + j * 256 + ck * 32; _Pragma("unroll") for (int i_ = 0; i_ < 4; ++i_) dst[i_] = *(const u32x4*)(xp_ + 8 * i_); } while (0)
#define E1_COMPUTE(wv, xr, u) do { h16x2 X_[16]; _Pragma("unroll") for (int a_ = 0; a_ < 4; ++a_) _Pragma("unroll") for (int i_ = 0; i_ < 4; ++i_) X_[4 * a_ + i_] = (h16x2){(_Float16)bflo(xr[a_][i_]), (_Float16)bfhi(xr[a_][i_])}; \
        float k0_ = 0.f, k1_ = 0.f; \
        _Pragma("unroll") for (int i_ = 0; i_ < 16; ++i_) { \
            float d0_ = 0.f, d1_ = 0.f; \
            _Pragma("unroll") for (int q_ = 0; q_ < 4; ++q_) { d0_ = __builtin_amdgcn_fdot2(FP4_H2(wv[i_][q_], 0), X_[4 * q_], d0_, false); d1_ = __builtin_amdgcn_fdot2(FP4_H2(wv[i_][q_], 1), X_[4 * q_ + 1], d1_, false); \
                d0_ = __builtin_amdgcn_fdot2(FP4_H2(wv[i_][q_], 2), X_[4 * q_ + 2], d0_, false); d1_ = __builtin_amdgcn_fdot2(FP4_H2(wv[i_][q_], 3), X_[4 * q_ + 3], d1_, false); } \
            float d_ = d0_ + d1_; \
            d_ += dpp_<0xB1>(d_); d_ += dpp_<0x4E>(d_); d_ += dpp_<0x141>(d_); \
            if (i_ < 8) k0_ = (ck == i_) ? d_ : k0_; else k1_ = (ck == i_ - 8) ? d_ : k1_; } \
        PD[((size_t)(tq + (u)) * 4 + j) * 64 + lane] = cvt_pk_bf16(__shfl(k0_, src), __shfl(k1_, src)); } while (0)
    for (int k = 0; k < 4; ++k) {
        const int j = (myx + k) & 3;
        const unsigned char* Us = U4 + (size_t)j * (16384 * 128) + ck * 16;
        for (;;) {
            int tq = 0;
            if (lane == 0) tq = (int)atomicAdd((unsigned*)(P.ws + WS_CTL) + QW + 64 * (layer * 8 + j), 16u);
            tq = __builtin_amdgcn_readfirstlane(tq);
            if (tq >= T_TOK) break;
            int ix[16];
            E1_IDX(ix, 0);
            for (int u = 0; u < 16; ++u) {
                u32x4 wA[16], xA[4];
                E1_X(xA, u);
                E1_ROWS(wA, ix);
                if (u + 1 < 16) E1_IDX(ix, u + 1);
                E1_COMPUTE(wA, xA, u);
            }
        }
    }
#undef E1_IDX
#undef E1_ROWS
#undef E1_X
#undef E1_COMPUTE
}
template <bool DUMMY2> __device__ void phase_peer_e2(const Params& P, int layer) {
    const unsigned* PD = (const unsigned*)(P.ws + WS_PD);
    const unsigned short* IDX = (const unsigned short*)(P.ws + WS_IDX);
    float* GATE = (float*)(P.ws + WS_GATE);
    unsigned* IW = DUMMY2 ? (unsigned*)(P.ws + WS_STAT + (size_t)T_TOK * 64) : (unsigned*)GATE;
    const float* SU = (const float*)(P.ws + WS_SU) + layer * 16384;
    const float* SV = (const float*)(P.ws + WS_SV) + layer * 16384;
    for (size_t i4 = (size_t)obid() * NTHREADS + otid(); i4 < (size_t)T_TOK * 16; i4 += (size_t)gridDim.x * NTHREADS) {
        const size_t t = i4 >> 4; const int e = (int)(i4 & 15) * 4;
        f32x4 dlo = {0.f, 0.f, 0.f, 0.f}, dhi = {0.f, 0.f, 0.f, 0.f};
#pragma unroll
        for (int j = 0; j < 4; ++j) { const u32x4 w = *(const u32x4*)(PD + (t * 4 + j) * 64 + e);
#pragma unroll
            for (int c = 0; c < 4; ++c) { dlo[c] += bflo(w[c]); dhi[c] += bfhi(w[c]); } }
        const u32x2 ia = *(const u32x2*)(IDX + t * 128 + e), ib = *(const u32x2*)(IDX + t * 128 + 64 + e);
        const int il[4] = {(int)(ia.x & 0xffffu), (int)(ia.x >> 16), (int)(ia.y & 0xffffu), (int)(ia.y >> 16)};
        const int ih[4] = {(int)(ib.x & 0xffffu), (int)(ib.x >> 16), (int)(ib.y & 0xffffu), (int)(ib.y >> 16)};
        const f32x4 gl = *(const f32x4*)(GATE + t * 128 + e), gh = *(const f32x4*)(GATE + t * 128 + 64 + e);
        u32x4 ol, oh;
#pragma unroll
        for (int c = 0; c < 4; ++c) {
            const float wl = gl[c] * SV[il[c]] * gelu_cdf_(SU[il[c]] * dlo[c]), wh = gh[c] * SV[ih[c]] * gelu_cdf_(SU[ih[c]] * dhi[c]);
            ol[c] = (cvt_pk_bf16(0.f, wl) & 0xffff0000u) | (unsigned)il[c];
            oh[c] = (cvt_pk_bf16(0.f, wh) & 0xffff0000u) | (unsigned)ih[c];
        }
        *(u32x4*)(IW + t * 128 + e) = ol; *(u32x4*)(IW + t * 128 + 64 + e) = oh;
    }
}
template <int QW, bool DUMMY> __device__ void phase_peer_e3(const Params& P, int layer) {
    const int lane = otid() & 63, es = lane >> 3, ck = lane & 7;
    const unsigned char* V4 = P.ws + WS_V8 + (size_t)layer * 16384 * 512;
    const unsigned* IW = (const unsigned*)(P.ws + WS_GATE);
    float* STAT = (float*)(P.ws + WS_STAT);
    const int myx = (int)(xb_xcc_id() & 3u);
    const bool b5 = (lane & 32) != 0, b4 = (lane & 16) != 0, b3 = (lane & 8) != 0;
    for (int k = 0; k < 4; ++k) {
        const int j = (myx + k) & 3;
        const unsigned char* Vs = V4 + (size_t)j * (16384 * 128) + ck * 16;
        for (;;) {
            const int tq = peer_pull<QW>(P, layer, j, lane);
            if (tq >= T_TOK) break;
            unsigned iwn[16];
#pragma unroll
            for (int i = 0; i < 16; ++i) iwn[i] = IW[(size_t)tq * 128 + i * 8 + es];
            for (int t = tq; t < tq + 16; ++t) {
                int idx[16]; float wg[16];
#pragma unroll
                for (int i = 0; i < 16; ++i) { idx[i] = (int)(iwn[i] & 0xffffu); wg[i] = __uint_as_float(iwn[i] & 0xffff0000u); }
                u32x4 w[16];
#pragma unroll
                for (int i = 0; i < 16; ++i) w[i] = *(const u32x4*)(Vs + (size_t)idx[i] * 128);
                if (t + 1 < tq + 16) {
#pragma unroll
                    for (int i = 0; i < 16; ++i) iwn[i] = IW[(size_t)(t + 1) * 128 + i * 8 + es];
                }
                bf16_t* hrow = (bf16_t*)(P.ws + WS_HB) + (size_t)t * DM + j * 256 + ck * 32 + es * 4;
                bf16_t* yrow = DUMMY ? (bf16_t*)(P.ws + WS_PD) + (size_t)t * DM + j * 256 + ck * 32 + es * 4 : hrow;
                float* strow = DUMMY ? (float*)(P.ws + WS_PD) + (size_t)T_TOK * DM : STAT;
                const u32x2 hv = *(const u32x2*)hrow;
                h16x2 acc[16];
#pragma unroll
                for (int c = 0; c < 16; ++c) acc[c] = (h16x2){(_Float16)0.f, (_Float16)0.f};
#pragma unroll
                for (int i = 0; i < 16; ++i) {
                    const _Float16 wh = (_Float16)wg[i]; const h16x2 w2 = {wh, wh};
#pragma unroll
                    for (int q = 0; q < 4; ++q) { acc[4 * q] += FP4_H2(w[i][q], 0) * w2; acc[4 * q + 1] += FP4_H2(w[i][q], 1) * w2; acc[4 * q + 2] += FP4_H2(w[i][q], 2) * w2; acc[4 * q + 3] += FP4_H2(w[i][q], 3) * w2; }
                }
                h16x2 r16[8];
#pragma unroll
                for (int c = 0; c < 8; ++c) {
                    const h16x2 keep = b5 ? acc[8 + c] : acc[c], send = b5 ? acc[c] : acc[8 + c];
                    r16[c] = keep + __builtin_bit_cast(h16x2, __shfl_xor(__builtin_bit_cast(int, send), 32));
                }
                h16x2 r8[4];
#pragma unroll
                for (int c = 0; c < 4; ++c) {
                    const h16x2 keep = b4 ? r16[4 + c] : r16[c], send = b4 ? r16[c] : r16[4 + c];
                    r8[c] = keep + __builtin_bit_cast(h16x2, __shfl_xor(__builtin_bit_cast(int, send), 16));
                }
                f32x2 r4[2];
#pragma unroll
                for (int c = 0; c < 2; ++c) {
                    const h16x2 keep = b3 ? r8[2 + c] : r8[c], send = b3 ? r8[c] : r8[2 + c];
                    const h16x2 got = __builtin_bit_cast(h16x2, __builtin_amdgcn_mov_dpp(__builtin_bit_cast(int, send), 0x128, 0xf, 0xf, true));
                    r4[c] = (f32x2){(float)keep[0] + (float)got[0], (float)keep[1] + (float)got[1]};
                }
                float y[4];
                y[0] = DN_ALPHA * bflo(hv.x) + r4[0][0]; y[1] = DN_ALPHA * bfhi(hv.x) + r4[0][1]; y[2] = DN_ALPHA * bflo(hv.y) + r4[1][0]; y[3] = DN_ALPHA * bfhi(hv.y) + r4[1][1];
                u32x2 ov; ov.x = cvt_pk_bf16(y[0], y[1]); ov.y = cvt_pk_bf16(y[2], y[3]);
                *(u32x2*)yrow = ov;
                float s1 = (y[0] + y[1]) + (y[2] + y[3]), s2 = (y[0] * y[0] + y[1] * y[1]) + (y[2] * y[2] + y[3] * y[3]);
                s1 = wave_sum_dpp(s1); s2 = wave_sum_dpp(s2);
                if (lane == 0) { strow[((size_t)t * 4 + j) * 2] = s1; strow[((size_t)t * 4 + j) * 2 + 1] = s2; }
            }
        }
    }
}
__device__ void phase_peer_e4(const Params& P, int layer) {
    ln_rows_bf16<true>((bf16_t*)(P.ws + WS_HB), P.ws + WS_MIX8, (layer == DEPTH - 1) ? P.out : nullptr, (const float*)(P.ws + WS_STAT), P.ln2_g + layer * DM, P.ln2_b + layer * DM);
}

constexpr int N_SUB = 12;
constexpr int N_PHASES = 1 + N_SUB * DEPTH;
__global__ void __launch_bounds__(NTHREADS, 2) fwd_megakernel(Params P) {
    extern __shared__ __attribute__((aligned(16))) unsigned char lds_raw[];
    LAS unsigned char* lds = (LAS unsigned char*)lds_raw;
    cg::grid_group grid = cg::this_grid();
    unsigned char* ws = P.ws;
    volatile LAS unsigned* xb_st = (volatile LAS unsigned*)(lds + LDS_BYTES - 32);
    if (otid() < 2) xb_st[otid()] = 0u;
    __syncthreads();
    const XcdBarrier xbar = xcd_barrier_post((unsigned*)(ws + WS_CTL + 4096), xb_st);
#ifdef DEBUG_COPY
    const int ph_end = P.ph_hi + 1;
#else
    const int ph_end = P.ph_hi;
#endif
    for (int ph = P.ph_lo; ph < ph_end; ++ph) {
        if (ph > P.ph_lo) {
            if (ph == 1) {
                asm volatile("s_waitcnt vmcnt(0)" ::: "memory");
                __syncthreads();
                grid.sync();
                if (otid() < 64) { __builtin_amdgcn_fence(__ATOMIC_ACQUIRE, "agent"); asm volatile("s_waitcnt vmcnt(0)" ::: "memory"); }
                __syncthreads();
            } else {
                xcd_barrier(xbar);
            }
        }
#ifdef TS_SUB
        if (obid() == 0 && otid() == 0) ((unsigned long long*)(ws + WS_CTL + 32768))[ph] = __builtin_amdgcn_s_memrealtime();
#endif
        if (ph == 0) { phase_prep(P, lds); continue; }
#ifdef DEBUG_COPY
        if (ph == P.ph_hi) {
            const bf16_t* proj = (const bf16_t*)(ws + WS_PROJ);
            const float* DTp = (const float*)(ws + WS_DT);
            for (size_t i = (size_t)obid() * NTHREADS + otid(); i < (size_t)T_TOK * 1024; i += (size_t)gridDim.x * NTHREADS) {
                const size_t t = i >> 10; const int c = (int)(i & 1023);
                float v;
                if (c < 256) v = bf2f(proj[t * PROJ_LD + C_K + c]);
                else if (c < 1008) v = bf2f(proj[t * PROJ_LD + C_XBC + (c - 256) * 2]);
                else v = DTp[t * 16 + (c - 1008)];
                P.out[i] = v;
            }
            continue;
        }
#endif
        const int layer = (ph - 1) / N_SUB, sub = (ph - 1) % N_SUB;
        if (sub == 0 || sub == 4 || sub == 6) {
            pg8::Gemm g; pg8::Epi E; int N; bool f8;
            if (sub == 0) {
                f8 = FP8_IN;
                if (FP8_IN) g = pg8::Gemm{(const bf16_t*)(ws + WS_MIX8), (const bf16_t*)(ws + WS_WIN8 + (size_t)layer * N_IN * 1024), T_TOK, N_IN, 512, 512, 1 << 30, 0};
                else g = pg8::Gemm{(const bf16_t*)(ws + WS_HB), (const bf16_t*)(ws + WS_WIN) + (size_t)layer * N_IN * 1024, T_TOK, N_IN, 1024, 1024, 1 << 30, 0};
                E.mode = 0; E.eb = pg8::EpiBf16{(bf16_t*)(ws + WS_PROJ), PROJ_LD, 3584, (size_t)3600, FP8_IN ? 1.f / 32.f : 1.f}; E.er = pg8::EpiResBf16{nullptr, 0, 0.f, 1.f}; N = N_IN;
            } else if (sub == 4) {
                f8 = FP8_OUT;
                if (FP8_OUT) g = pg8::Gemm{(const bf16_t*)(ws + WS_MIX8), (const bf16_t*)(ws + WS_WOUT8 + (size_t)layer * 1024 * MIXW), T_TOK, 1024, 1024, 1024, 1 << 30, 0};
                else g = pg8::Gemm{(const bf16_t*)(ws + WS_PROJ) + C_GATE, (const bf16_t*)(ws + WS_WOUT) + (size_t)layer * 1024 * MIXW, T_TOK, 1024, MIXW, PROJ_LD, 24, (C_Q - (C_GATE + 1536)) * 2};
                E.mode = 1; E.eb = pg8::EpiBf16{nullptr, 0, 0, (size_t)0, 1.f}; E.er = pg8::EpiResBf16{(bf16_t*)(ws + WS_HB), DM, DN_ALPHA, FP8_OUT ? 1.f / 64.f : 1.f}; N = 1024;
            } else {
                f8 = FP8_Q;
                if (FP8_Q) g = pg8::Gemm{(const bf16_t*)(ws + WS_MIX8), (const bf16_t*)(ws + WS_WQ8 + (size_t)layer * 1024 * 1024), T_TOK, 1024, 512, 512, 1 << 30, 0};
                else g = pg8::Gemm{(const bf16_t*)(ws + WS_HB), (const bf16_t*)(ws + WS_WQ) + (size_t)layer * 1024 * 1024, T_TOK, 1024, 1024, 1024, 1 << 30, 0};
                E.mode = 0; E.eb = pg8::EpiBf16{(bf16_t*)(ws + WS_QP), DM, 0, (size_t)0, FP8_Q ? 1.f / 32.f : 1.f}; E.er = pg8::EpiResBf16{nullptr, 0, 0.f, 1.f}; N = 1024;
            }
            pg8::StaticOrder S; S.init(T_TOK, N, (int)gridDim.x, (int)obid());
            __syncthreads();
            if (f8) pg8::gemm_phase<true>(lds, g, S, E); else pg8::gemm_phase<false>(lds, g, S, E);
#ifdef EXP_GEMM_TWICE
            if (sub == EXP_GEMM_TWICE) { xcd_barrier(xbar); __syncthreads(); if (f8) pg8::gemm_phase<true>(lds, g, S, E); else pg8::gemm_phase<false>(lds, g, S, E); }
#endif
            if (sub == 0) phase_dt(P, layer);
        } else if (sub == 1) {
            phase_conv(P, layer);
        } else if (sub == 2) {
#ifndef SKIP_MIX
            phase_mixers(P, layer, lds);
#endif
        } else if (sub == 3) {
            if (FP8_OUT) phase_ssdnorm(P); else phase_ssdnorm_bf16(P);
        } else if (sub == 5) {
            ln_rows_bf16<false>((bf16_t*)(ws + WS_HB), ws + WS_MIX8, nullptr, nullptr, P.ln1_g + layer * DM, P.ln1_b + layer * DM);
        } else if (sub == 7) {
            phase_peer_topk(P, layer, lds);
#ifdef EXP_TOPK_TWICE
            xcd_barrier(xbar);
            phase_peer_topk(P, layer, lds);
#endif
        } else if (sub == 8) {
            phase_peer_e1<CTLW_QE1>(P, layer);
#ifdef EXP_E1_TWICE
            xcd_barrier(xbar);
            phase_peer_e1<7168>(P, layer);
#endif
        } else if (sub == 9) {
#ifdef EXP_E2_DUMMY
            phase_peer_e2<true>(P, layer);
            xcd_barrier(xbar);
#endif
            phase_peer_e2<false>(P, layer);
        } else if (sub == 10) {
#ifdef EXP_E3_DUMMY
            phase_peer_e3<7168, true>(P, layer);
            xcd_barrier(xbar);
#endif
            phase_peer_e3<CTLW_QE3, false>(P, layer);
        } else {
            phase_peer_e4(P, layer);
        }
    }
#ifdef TS_SUB
    if (obid() == 0 && otid() == 0) {
        unsigned long long* ts = (unsigned long long*)(ws + WS_CTL + 32768);
        const unsigned long long now = __builtin_amdgcn_s_memrealtime();
        ts[P.ph_hi] = now;
        unsigned long long d = 0;
        for (int ph = 0; ph < P.ph_hi; ++ph) {
            const bool sel = (TS_SUB == 20) ? (ph == 0) : (ph > 0 && ((ph - 1) % N_SUB) == TS_SUB);
            if (sel) d += ts[ph + 1] - ts[ph];
        }
        if (TS_SUB == 21) d = (ts[P.ph_hi] - ts[0]) / TS_AMP;
        if (TS_SUB >= 9 && TS_SUB < 20) d = ((unsigned long long*)(ws + WS_CTL + 40960))[TS_SUB];
        d *= TS_AMP;
        while (__builtin_amdgcn_s_memrealtime() - now < d) __builtin_amdgcn_s_sleep(32);
    }
#endif
}

extern "C" void kernel_launch(void* const* d_in, const int* in_sizes, int n_in, void* d_out, int out_size, void* d_ws, size_t ws_size, hipStream_t stream) {
    static int grid_blocks = 0;
    if (grid_blocks == 0) {
        if (n_in != 27 || out_size != T_TOK * DM || ws_size < WS_END) { fprintf(stderr, "kernel_launch: unexpected shapes (n_in %d out %d ws %zu need %zu)\n", n_in, out_size, ws_size, (size_t)WS_END); grid_blocks = -1; return; }
        int dev = 0, cus = 0, per_cu = 0;
        hipGetDevice(&dev);
        hipDeviceGetAttribute(&cus, hipDeviceAttributeMultiprocessorCount, dev);
        if (hipFuncSetAttribute((const void*)fwd_megakernel, hipFuncAttributeMaxDynamicSharedMemorySize, LDS_BYTES) != hipSuccess) { fprintf(stderr, "kernel_launch: hipFuncSetAttribute failed\n"); grid_blocks = -1; return; }
        hipOccupancyMaxActiveBlocksPerMultiprocessor(&per_cu, (const void*)fwd_megakernel, NTHREADS, LDS_BYTES);
        if (per_cu < 1) { fprintf(stderr, "kernel_launch: occupancy query says %d blocks per CU\n", per_cu); grid_blocks = -1; return; }
        grid_blocks = cus;
    }
    if (grid_blocks < 0) return;
    hipMemsetAsync((char*)d_ws + WS_CTL, 0, 65536, stream);
    Params p{};
    const float** pp = (const float**)&p;
    for (int i = 0; i < 27; ++i) pp[i] = (const float*)d_in[i];
    p.out = (float*)d_out; p.ws = (unsigned char*)d_ws; p.ph_lo = 0; p.ph_hi = PH_HI;
    void* args[] = {&p};
    hipError_t e = hipLaunchCooperativeKernel((const void*)fwd_megakernel, dim3(grid_blocks), dim3(NTHREADS), args, LDS_BYTES, stream);
    if (e != hipSuccess) fprintf(stderr, "cooperative launch failed: %s (grid %d)\n", hipGetErrorString(e), grid_blocks);
}
```

```cpp
#include <hip/hip_runtime.h>
#include <hip/hip_cooperative_groups.h>
#include <cstdio>
#include <cstdint>
namespace cg = cooperative_groups;
#ifndef PH_HI
#define PH_HI N_PHASES
#endif
#ifdef TS_SUB
#ifndef TS_AMP
#define TS_AMP 4
#endif
#endif
#ifndef FP8_IN
#define FP8_IN 0
#endif
#ifndef FP8_OUT
#define FP8_OUT 1
#endif
#ifndef FP8_Q
#define FP8_Q 0
#endif
#if FP8_OUT && (FP8_IN || FP8_Q)
#error "the fp8 mix buffer shares workspace with the fp8 copies of the other GEMMs"
#endif
#ifndef MIX_MASK
#define MIX_MASK 7
#endif

#define LAS __attribute__((address_space(3)))
typedef unsigned short bf16_t;
typedef short bf16x8 __attribute__((ext_vector_type(8)));
typedef float f32x4 __attribute__((ext_vector_type(4)));
typedef float f32x2 __attribute__((ext_vector_type(2)));
typedef unsigned u32x4 __attribute__((ext_vector_type(4)));
typedef unsigned u32x2 __attribute__((ext_vector_type(2)));
using bf16x2v = __attribute__((ext_vector_type(2))) __bf16;

constexpr int T_TOK = 65536, DM = 1024, SEQ = 4096, NBATCH = 16, DEPTH = 2;
constexpr int PROJ_LD = 4368;
constexpr int C_RGX = 0, C_GATE = 512, C_Z = 1024, C_XBC = 2048, C_DT = 3584, C_Q = 3600, C_K = 4112, C_V = 4240;
constexpr int N_IN = 4352;
constexpr int MIXW = 2048;
constexpr float DN_ALPHA = 1.41421356237f;
constexpr float LN_EPS = 1e-5f;
constexpr int NTHREADS = 512;
constexpr int LDS_BYTES = 147456;

constexpr size_t WS_CTL  = 0;
constexpr size_t WS_WIN  = 65536;
constexpr size_t WS_WDT  = WS_WIN  + (size_t)2 * N_IN * 1024 * 2;
constexpr size_t WS_WOUT = WS_WDT  + (size_t)2 * 16 * 1024 * 2;
constexpr size_t WS_WQ   = WS_WOUT + (size_t)2 * 1024 * 2048 * 2;
constexpr size_t WS_KEYS = WS_WQ   + (size_t)2 * 1024 * 1024 * 2;
constexpr size_t WS_WA   = WS_KEYS + (size_t)2 * 2 * 128 * 64 * 2;
constexpr size_t WS_WX   = WS_WA   + (size_t)2 * 8 * 64 * 64 * 2;
constexpr size_t WS_U    = WS_WX   + (size_t)2 * 8 * 64 * 64 * 2;
constexpr size_t WS_V    = WS_U    + (size_t)2 * 16384 * 1024 * 2;
constexpr size_t WS_HB   = WS_V    + (size_t)2 * 16384 * 1024 * 2;
constexpr size_t WS_DT   = WS_HB   + (size_t)T_TOK * 1024 * 2;
constexpr size_t WS_SSQ  = WS_DT   + (size_t)T_TOK * 16 * 4;
constexpr size_t WS_PROJ = WS_SSQ  + (size_t)T_TOK * 16 * 4;
constexpr size_t WS_PEND = WS_PROJ + (size_t)T_TOK * PROJ_LD * 2;
constexpr size_t WS_HB8  = WS_PEND;
constexpr size_t WS_WIN8 = WS_HB8 + (size_t)T_TOK * 1024;
constexpr size_t WS_WQ8  = WS_WIN8 + (size_t)2 * N_IN * 1024;
constexpr size_t WS_MIX8 = WS_PEND;
constexpr size_t WS_WOUT8 = WS_MIX8 + (size_t)T_TOK * MIXW;
constexpr size_t WS_END  = WS_WOUT8 + (size_t)2 * 1024 * MIXW;
constexpr size_t WS_U8 = WS_U, WS_SU = WS_U + (size_t)2 * 16384 * 1024;
constexpr size_t WS_V8 = WS_V, WS_SV = WS_V + (size_t)2 * 16384 * 1024;
constexpr size_t WS_QP   = WS_PROJ;
constexpr size_t WS_IDX  = WS_QP  + (size_t)T_TOK * 1024 * 2;
constexpr size_t WS_GATE = WS_IDX + (size_t)T_TOK * 128 * 4;
constexpr size_t WS_PD   = WS_GATE + (size_t)T_TOK * 128 * 4;
constexpr size_t WS_STAT = WS_PD + (size_t)T_TOK * 8 * 128 * 4;
static_assert(WS_STAT + (size_t)T_TOK * 8 * 2 * 4 <= WS_PEND, "PEER buffers must fit inside the proj region");
static_assert(WS_END <= ((size_t)1 << 30), "workspace must fit 1 GiB");
constexpr int CTLW_QE1 = 5120, CTLW_QE3 = 6144;

struct Params {
    const float* x; const float* emb_g; const float* emb_b; const float* w_in; const float* rg_conv_w; const float* rg_conv_b;
    const float* rg_wa; const float* rg_ba; const float* rg_wx; const float* rg_bx; const float* rg_lambda;
    const float* ssm_conv_w; const float* ssm_conv_b; const float* ssm_dt_bias; const float* ssm_a_log; const float* ssm_d; const float* ssm_norm_g;
    const float* attn_sinks; const float* w_out; const float* ln1_g; const float* ln1_b;
    const float* peer_wq; const float* peer_keys; const float* peer_u; const float* peer_v; const float* ln2_g; const float* ln2_b;
    float* out; unsigned char* ws; int ph_lo, ph_hi;
};

typedef __bf16 bf16x2n __attribute__((ext_vector_type(2)));
__device__ __forceinline__ unsigned cvt_pk_bf16(float lo, float hi) { const f32x2 v = {lo, hi}; const bf16x2n r = __builtin_convertvector(v, bf16x2n); return __builtin_bit_cast(unsigned, r); }
__device__ __forceinline__ bf16_t f2bf(float f) { return (bf16_t)(cvt_pk_bf16(f, 0.f) & 0xffffu); }
__device__ __forceinline__ float bf2f(bf16_t b) { return __uint_as_float(((unsigned)b) << 16); }
__device__ __forceinline__ float bflo(unsigned w) { return __uint_as_float(w << 16); }
__device__ __forceinline__ float bfhi(unsigned w) { return __uint_as_float(w & 0xffff0000u); }
__device__ __forceinline__ float sigmoidf_(float x) { return __builtin_amdgcn_rcpf(1.f + __expf(-x)); }
__device__ __forceinline__ float siluf_(float x) { return x * __builtin_amdgcn_rcpf(1.f + __expf(-x)); }
__device__ __forceinline__ float softplusf_(float x) { return x > 20.f ? x : log1pf(__expf(x)); }
__device__ __forceinline__ float gelu_tanhf_(float x) { const float u = 0.7978845608028654f * (x + 0.044715f * x * x * x); const float t = 1.f - 2.f * __builtin_amdgcn_rcpf(__expf(2.f * u) + 1.f); return 0.5f * x * (1.f + t); }
__device__ __forceinline__ float gelu_erff_(float x) { return 0.5f * x * (1.f + erff(x * 0.70710678118654752f)); }
__device__ __forceinline__ float wave_sum(float v) {
#pragma unroll
    for (int o = 32; o > 0; o >>= 1) v += __shfl_xor(v, o);
    return v;
}
template <int CTRL> __device__ __forceinline__ float dpp_(float x) { return __builtin_bit_cast(float, __builtin_amdgcn_mov_dpp(__builtin_bit_cast(int, x), CTRL, 0xf, 0xf, true)); }
__device__ __forceinline__ float row_sum16(float x) { x += dpp_<0xB1>(x); x += dpp_<0x4E>(x); x += dpp_<0x141>(x); x += dpp_<0x128>(x); return x; }
__device__ __forceinline__ float rdlane(float x, int l) { return __builtin_bit_cast(float, __builtin_amdgcn_readlane(__builtin_bit_cast(int, x), l)); }
__device__ __forceinline__ float wave_sum_dpp(float x) { x = row_sum16(x); return (rdlane(x, 0) + rdlane(x, 16)) + (rdlane(x, 32) + rdlane(x, 48)); }
__device__ __forceinline__ float gelu_cdf_(float v) {
    const float av = fabsf(v), t = __builtin_amdgcn_rcpf(av * 0.2316418882f + 1.0f);
    float q = t * 0.5307027145f + (-0.7265760135f); q = q * t + 0.7107068705f; q = q * t + (-0.142248368f); q = q * t + 0.127414796f; q = q * t;
    const float e = __builtin_amdgcn_exp2f(v * v * (-0.72134752044f));
    const float m = v * (q * e), r = v - m;
    return v < 0.f ? m : r;
}
__device__ __forceinline__ float dot2bf(unsigned a, unsigned b, float acc) { return __builtin_amdgcn_fdot2_f32_bf16(__builtin_bit_cast(bf16x2v, a), __builtin_bit_cast(bf16x2v, b), acc, false); }
__device__ __forceinline__ unsigned umax_(unsigned a, unsigned b) { return a > b ? a : b; }
__device__ __forceinline__ unsigned umin_(unsigned a, unsigned b) { return a < b ? a : b; }
__device__ __forceinline__ u32x2 cvt8_fp8(const float* v, float sc) {
    int a = 0, b = 0;
    a = __builtin_amdgcn_cvt_pk_fp8_f32(v[0] * sc, v[1] * sc, a, false); a = __builtin_amdgcn_cvt_pk_fp8_f32(v[2] * sc, v[3] * sc, a, true);
    b = __builtin_amdgcn_cvt_pk_fp8_f32(v[4] * sc, v[5] * sc, b, false); b = __builtin_amdgcn_cvt_pk_fp8_f32(v[6] * sc, v[7] * sc, b, true);
    u32x2 r; r.x = (unsigned)a; r.y = (unsigned)b; return r;
}
__device__ __forceinline__ int otid() { int t = (int)threadIdx.x; asm volatile("" : "+v"(t)); return t; }
__device__ __forceinline__ int obid() { int b = (int)blockIdx.x; asm volatile("" : "+s"(b)); return b; }
#define MFMA16(a, b, c) __builtin_amdgcn_mfma_f32_16x16x32_bf16((a), (b), (c), 0, 0, 0)

#define XB_TMO      128
#define XB_XCNT(j)  (256  + 64 * (j))
#define XB_XSUB(j)  (1280 + 64 * (j))
#define XB_XGEN(j)  (2304 + 64 * (j))
#define XB_TOP      3328
#define XB_TOPGEN   3392
#define XCD_BAR_WORDS 3456
#define XB_SPIN_CAP (1u << 22)
__device__ __forceinline__ unsigned xb_ld(unsigned* p)              { return __hip_atomic_load(p, __ATOMIC_RELAXED, __HIP_MEMORY_SCOPE_AGENT); }
__device__ __forceinline__ unsigned xb_add(unsigned* p, unsigned v) { return __hip_atomic_fetch_add(p, v, __ATOMIC_RELAXED, __HIP_MEMORY_SCOPE_AGENT); }
__device__ __forceinline__ unsigned xb_xcc_id() { return (unsigned)__builtin_amdgcn_s_getreg((3 << 11) | 20) & 0xFu; }
#define XB_SPIN(cond, bar) do { unsigned _sp = 0; while (cond) { __builtin_amdgcn_s_sleep(1); \
    if ((++_sp & 255u) == 0u) { if (xb_ld(&(bar)[XB_TMO])) break; if (_sp > XB_SPIN_CAP) { atomicAdd(&(bar)[XB_TMO], 1u); break; } } } } while (0)
struct XcdBarrier { unsigned* bar; unsigned x; volatile LAS unsigned* st; };
__device__ __forceinline__ XcdBarrier xcd_barrier_post(unsigned* bar, volatile LAS unsigned* st) {
    XcdBarrier b; b.bar = bar; b.x = xb_xcc_id(); b.st = st;
    if (otid() == 0) (void)xb_add(&bar[XB_XCNT(b.x)], 1u);
    return b;
}
__device__ __forceinline__ void xcd_barrier_complete(unsigned* bar, unsigned x, unsigned& nloc, unsigned& nx) {
    const unsigned G = gridDim.x * gridDim.y * gridDim.z;
    unsigned sum, cnt, mine, sp = 0u;
    for (;;) {
        sum = 0u; cnt = 0u; mine = 0u;
#pragma unroll
        for (unsigned j = 0; j < 16; ++j) { const unsigned c = xb_ld(&bar[XB_XCNT(j)]); sum += c; cnt += (c > 0u) ? 1u : 0u; mine = (j == x) ? c : mine; }
        if (sum == G) break;
        __builtin_amdgcn_s_sleep(1);
        if ((++sp & 255u) == 0u) { if (xb_ld(&bar[XB_TMO])) break; if (sp > XB_SPIN_CAP) { atomicAdd(&bar[XB_TMO], 1u); break; } }
    }
    nloc = mine > 0u ? mine : 1u; nx = cnt > 0u ? cnt : 1u;
}
__device__ __forceinline__ void xcd_barrier(const XcdBarrier& b) {
    asm volatile("s_waitcnt vmcnt(0)" ::: "memory");
    __syncthreads();
    if (otid() == 0) {
        unsigned* bar = b.bar;
        __builtin_amdgcn_s_waitcnt(0);
        unsigned nloc = b.st[0], nx = b.st[1];
        if (nloc == 0u) { xcd_barrier_complete(bar, b.x, nloc, nx); b.st[0] = nloc; b.st[1] = nx; }
        const unsigned old = xb_add(&bar[XB_XSUB(b.x)], 1u);
        const unsigned gen = old / nloc;
        if (old + 1u == (gen + 1u) * nloc) {
            __builtin_amdgcn_fence(__ATOMIC_RELEASE, "agent");
            asm volatile("s_waitcnt vmcnt(0)" ::: "memory");
            const unsigned og = xb_add(&bar[XB_TOP], 1u);
            const unsigned tg = og / nx;
            if (og + 1u == (tg + 1u) * nx) xb_add(&bar[XB_TOPGEN], 1u);
            else XB_SPIN(xb_ld(&bar[XB_TOPGEN]) == tg, bar);
            __builtin_amdgcn_fence(__ATOMIC_ACQUIRE, "agent");
            xb_add(&bar[XB_XGEN(b.x)], 1u);
            asm volatile("s_waitcnt vmcnt(0)" ::: "memory");
        } else {
            XB_SPIN(xb_ld(&bar[XB_XGEN(b.x)]) == gen, bar);
            __builtin_amdgcn_fence(__ATOMIC_ACQUIRE, "agent");
            asm volatile("s_waitcnt vmcnt(0)" ::: "memory");
        }
    }
    __syncthreads();
}

namespace pg8 {
typedef int v8i32_t __attribute__((ext_vector_type(8)));
typedef int v4i32_t __attribute__((ext_vector_type(4)));
constexpr int BM = 256, BK = 64, HALF = 128, HTB = HALF * BK * 2, STAGE_BYTES = 8 * HTB, NXCD = 8, WGM = 4;
__device__ __forceinline__ int lds_byte(int r, int c) { const int st = (r >> 4) * 2 + (c >> 5), rr = r & 15, cc = c & 31, ob = rr * 64 + cc * 2; return st * 1024 + (ob ^ (((ob >> 9) & 1) << 5)); }
__device__ __forceinline__ void stage_rc(int b, int& R, int& C) { const int st = b / 1024, sb = b % 1024, swz = sb ^ (((sb >> 9) & 1) << 5); R = (st >> 1) * 16 + swz / 64; C = (st & 1) * 32 + (swz % 64) / 2; }
__device__ __forceinline__ int perm32(int rho) { const int n = rho >> 4, i = rho & 15; return 8 * (i >> 2) + 4 * n + (i & 3); }
struct Unit { int pm, pn; };
struct Gemm { const bf16_t* A; const bf16_t* Bt; int M, N, K, lda, ksplit, kextra; };
struct StaticOrder {
    int nM, nN, nwg, G, c;
    __device__ void init(int M, int N, int G_, int c_) { nM = M / BM; nN = N / BM; nwg = nM * nN; G = G_; c = c_; }
    __device__ bool next(int i, Unit& u) const {
        const long L = (long)i * G + c; if (L >= nwg) return false;
        int wgid = (int)L; { const int q = nwg / NXCD, r = nwg % NXCD, xcd = wgid % NXCD, off = wgid / NXCD; wgid = (xcd < r ? xcd * (q + 1) : r * (q + 1) + (xcd - r) * q) + off; }
        const int nig = WGM * nN, gid = wgid / nig, fm = gid * WGM, gsz = (nM - fm) < WGM ? (nM - fm) : WGM;
        u.pm = fm + ((wgid % nig) % gsz); u.pn = (wgid % nig) / gsz; return true;
    }
};
struct EpiBf16 {
    static constexpr bool PERM = true;
    bf16_t* O; int ldc; int split_cols; size_t split_stride; float oscale;
    __device__ __forceinline__ void operator()(const f32x4 (&acc)[2][2][4][2], const Unit& u, int wr, int wc, int fr, int fq) const {
        const int row0 = u.pm * BM + wr * 64 + fr; int colt = u.pn * BM; bf16_t* base = O;
        if (split_cols) { const int t = colt / split_cols; base += (size_t)t * split_stride; colt -= t * split_cols; }
        const int col0 = colt + wc * 32 + 8 * fq;
#pragma unroll
        for (int ai = 0; ai < 2; ++ai)
#pragma unroll
            for (int m = 0; m < 4; ++m) { bf16_t* rowp = base + (size_t)(row0 + ai * HALF + m * 16) * ldc + col0;
#pragma unroll
                for (int bj = 0; bj < 2; ++bj) { const f32x4 v0 = acc[ai][bj][m][0] * oscale, v1 = acc[ai][bj][m][1] * oscale;
                    u32x4 w; w.x = cvt_pk_bf16(v0[0], v0[1]); w.y = cvt_pk_bf16(v0[2], v0[3]); w.z = cvt_pk_bf16(v1[0], v1[1]); w.w = cvt_pk_bf16(v1[2], v1[3]);
                    *(u32x4*)(rowp + bj * HALF) = w; } }
    }
};
struct EpiResBf16 {
    bf16_t* H; int ldc; float alpha; float oscale;
    __device__ __forceinline__ void operator()(const f32x4 (&acc)[2][2][4][2], const Unit& u, int wr, int wc, int fr, int fq) const {
        const int row0 = u.pm * BM + wr * 64 + fr, col0 = u.pn * BM + wc * 32 + 8 * fq;
#pragma unroll
        for (int ai = 0; ai < 2; ++ai)
#pragma unroll
            for (int m = 0; m < 4; ++m) { bf16_t* rowp = H + (size_t)(row0 + ai * HALF + m * 16) * ldc + col0;
#pragma unroll
                for (int bj = 0; bj < 2; ++bj) { u32x4* p = (u32x4*)(rowp + bj * HALF); const u32x4 h = *p; const f32x4 v0 = acc[ai][bj][m][0] * oscale, v1 = acc[ai][bj][m][1] * oscale;
                    u32x4 w; w.x = cvt_pk_bf16(alpha * bflo(h.x) + v0[0], alpha * bfhi(h.x) + v0[1]); w.y = cvt_pk_bf16(alpha * bflo(h.y) + v0[2], alpha * bfhi(h.y) + v0[3]);
                    w.z = cvt_pk_bf16(alpha * bflo(h.z) + v1[0], alpha * bfhi(h.z) + v1[1]); w.w = cvt_pk_bf16(alpha * bflo(h.w) + v1[2], alpha * bfhi(h.w) + v1[3]);
                    *p = w; } }
    }
};
struct Epi {
    int mode; EpiBf16 eb; EpiResBf16 er;
};
template <bool FP8>
__device__ __forceinline__ void gemm_phase(LAS unsigned char* lds, const Gemm g, const StaticOrder& S, const Epi& E) {
    const int tid = otid(), wid = __builtin_amdgcn_readfirstlane(tid >> 6), lane = tid & 63, wr = wid >> 2, wc = wid & 3, fr = lane & 15, fq = lane >> 4;
    const int K = g.K, nt = K / BK, lda = g.lda;
    unsigned voffA[2], voffB[2];
#pragma unroll
    for (int i = 0; i < 2; ++i) { int R, C; stage_rc(tid * 16 + i * 8192, R, C); const int Rb = (R & ~31) + perm32(R & 31);
        voffA[i] = (unsigned)(R * lda + C) * 2u; voffB[i] = (unsigned)(Rb * K + C) * 2u; }
    const size_t kstep = (size_t)(BK * 2);
    const size_t hstepA = (size_t)HALF * lda * 2, hstepB = (size_t)HALF * K * 2;
    const size_t tstepA = 2 * hstepA, tstepB = 2 * hstepB;
    const int ksplit = g.ksplit; const size_t kextra = (size_t)g.kextra;
#define PG8_AKOFF(t) ((size_t)(t) * kstep + (((t) >= ksplit) ? kextra : (size_t)0))
    const unsigned ldsw = (unsigned)wid * 1024u;
    const int aoff = lds_byte(wr * 64 + fr, fq * 8), boff = lds_byte(wc * 32 + fr, fq * 8);
#define PG8_SA(b, h) (((b) * 2 + (h)) * HTB)
#define PG8_SB(b, h) ((4 + (b) * 2 + (h)) * HTB)
#define PG8_STAGE(bufoff, gbase, voff) do { _Pragma("unroll") for (int _i = 0; _i < 2; ++_i) \
        __builtin_amdgcn_global_load_lds((const unsigned*)((const char*)(gbase) + (voff)[_i]), (LAS unsigned*)(lds + (bufoff) + ldsw + _i * 8192), 16, 0, 0); } while (0)
#define PG8_LDA(dst, b, h) do { _Pragma("unroll") for (int m = 0; m < 4; ++m) dst[m] = __builtin_shufflevector(*(const LAS v4i32_t*)(lds + PG8_SA(b, h) + aoff + m * 2048), *(const LAS v4i32_t*)(lds + PG8_SA(b, h) + aoff + m * 2048 + 1024), 0, 1, 2, 3, 4, 5, 6, 7); } while (0)
#define PG8_LDB(dst, b, h) do { _Pragma("unroll") for (int n = 0; n < 2; ++n) dst[n] = __builtin_shufflevector(*(const LAS v4i32_t*)(lds + PG8_SB(b, h) + boff + n * 2048), *(const LAS v4i32_t*)(lds + PG8_SB(b, h) + boff + n * 2048 + 1024), 0, 1, 2, 3, 4, 5, 6, 7); } while (0)
#define PG8_MMA8(ai, bj, At, Bt) do { __builtin_amdgcn_s_setprio(1); _Pragma("unroll") for (int m = 0; m < 4; ++m) _Pragma("unroll") for (int n = 0; n < 2; ++n) \
        asm volatile("s_nop 1\n\tv_mfma_scale_f32_16x16x128_f8f6f4 %0, %1, %2, %0, %3, %3 op_sel_hi:[0,0,0]" : "+v"(acc[ai][bj][m][n]) : "v"(Bt[n]), "v"(At[m]), "v"(mxscale)); \
        __builtin_amdgcn_s_setprio(0); } while (0)
#define PG8_MMA16(ai, bj, At, Bt) do { __builtin_amdgcn_s_setprio(1); _Pragma("unroll") for (int m = 0; m < 4; ++m) _Pragma("unroll") for (int n = 0; n < 2; ++n) { \
        acc[ai][bj][m][n] = __builtin_amdgcn_mfma_f32_16x16x32_bf16(__builtin_bit_cast(bf16x8, __builtin_shufflevector(Bt[n], Bt[n], 0, 1, 2, 3)), __builtin_bit_cast(bf16x8, __builtin_shufflevector(At[m], At[m], 0, 1, 2, 3)), acc[ai][bj][m][n], 0, 0, 0); \
        acc[ai][bj][m][n] = __builtin_amdgcn_mfma_f32_16x16x32_bf16(__builtin_bit_cast(bf16x8, __builtin_shufflevector(Bt[n], Bt[n], 4, 5, 6, 7)), __builtin_bit_cast(bf16x8, __builtin_shufflevector(At[m], At[m], 4, 5, 6, 7)), acc[ai][bj][m][n], 0, 0, 0); } \
        __builtin_amdgcn_s_setprio(0); } while (0)
#define PG8_MM(ai, bj, At, Bt) do { if (FP8) PG8_MMA8(ai, bj, At, Bt); else PG8_MMA16(ai, bj, At, Bt); } while (0)
#define PG8_WAIT_V(n) asm volatile("s_waitcnt vmcnt(" #n ")" ::: "memory")
#define PG8_WAIT_L(n) asm volatile("s_waitcnt lgkmcnt(" #n ")" ::: "memory")
#define PG8_BAR __builtin_amdgcn_s_barrier()
#define PG8_SCHED __builtin_amdgcn_sched_barrier(0)
    Unit cur, nxt; int ui = 0;
    if (!S.next(0, cur)) return;
    f32x4 acc[2][2][4][2];
#pragma unroll
    for (int a = 0; a < 2; ++a)
#pragma unroll
        for (int b = 0; b < 2; ++b)
#pragma unroll
            for (int m = 0; m < 4; ++m)
#pragma unroll
                for (int n = 0; n < 2; ++n) acc[a][b][m][n] = (f32x4){0.f, 0.f, 0.f, 0.f};
    v8i32_t At[4], B0[2], B1[2];
    const int mxscale = 0x7F7F7F7F;
    const char* cA = (const char*)g.A + (size_t)cur.pm * tstepA; const char* cB = (const char*)g.Bt + (size_t)cur.pn * tstepB;
    PG8_STAGE(PG8_SB(0, 0), cB, voffB); PG8_STAGE(PG8_SA(0, 0), cA, voffA); PG8_STAGE(PG8_SB(0, 1), cB + hstepB, voffB); PG8_STAGE(PG8_SA(0, 1), cA + hstepA, voffA);
    if (wr == 1) PG8_BAR;
    PG8_WAIT_V(4); PG8_BAR;
    PG8_STAGE(PG8_SB(1, 0), cB + kstep, voffB); PG8_STAGE(PG8_SA(1, 0), cA + PG8_AKOFF(1), voffA); PG8_STAGE(PG8_SB(1, 1), cB + hstepB + kstep, voffB);
    PG8_WAIT_V(6); PG8_BAR;
    for (;;) {
        const bool has_next = S.next(ui + 1, nxt);
        const char* nA = has_next ? (const char*)g.A + (size_t)nxt.pm * tstepA : cA; const char* nB = has_next ? (const char*)g.Bt + (size_t)nxt.pn * tstepB : cB;
        for (int t = 0; t < nt; t += 2) {
            const bool last = (t == nt - 2);
            const char* a1 = cA + PG8_AKOFF(t + 1);
            const char* a2 = last ? nA : cA + PG8_AKOFF(t + 2); const char* b2 = last ? nB : cB + (size_t)(t + 2) * kstep;
            const char* a3 = last ? nA + PG8_AKOFF(1) : cA + PG8_AKOFF(t + 3); const char* b3 = b2 + kstep;
            PG8_LDB(B0, 0, 0); PG8_SCHED; PG8_LDA(At, 0, 0); PG8_STAGE(PG8_SA(1, 1), a1 + hstepA, voffA);
            PG8_WAIT_L(8); PG8_BAR; PG8_WAIT_L(0); PG8_MM(0, 0, At, B0); PG8_BAR; PG8_SCHED;
            PG8_LDB(B1, 0, 1); PG8_STAGE(PG8_SB(0, 0), b2, voffB);
            PG8_BAR; PG8_WAIT_L(0); PG8_MM(0, 1, At, B1); PG8_BAR;
            PG8_LDA(At, 0, 1); PG8_STAGE(PG8_SA(0, 0), a2, voffA);
            PG8_BAR; PG8_WAIT_L(0); PG8_MM(1, 0, At, B0); PG8_BAR; PG8_SCHED;
            PG8_STAGE(PG8_SB(0, 1), b2 + hstepB, voffB);
            PG8_WAIT_V(6); PG8_BAR; PG8_MM(1, 1, At, B1); PG8_BAR;
            PG8_LDB(B0, 1, 0); PG8_SCHED; PG8_LDA(At, 1, 0); PG8_STAGE(PG8_SA(0, 1), a2 + hstepA, voffA);
            PG8_WAIT_L(8); PG8_BAR; PG8_WAIT_L(0); PG8_MM(0, 0, At, B0); PG8_BAR; PG8_SCHED;
            PG8_LDB(B1, 1, 1); PG8_STAGE(PG8_SB(1, 0), b3, voffB);
            PG8_BAR; PG8_WAIT_L(0); PG8_MM(0, 1, At, B1); PG8_BAR;
            PG8_LDA(At, 1, 1); PG8_STAGE(PG8_SA(1, 0), a3, voffA);
            PG8_BAR; PG8_WAIT_L(0); PG8_MM(1, 0, At, B0); PG8_BAR; PG8_SCHED;
            PG8_STAGE(PG8_SB(1, 1), b3 + hstepB, voffB);
            PG8_WAIT_V(6); PG8_BAR; PG8_MM(1, 1, At, B1); PG8_BAR;
        }
        asm volatile("s_nop 15\n\ts_nop 15" ::: "memory");
        if (E.mode == 0) E.eb(acc, cur, wr, wc, fr, fq); else E.er(acc, cur, wr, wc, fr, fq);
        if (!has_next) break;
#pragma unroll
        for (int a = 0; a < 2; ++a)
#pragma unroll
            for (int b = 0; b < 2; ++b)
#pragma unroll
                for (int m = 0; m < 4; ++m)
#pragma unroll
                    for (int n = 0; n < 2; ++n) acc[a][b][m][n] = (f32x4){0.f, 0.f, 0.f, 0.f};
        cur = nxt; cA = nA; cB = nB; ++ui;
    }
    PG8_WAIT_V(0);
    if (wr == 0) PG8_BAR;
    PG8_BAR;
#undef PG8_AKOFF
#undef PG8_SA
#undef PG8_SB
#undef PG8_STAGE
#undef PG8_LDA
#undef PG8_LDB
#undef PG8_MMA8
#undef PG8_MMA16
#undef PG8_MM
#undef PG8_WAIT_V
#undef PG8_WAIT_L
#undef PG8_BAR
#undef PG8_SCHED
}
}

__device__ __forceinline__ void tr_tile(LAS float* s, const float* src, int ld_src, int k0, int c0, bf16_t* dst, int ld_dst, int n0, const float* scale, unsigned char* dst8 = nullptr, float sc8 = 32.f) {
    const int tid = otid();
    {
        const int r = tid >> 4, c4 = (tid & 15) * 4;
#pragma unroll
        for (int p = 0; p < 2; ++p) {
            const int rr = r + p * 32;
            f32x4 v = *(const f32x4*)(src + (size_t)(k0 + rr) * ld_src + c0 + c4);
            if (scale) { const float sc = scale[rr]; v = v * sc; }
            s[rr * 65 + c4 + 0] = v[0]; s[rr * 65 + c4 + 1] = v[1]; s[rr * 65 + c4 + 2] = v[2]; s[rr * 65 + c4 + 3] = v[3];
        }
    }
    __syncthreads();
    {
        const int n = tid >> 3, kq = (tid & 7) * 8;
        float v[8];
#pragma unroll
        for (int j = 0; j < 8; ++j) v[j] = s[(kq + j) * 65 + n];
        u32x4 w; w.x = cvt_pk_bf16(v[0], v[1]); w.y = cvt_pk_bf16(v[2], v[3]); w.z = cvt_pk_bf16(v[4], v[5]); w.w = cvt_pk_bf16(v[6], v[7]);
        *(u32x4*)(dst + (size_t)(n0 + n) * ld_dst + k0 + kq) = w;
        if (dst8) *(u32x2*)(dst8 + (size_t)(n0 + n) * ld_dst + k0 + kq) = cvt8_fp8(v, sc8);
    }
    __syncthreads();
}

__device__ __forceinline__ void convert_rows(const float* src, bf16_t* dst, size_t n_elems) {
    const size_t n8 = n_elems / 8;
    for (size_t i = (size_t)obid() * NTHREADS + otid(); i < n8; i += (size_t)gridDim.x * NTHREADS) {
        const f32x4 a = *(const f32x4*)(src + i * 8), b = *(const f32x4*)(src + i * 8 + 4);
        u32x4 w; w.x = cvt_pk_bf16(a[0], a[1]); w.y = cvt_pk_bf16(a[2], a[3]); w.z = cvt_pk_bf16(b[0], b[1]); w.w = cvt_pk_bf16(b[2], b[3]);
        *(u32x4*)(dst + i * 8) = w;
    }
}

__device__ __forceinline__ void ln_rows_f32(const float* in, bf16_t* hb, unsigned char* hb8, const float* g, const float* bta) {
    const int lane = otid() & 63, wid = otid() >> 6;
    f32x4 gg[4], bb[4];
#pragma unroll
    for (int i = 0; i < 4; ++i) { gg[i] = ((const f32x4*)g)[lane + 64 * i]; bb[i] = ((const f32x4*)bta)[lane + 64 * i]; }
    for (int r = obid() * 8 + wid; r < T_TOK; r += gridDim.x * 8) {
        const f32x4* xr = (const f32x4*)(in + (size_t)r * DM);
        f32x4 v[4]; float s = 0.f;
#pragma unroll
        for (int i = 0; i < 4; ++i) { v[i] = xr[lane + 64 * i]; s += v[i][0] + v[i][1] + v[i][2] + v[i][3]; }
        s = wave_sum(s);
        const float mu = s * (1.f / DM);
        float q = 0.f;
#pragma unroll
        for (int i = 0; i < 4; ++i) { v[i] = v[i] - mu; q += v[i][0] * v[i][0] + v[i][1] * v[i][1] + v[i][2] * v[i][2] + v[i][3] * v[i][3]; }
        q = wave_sum(q);
        const float rs = rsqrtf(q * (1.f / DM) + LN_EPS);
        u32x2* hrow = (u32x2*)(hb + (size_t)r * DM);
#pragma unroll
        for (int i = 0; i < 4; ++i) {
            const f32x4 o = v[i] * rs * gg[i] + bb[i];
            u32x2 w; w.x = cvt_pk_bf16(o[0], o[1]); w.y = cvt_pk_bf16(o[2], o[3]);
            hrow[lane + 64 * i] = w;
            if (FP8_IN || FP8_Q) { int d8 = 0; d8 = __builtin_amdgcn_cvt_pk_fp8_f32(o[0], o[1], d8, false); d8 = __builtin_amdgcn_cvt_pk_fp8_f32(o[2], o[3], d8, true);
                ((unsigned*)(hb8 + (size_t)r * DM))[lane + 64 * i] = (unsigned)d8; }
        }
    }
}
template <bool HAVE_STAT>
__device__ __forceinline__ void ln_rows_bf16(bf16_t* hb, unsigned char* hb8, float* out_f32, const float* STAT, const float* g, const float* bta) {
    const int lane = otid() & 63, wid = otid() >> 6;
    f32x4 gg[4], bb[4];
#pragma unroll
    for (int i = 0; i < 2; ++i) { gg[2 * i] = *(const f32x4*)(g + i * 512 + lane * 8); gg[2 * i + 1] = *(const f32x4*)(g + i * 512 + lane * 8 + 4);
        bb[2 * i] = *(const f32x4*)(bta + i * 512 + lane * 8); bb[2 * i + 1] = *(const f32x4*)(bta + i * 512 + lane * 8 + 4); }
    constexpr int NR = 4;
    for (int r0 = (obid() * 8 + wid) * NR; r0 < T_TOK; r0 += gridDim.x * 8 * NR) {
        u32x4 ra[NR], rb[NR]; f32x4 st[NR][2];
#pragma unroll
        for (int k = 0; k < NR; ++k) {
            const bf16_t* hrow = hb + (size_t)(r0 + k) * DM;
            ra[k] = *(const u32x4*)(hrow + lane * 8); rb[k] = *(const u32x4*)(hrow + 512 + lane * 8);
            if (HAVE_STAT) {
#pragma unroll
                for (int q = 0; q < 2; ++q) st[k][q] = *(const f32x4*)(STAT + (size_t)(r0 + k) * 8 + 4 * q);
            }
        }
#pragma unroll
        for (int k = 0; k < NR; ++k) {
            const int r = r0 + k;
            bf16_t* hrow = hb + (size_t)r * DM;
            float v[16];
#pragma unroll
            for (int i = 0; i < 4; ++i) { v[2 * i] = bflo(ra[k][i]); v[2 * i + 1] = bfhi(ra[k][i]); v[8 + 2 * i] = bflo(rb[k][i]); v[8 + 2 * i + 1] = bfhi(rb[k][i]); }
            float mu, rs;
            if (HAVE_STAT) {
                const float s1 = (st[k][0][0] + st[k][0][2]) + (st[k][1][0] + st[k][1][2]);
                const float s2 = (st[k][0][1] + st[k][0][3]) + (st[k][1][1] + st[k][1][3]);
                mu = s1 * (1.f / DM);
                rs = rsqrtf(fmaxf(s2 * (1.f / DM) - mu * mu, 0.f) + LN_EPS);
            } else {
                float sm = 0.f;
#pragma unroll
                for (int i = 0; i < 16; ++i) sm += v[i];
                sm = wave_sum(sm);
                mu = sm * (1.f / DM);
                float q = 0.f;
#pragma unroll
                for (int i = 0; i < 16; ++i) { const float d = v[i] - mu; q += d * d; }
                q = wave_sum(q);
                rs = rsqrtf(q * (1.f / DM) + LN_EPS);
            }
            float o[16];
#pragma unroll
            for (int i = 0; i < 4; ++i)
#pragma unroll
                for (int c = 0; c < 4; ++c) o[4 * i + c] = (v[4 * i + c] - mu) * rs * gg[i][c] + bb[i][c];
            u32x4 w0, w1;
            w0.x = cvt_pk_bf16(o[0], o[1]); w0.y = cvt_pk_bf16(o[2], o[3]); w0.z = cvt_pk_bf16(o[4], o[5]); w0.w = cvt_pk_bf16(o[6], o[7]);
            w1.x = cvt_pk_bf16(o[8], o[9]); w1.y = cvt_pk_bf16(o[10], o[11]); w1.z = cvt_pk_bf16(o[12], o[13]); w1.w = cvt_pk_bf16(o[14], o[15]);
            *(u32x4*)(hrow + lane * 8) = w0; *(u32x4*)(hrow + 512 + lane * 8) = w1;
            if (FP8_IN || FP8_Q) { *(u32x2*)(hb8 + (size_t)r * DM + lane * 8) = cvt8_fp8(o, 1.f); *(u32x2*)(hb8 + (size_t)r * DM + 512 + lane * 8) = cvt8_fp8(o + 8, 1.f); }
            if (out_f32) {
                float* orow = out_f32 + (size_t)r * DM;
                *(f32x4*)(orow + lane * 8) = (f32x4){o[0], o[1], o[2], o[3]}; *(f32x4*)(orow + lane * 8 + 4) = (f32x4){o[4], o[5], o[6], o[7]};
                *(f32x4*)(orow + 512 + lane * 8) = (f32x4){o[8], o[9], o[10], o[11]}; *(f32x4*)(orow + 512 + lane * 8 + 4) = (f32x4){o[12], o[13], o[14], o[15]};
            }
        }
    }
}

__device__ void phase_prep(const Params& P, LAS unsigned char* lds) {
    unsigned char* ws = P.ws;
#ifdef TS_SUB
    if (obid() == 0 && otid() < 16) ((unsigned long long*)(ws + WS_CTL + 40960))[otid()] = 0ull;
#endif
    if (obid() == 0 && otid() < 2 * DEPTH) __hip_atomic_store((unsigned*)(ws + WS_CTL) + 64 * (1 + otid()), 0u, __ATOMIC_RELAXED, __HIP_MEMORY_SCOPE_AGENT);
    if (obid() == 0 && otid() < 32) __hip_atomic_store((unsigned*)(ws + WS_CTL) + ((otid() < 16) ? CTLW_QE1 : CTLW_QE3 - 16 * 64) + 64 * otid(), 0u, __ATOMIC_RELAXED, __HIP_MEMORY_SCOPE_AGENT);
    LAS float* s = (LAS float*)lds;
    const int n_win = 2 * 68 * 16, n_wout = 2 * 16 * 32, n_wq = 2 * 16 * 16, n_g = 2 * 8 * 2;
    const int total = n_win + n_wout + n_wq + n_g;
    for (int j = obid(); j < total; j += gridDim.x) {
        if (j < n_win) {
            const int l = j / (68 * 16), r = j % (68 * 16), nt = r / 16, kt = r % 16;
            const int n0 = nt * 64, c0 = n0 < 3584 ? n0 : n0 + 16;
            tr_tile(s, P.w_in + (size_t)l * 1024 * PROJ_LD, PROJ_LD, kt * 64, c0, (bf16_t*)(ws + WS_WIN) + (size_t)l * N_IN * 1024, 1024, n0, nullptr, FP8_IN ? ws + WS_WIN8 + (size_t)l * N_IN * 1024 : nullptr);
        } else if (j < n_win + n_wout) {
            const int jj = j - n_win, l = jj / (16 * 32), r = jj % (16 * 32), nt = r / 32, kt = r % 32;
            const int k0 = kt * 64;
            const float* sc = (k0 >= 512 && k0 < 1536) ? P.ssm_norm_g + l * 1024 + (k0 - 512) : nullptr;
            tr_tile(s, P.w_out + (size_t)l * MIXW * 1024, 1024, k0, nt * 64, (bf16_t*)(ws + WS_WOUT) + (size_t)l * 1024 * MIXW, MIXW, nt * 64, sc, FP8_OUT ? ws + WS_WOUT8 + (size_t)l * 1024 * MIXW : nullptr, 64.f);
        } else if (j < n_win + n_wout + n_wq) {
            const int jj = j - n_win - n_wout, l = jj / 256, r = jj % 256, nt = r / 16, kt = r % 16;
            tr_tile(s, P.peer_wq + (size_t)l * 1024 * 1024, 1024, kt * 64, nt * 64, (bf16_t*)(ws + WS_WQ) + (size_t)l * 1024 * 1024, 1024, nt * 64, nullptr, FP8_Q ? ws + WS_WQ8 + (size_t)l * 1024 * 1024 : nullptr);
        } else {
            const int jj = j - n_win - n_wout - n_wq, which = jj / 16, lb = jj % 16;
            const float* src = (which ? P.rg_wx : P.rg_wa) + (size_t)lb * 4096;
            bf16_t* dst = (bf16_t*)(ws + (which ? WS_WX : WS_WA)) + (size_t)lb * 4096;
            tr_tile(s, src, 64, 0, 0, dst, 64, 0, nullptr);
        }
    }
    for (int i = obid() * NTHREADS + otid(); i < 2 * 16 * 1024; i += gridDim.x * NTHREADS) {
        const int l = i >> 14, j = (i >> 10) & 15, k = i & 1023;
        ((bf16_t*)(ws + WS_WDT))[i] = f2bf(P.w_in[((size_t)l * 1024 + k) * PROJ_LD + C_DT + j]);
    }
    convert_rows(P.peer_keys, (bf16_t*)(ws + WS_KEYS), (size_t)2 * 2 * 128 * 64);
    {
        const int lane = otid() & 63, wid = otid() >> 6;
        for (int r = obid() * 8 + wid; r < 2 * 2 * 16384; r += gridDim.x * 8) {
            const int which = r >> 15, row = r & 32767;
            const float* src = (which ? P.peer_v : P.peer_u) + (size_t)row * DM + lane * 16;
            f32x4 v[4]; float amax = 0.f;
#pragma unroll
            for (int i = 0; i < 4; ++i) { v[i] = *(const f32x4*)(src + 4 * i); amax = fmaxf(amax, fmaxf(fmaxf(fabsf(v[i][0]), fabsf(v[i][1])), fmaxf(fabsf(v[i][2]), fabsf(v[i][3])))); }
#pragma unroll
            for (int o = 32; o > 0; o >>= 1) amax = fmaxf(amax, __shfl_xor(amax, o));
            const float inv = amax > 0.f ? 6.f / amax : 0.f;
            u32x2 w;
#pragma unroll
            for (int i = 0; i < 2; ++i) { unsigned q = 0;
                q = __builtin_amdgcn_cvt_scalef32_pk_fp4_f32(q, v[2 * i][0] * inv, v[2 * i][1] * inv, 1.0f, 0); q = __builtin_amdgcn_cvt_scalef32_pk_fp4_f32(q, v[2 * i][2] * inv, v[2 * i][3] * inv, 1.0f, 1);
                q = __builtin_amdgcn_cvt_scalef32_pk_fp4_f32(q, v[2 * i + 1][0] * inv, v[2 * i + 1][1] * inv, 1.0f, 2); q = __builtin_amdgcn_cvt_scalef32_pk_fp4_f32(q, v[2 * i + 1][2] * inv, v[2 * i + 1][3] * inv, 1.0f, 3);
                w[i] = q; }
            *(u32x2*)(ws + (which ? WS_V8 : WS_U8) + (size_t)(row >> 14) * (16384 * 512) + (size_t)(lane >> 4) * (16384 * 128) + (size_t)(row & 16383) * 128 + (lane & 15) * 8) = w;
            if (lane == 0) ((float*)(ws + (which ? WS_SV : WS_SU)))[row] = amax * (1.f / 6.f);
        }
    }
    ln_rows_f32(P.x, (bf16_t*)(ws + WS_HB), ws + WS_MIX8, P.emb_g, P.emb_b);
}

__device__ void phase_dt(const Params& P, int layer) {
    const int lane = otid() & 63, wid = otid() >> 6;
    const bf16_t* hb = (const bf16_t*)(P.ws + WS_HB);
    const bf16_t* wdt = (const bf16_t*)(P.ws + WS_WDT) + (size_t)layer * 16 * 1024;
    float* DT = (float*)(P.ws + WS_DT);
    const float bias = P.ssm_dt_bias[layer * 16 + (lane & 15)];
    for (int task = obid() * 8 + wid; task < T_TOK / 16; task += gridDim.x * 8) {
        const int t0 = task * 16;
        f32x4 acc = {0.f, 0.f, 0.f, 0.f};
        const bf16_t* ap = hb + (size_t)(t0 + (lane & 15)) * DM + (lane >> 4) * 8;
        const bf16_t* bp = wdt + (size_t)(lane & 15) * DM + (lane >> 4) * 8;
#pragma unroll 8
        for (int ks = 0; ks < 32; ++ks) {
            const bf16x8 a = *(const bf16x8*)(ap + ks * 32), b = *(const bf16x8*)(bp + ks * 32);
            acc = MFMA16(a, b, acc);
        }
#pragma unroll
        for (int j = 0; j < 4; ++j) DT[(size_t)(t0 + (lane >> 4) * 4 + j) * 16 + (lane & 15)] = softplusf_(acc[j] + bias);
    }
}

__device__ void phase_conv(const Params& P, int layer) {
    const int tid = otid();
    bf16_t* proj = (bf16_t*)(P.ws + WS_PROJ);
    for (int tile = obid(); tile < 128; tile += gridDim.x) {
        const int b = tile >> 3, slab = tile & 7;
        const int cg = tid & 7, chx = 1024 + slab * 64 + cg * 8;
        float cw[4][8], cb[8];
#pragma unroll
        for (int j = 0; j < 8; ++j) {
            cb[j] = P.ssm_conv_b[layer * 1536 + chx + j];
#pragma unroll
            for (int i = 0; i < 4; ++i) cw[i][j] = P.ssm_conv_w[(layer * 4 + i) * 1536 + chx + j];
        }
        bf16_t* base = proj + (size_t)b * SEQ * PROJ_LD + C_XBC + chx;
        const int r0 = tid >> 3;
        u32x4 tap[4][4];
#define CONV_LOAD(c) do { _Pragma("unroll") for (int it = 0; it < 4; ++it) _Pragma("unroll") for (int i = 0; i < 4; ++i) { \
            const int pos = (c) * 256 + r0 + it * 64 - 3 + i; \
            tap[it][i] = (pos >= 0) ? *(const u32x4*)(base + (size_t)pos * PROJ_LD) : (u32x4){0u, 0u, 0u, 0u}; } } while (0)
        CONV_LOAD(15);
        for (int c = 15; c >= 0; --c) {
            u32x4 res[4];
#pragma unroll
            for (int it = 0; it < 4; ++it) {
                float v[8];
#pragma unroll
                for (int j = 0; j < 8; ++j) v[j] = cb[j];
#pragma unroll
                for (int i = 0; i < 4; ++i) {
                    const u32x4 w = tap[it][i];
                    v[0] += cw[i][0] * bflo(w.x); v[1] += cw[i][1] * bfhi(w.x); v[2] += cw[i][2] * bflo(w.y); v[3] += cw[i][3] * bfhi(w.y);
                    v[4] += cw[i][4] * bflo(w.z); v[5] += cw[i][5] * bfhi(w.z); v[6] += cw[i][6] * bflo(w.w); v[7] += cw[i][7] * bfhi(w.w);
                }
#pragma unroll
                for (int j = 0; j < 8; ++j) v[j] = siluf_(v[j]);
                res[it].x = cvt_pk_bf16(v[0], v[1]); res[it].y = cvt_pk_bf16(v[2], v[3]); res[it].z = cvt_pk_bf16(v[4], v[5]); res[it].w = cvt_pk_bf16(v[6], v[7]);
            }
            if (c > 0) CONV_LOAD(c - 1);
            __syncthreads();
#pragma unroll
            for (int it = 0; it < 4; ++it) *(u32x4*)(base + (size_t)(c * 256 + r0 + it * 64) * PROJ_LD) = res[it];
        }
#undef CONV_LOAD
        __syncthreads();
    }
}

typedef short v4i16_t __attribute__((ext_vector_type(4)));
__device__ __forceinline__ bf16x8 tr_frag(const LAS bf16_t* base, int stride, int kbase, int n0, int fr, int fq) {
    const LAS bf16_t* p = base + (kbase + fq * 8 + (fr >> 2)) * stride + n0 + (fr & 3) * 4;
    const v4i16_t lo = __builtin_amdgcn_ds_read_tr16_b64_v4i16((LAS v4i16_t*)p);
    const v4i16_t hi = __builtin_amdgcn_ds_read_tr16_b64_v4i16((LAS v4i16_t*)(p + 4 * stride));
    return (bf16x8){lo[0], lo[1], lo[2], lo[3], hi[0], hi[1], hi[2], hi[3]};
}

__device__ void ssd_tile(const Params& P, int layer, int b, int h, LAS unsigned char* lds) {
    const int tid = otid(), lane = tid & 63, wid = tid >> 6, fr = lane & 15, fq = lane >> 4;
    bf16_t* proj = (bf16_t*)(P.ws + WS_PROJ);
    const float* DT = (const float*)(P.ws + WS_DT);
    float* SSQ = (float*)(P.ws + WS_SSQ);
    const int g = h >> 3;
    LAS bf16_t* sC = (LAS bf16_t*)lds;
    LAS bf16_t* sB = sC + 64 * 136;
    LAS bf16_t* sS = sB + 64 * 136;
    LAS bf16_t* sXH = sS + 64 * 136;
    LAS bf16_t* sXD = sXH + 64 * 72;
    LAS bf16_t* sM = sXD + 64 * 72;
    LAS float* sY = (LAS float*)(sM + 64 * 72);
    LAS float* sAcs = sY + 64 * 68;
    LAS float* sDt = sAcs + 128;
    LAS bf16_t* sXR = (LAS bf16_t*)(sDt + 128);
    LAS bf16_t* sXHalo = sXR + 64 * 72;
    const float a_h = -__expf(P.ssm_a_log[layer * 16 + h]);
    const float d_h = P.ssm_d[layer * 16 + h];
    int goff[5], loff[5];
#pragma unroll
    for (int it = 0; it < 5; ++it) {
        const int i = it * NTHREADS + tid, row = i / 40, c2 = i % 40;
        int ch, lo;
        if (c2 < 8) { ch = h * 64 + c2 * 8; lo = (int)(sXR - sC) + row * 72 + c2 * 8; }
        else if (c2 < 24) { ch = 1024 + g * 128 + (c2 - 8) * 8; lo = (int)(sB - sC) + row * 136 + (c2 - 8) * 8; }
        else { ch = 1280 + g * 128 + (c2 - 24) * 8; lo = row * 136 + (c2 - 24) * 8; }
        goff[it] = row * PROJ_LD + C_XBC + ch; loff[it] = lo;
    }
    const bf16_t* pbase = proj + (size_t)b * SEQ * PROJ_LD;
    float cw[4][8], cb[8];
#pragma unroll
    for (int j = 0; j < 8; ++j) {
        const int ch = h * 64 + (tid & 7) * 8 + j;
        cb[j] = P.ssm_conv_b[layer * 1536 + ch];
#pragma unroll
        for (int i = 0; i < 4; ++i) cw[i][j] = P.ssm_conv_w[(layer * 4 + i) * 1536 + ch];
    }
    for (int i = tid; i < 3 * 72 / 2; i += NTHREADS) ((LAS unsigned*)(sXHalo + 3 * 72))[i] = 0u;
    for (int i = tid; i < 64 * 136 / 2; i += NTHREADS) ((LAS unsigned*)sS)[i] = 0u;
    f32x4 accS[4];
#pragma unroll
    for (int q = 0; q < 4; ++q) accS[q] = (f32x4){0.f, 0.f, 0.f, 0.f};
    u32x4 raw[5];
#pragma unroll
    for (int it = 0; it < 5; ++it) raw[it] = *(const u32x4*)(pbase + goff[it]);
    float dtn = 0.f, dtc = 0.f;
    if (wid == 0) { dtc = DT[(size_t)(b * SEQ + lane) * 16 + h]; dtn = DT[(size_t)(b * SEQ + 64 + lane) * 16 + h]; }
#pragma unroll
    for (int it = 0; it < 5; ++it) {
        *(LAS u32x4*)(sC + loff[it]) = raw[it];
        const int i_ = it * NTHREADS + tid, row_ = i_ / 40, c2_ = i_ % 40;
        if (c2_ < 8 && row_ >= 61) *(LAS u32x4*)(sXHalo + (row_ - 61) * 72 + c2_ * 8) = raw[it];
    }
    if (wid == 0) {
        float v = dtc * a_h;
#pragma unroll
        for (int o = 1; o < 64; o <<= 1) { const float n = __shfl_up(v, o); if (lane >= o) v += n; }
        sDt[lane] = dtc; sAcs[lane] = v;
    }
    __syncthreads();
    const int dl = tid >> 3, dp8 = (tid & 7) * 8;
    for (int c = 0; c < 64; ++c) {
        const int t0 = b * SEQ + c * 64;
        if (c + 1 < 64) {
            const bf16_t* nb = pbase + (size_t)(c + 1) * 64 * PROJ_LD;
#pragma unroll
            for (int it = 0; it < 5; ++it) raw[it] = *(const u32x4*)(nb + goff[it]);
            if (wid == 0) {
                float v = dtn * a_h;
#pragma unroll
                for (int o = 1; o < 64; o <<= 1) { const float n = __shfl_up(v, o); if (lane >= o) v += n; }
                sDt[((c + 1) & 1) * 64 + lane] = dtn; sAcs[((c + 1) & 1) * 64 + lane] = v;
                if (c + 2 < 64) dtn = DT[(size_t)(t0 + 128 + lane) * 16 + h];
            }
        }
        const LAS float* cAcs = sAcs + (c & 1) * 64; const LAS float* cDt = sDt + (c & 1) * 64;
        const size_t ga = (size_t)(t0 + dl) * PROJ_LD + C_Z + h * 64 + dp8;
        const u32x4 zw = *(const u32x4*)(proj + ga);
        {
            const LAS bf16_t* halo = sXHalo + ((c + 1) & 1) * (3 * 72);
            float v[8];
#pragma unroll
            for (int j = 0; j < 8; ++j) v[j] = cb[j];
#pragma unroll
            for (int i = 0; i < 4; ++i) {
                const int r = dl - 3 + i;
                const u32x4 w = (r >= 0) ? *(const LAS u32x4*)(sXR + r * 72 + dp8) : *(const LAS u32x4*)(halo + (r + 3) * 72 + dp8);
                v[0] += cw[i][0] * bflo(w.x); v[1] += cw[i][1] * bfhi(w.x); v[2] += cw[i][2] * bflo(w.y); v[3] += cw[i][3] * bfhi(w.y);
                v[4] += cw[i][4] * bflo(w.z); v[5] += cw[i][5] * bfhi(w.z); v[6] += cw[i][6] * bflo(w.w); v[7] += cw[i][7] * bfhi(w.w);
            }
#pragma unroll
            for (int j = 0; j < 8; ++j) v[j] = siluf_(v[j]);
            const float dd = cDt[dl] * __expf(cAcs[63] - cAcs[dl]);
            u32x4 o1; o1.x = cvt_pk_bf16(v[0], v[1]); o1.y = cvt_pk_bf16(v[2], v[3]); o1.z = cvt_pk_bf16(v[4], v[5]); o1.w = cvt_pk_bf16(v[6], v[7]);
            u32x4 o3; o3.x = cvt_pk_bf16(v[0] * dd, v[1] * dd); o3.y = cvt_pk_bf16(v[2] * dd, v[3] * dd); o3.z = cvt_pk_bf16(v[4] * dd, v[5] * dd); o3.w = cvt_pk_bf16(v[6] * dd, v[7] * dd);
            *(LAS u32x4*)(sXH + dl * 72 + dp8) = o1;
            *(LAS u32x4*)(sXD + dl * 72 + dp8) = o3;
        }
        const int lt = wid >> 1, ph = wid & 1;
        f32x4 accY[2];
        {
            bf16x8 aC[4];
#pragma unroll
            for (int ks = 0; ks < 4; ++ks) aC[ks] = *(const LAS bf16x8*)(sC + (lt * 16 + fr) * 136 + ks * 32 + fq * 8);
#pragma unroll
            for (int tt = 0; tt < 2; ++tt) {
                const int st = ph * 2 + tt;
                f32x4 accG = {0.f, 0.f, 0.f, 0.f};
#pragma unroll
                for (int ks = 0; ks < 4; ++ks) { const bf16x8 bb = *(const LAS bf16x8*)(sB + (st * 16 + fr) * 136 + ks * 32 + fq * 8); accG = MFMA16(aC[ks], bb, accG); }
                const int s_idx = st * 16 + fr; const float acs_s = cAcs[s_idx], dt_s = cDt[s_idx];
#pragma unroll
                for (int j = 0; j < 4; ++j) {
                    const int l = lt * 16 + fq * 4 + j;
                    const float val = (s_idx <= l) ? accG[j] * __expf(cAcs[l] - acs_s) * dt_s : 0.f;
                    sM[l * 72 + s_idx] = f2bf(val);
                }
            }
#pragma unroll
            for (int tt = 0; tt < 2; ++tt) {
                const int pt = ph * 2 + tt;
                f32x4 a = {0.f, 0.f, 0.f, 0.f};
#pragma unroll
                for (int ks = 0; ks < 4; ++ks) { const bf16x8 bb = *(const LAS bf16x8*)(sS + (pt * 16 + fr) * 136 + ks * 32 + fq * 8); a = MFMA16(aC[ks], bb, a); }
#pragma unroll
                for (int j = 0; j < 4; ++j) a[j] *= __expf(cAcs[lt * 16 + fq * 4 + j]);
                accY[tt] = a;
            }
        }
        __syncthreads();
        {
#pragma unroll
            for (int tt = 0; tt < 2; ++tt) {
                const int pt = ph * 2 + tt;
#pragma unroll
                for (int ks = 0; ks < 2; ++ks) {
                    const bf16x8 am = *(const LAS bf16x8*)(sM + (lt * 16 + fr) * 72 + ks * 32 + fq * 8);
                    const bf16x8 bx = tr_frag(sXH, 72, ks * 32, pt * 16, fr, fq);
                    accY[tt] = MFMA16(am, bx, accY[tt]);
                }
#pragma unroll
                for (int j = 0; j < 4; ++j) sY[(lt * 16 + fq * 4 + j) * 68 + pt * 16 + fr] = accY[tt][j];
            }
            const float dec = __expf(cAcs[63]);
            const int pt2 = wid >> 1;
            bf16x8 ax[2];
#pragma unroll
            for (int ks = 0; ks < 2; ++ks) ax[ks] = tr_frag(sXD, 72, ks * 32, pt2 * 16, fr, fq);
#pragma unroll
            for (int q = 0; q < 4; ++q) {
                const int nt = ph * 4 + q;
                f32x4 a = accS[q] * dec;
#pragma unroll
                for (int ks = 0; ks < 2; ++ks) { const bf16x8 bb = tr_frag(sB, 136, ks * 32, nt * 16, fr, fq); a = MFMA16(ax[ks], bb, a); }
                accS[q] = a;
#pragma unroll
                for (int j = 0; j < 4; ++j) sS[(pt2 * 16 + fq * 4 + j) * 136 + nt * 16 + fr] = f2bf(a[j]);
            }
        }
        __syncthreads();
        {
            const u32x4 xw = *(const LAS u32x4*)(sXH + dl * 72 + dp8);
            const f32x4 y0 = *(const LAS f32x4*)(sY + dl * 68 + dp8), y1 = *(const LAS f32x4*)(sY + dl * 68 + dp8 + 4);
            float y[8];
            y[0] = (y0[0] + d_h * bflo(xw.x)) * siluf_(bflo(zw.x)); y[1] = (y0[1] + d_h * bfhi(xw.x)) * siluf_(bfhi(zw.x));
            y[2] = (y0[2] + d_h * bflo(xw.y)) * siluf_(bflo(zw.y)); y[3] = (y0[3] + d_h * bfhi(xw.y)) * siluf_(bfhi(zw.y));
            y[4] = (y1[0] + d_h * bflo(xw.z)) * siluf_(bflo(zw.z)); y[5] = (y1[1] + d_h * bfhi(xw.z)) * siluf_(bfhi(zw.z));
            y[6] = (y1[2] + d_h * bflo(xw.w)) * siluf_(bflo(zw.w)); y[7] = (y1[3] + d_h * bfhi(xw.w)) * siluf_(bfhi(zw.w));
            float q = 0.f;
#pragma unroll
            for (int j = 0; j < 8; ++j) q += y[j] * y[j];
            q += dpp_<0xB1>(q); q += dpp_<0x4E>(q); q += dpp_<0x141>(q);
            if ((tid & 7) == 0) SSQ[(size_t)(t0 + dl) * 16 + h] = q;
            u32x4 o; o.x = cvt_pk_bf16(y[0], y[1]); o.y = cvt_pk_bf16(y[2], y[3]); o.z = cvt_pk_bf16(y[4], y[5]); o.w = cvt_pk_bf16(y[6], y[7]);
            *(u32x4*)(proj + ga) = o;
        }
        if (c + 1 < 64) {
#pragma unroll
            for (int it = 0; it < 5; ++it) {
                *(LAS u32x4*)(sC + loff[it]) = raw[it];
                const int i_ = it * NTHREADS + tid, row_ = i_ / 40, c2_ = i_ % 40;
                if (c2_ < 8 && row_ >= 61) *(LAS u32x4*)(sXHalo + ((c + 1) & 1) * (3 * 72) + (row_ - 61) * 72 + c2_ * 8) = raw[it];
            }
        }
        __syncthreads();
    }
}

__device__ void rglru_tile(const Params& P, int layer, int b, int n, LAS unsigned char* lds) {
    const int tid = otid(), lane = tid & 63, wid = tid >> 6, fr = lane & 15, fq = lane >> 4;
    bf16_t* proj = (bf16_t*)(P.ws + WS_PROJ);
    LAS bf16_t* sXC = (LAS bf16_t*)lds;
    LAS bf16_t* sWa = sXC + 64 * 72;
    LAS bf16_t* sWx = sWa + 64 * 72;
    LAS float* sA = (LAS float*)(sWx + 64 * 72);
    LAS float* sU = sA + 64 * 64;
    LAS float* sPs = sU + 64 * 64;
    LAS float* sHs = sPs + 8 * 64;
    LAS float* sCar = sHs + 8 * 64;
    LAS bf16_t* sR = (LAS bf16_t*)(sCar + 64);
    LAS bf16_t* sRHalo = sR + 64 * 72;
    {
        const int d = tid >> 3, c8 = (tid & 7) * 8;
        const bf16_t* wa = (const bf16_t*)(P.ws + WS_WA) + (size_t)(layer * 8 + n) * 4096;
        const bf16_t* wx = (const bf16_t*)(P.ws + WS_WX) + (size_t)(layer * 8 + n) * 4096;
        *(LAS u32x4*)(sWa + d * 72 + c8) = *(const u32x4*)(wa + d * 64 + c8);
        *(LAS u32x4*)(sWx + d * 72 + c8) = *(const u32x4*)(wx + d * 64 + c8);
    }
    if (tid < 64) sCar[tid] = 0.f;
    for (int i = tid; i < 3 * 72 / 2; i += NTHREADS) ((LAS unsigned*)(sRHalo + 3 * 72))[i] = 0u;
    const int cg = tid & 7, crow = tid >> 3, ch0 = n * 64 + cg * 8;
    float cw[4][8], cb[8];
#pragma unroll
    for (int j = 0; j < 8; ++j) {
        cb[j] = P.rg_conv_b[layer * 512 + ch0 + j];
#pragma unroll
        for (int i = 0; i < 4; ++i) cw[i][j] = P.rg_conv_w[(layer * 4 + i) * 512 + ch0 + j];
    }
    const int tt = wid & 3, dpair = wid >> 2;
    float ba[2], bx[2], sp[2];
#pragma unroll
    for (int dd = 0; dd < 2; ++dd) {
        const int ch = layer * 512 + n * 64 + (dpair * 2 + dd) * 16 + fr;
        ba[dd] = P.rg_ba[ch]; bx[dd] = P.rg_bx[ch]; sp[dd] = softplusf_(-P.rg_lambda[ch]);
    }
    const int sc = tid & 63, seg = wid;
    const bf16_t* pbase = proj + (size_t)b * SEQ * PROJ_LD;
    const int goff = crow * PROJ_LD + C_RGX + ch0;
#define RG_CONV(cc) do { const LAS bf16_t* halo_ = sRHalo + (((cc) + 1) & 1) * (3 * 72); float v_[8]; \
        _Pragma("unroll") for (int j_ = 0; j_ < 8; ++j_) v_[j_] = cb[j_]; \
        _Pragma("unroll") for (int i_ = 0; i_ < 4; ++i_) { const int r_ = crow - 3 + i_; \
            const u32x4 w_ = (r_ >= 0) ? *(const LAS u32x4*)(sR + r_ * 72 + cg * 8) : *(const LAS u32x4*)(halo_ + (r_ + 3) * 72 + cg * 8); \
            v_[0] += cw[i_][0] * bflo(w_.x); v_[1] += cw[i_][1] * bfhi(w_.x); v_[2] += cw[i_][2] * bflo(w_.y); v_[3] += cw[i_][3] * bfhi(w_.y); \
            v_[4] += cw[i_][4] * bflo(w_.z); v_[5] += cw[i_][5] * bfhi(w_.z); v_[6] += cw[i_][6] * bflo(w_.w); v_[7] += cw[i_][7] * bfhi(w_.w); } \
        u32x4 o_; o_.x = cvt_pk_bf16(v_[0], v_[1]); o_.y = cvt_pk_bf16(v_[2], v_[3]); o_.z = cvt_pk_bf16(v_[4], v_[5]); o_.w = cvt_pk_bf16(v_[6], v_[7]); \
        *(LAS u32x4*)(sXC + crow * 72 + cg * 8) = o_; } while (0)
    u32x4 raw = *(const u32x4*)(pbase + goff);
    *(LAS u32x4*)(sR + crow * 72 + cg * 8) = raw;
    if (crow >= 61) *(LAS u32x4*)(sRHalo + (crow - 61) * 72 + cg * 8) = raw;
    __syncthreads();
    RG_CONV(0);
    __syncthreads();
    for (int c = 0; c < 64; ++c) {
        const int t0 = b * SEQ + c * 64;
        if (c + 1 < 64) raw = *(const u32x4*)(pbase + (size_t)(c + 1) * 64 * PROJ_LD + goff);
        const size_t ga = (size_t)(t0 + crow) * PROJ_LD + C_GATE + ch0;
        const u32x4 gw = *(const u32x4*)(proj + ga);
        {
            bf16x8 ax[2];
#pragma unroll
            for (int ks = 0; ks < 2; ++ks) ax[ks] = *(const LAS bf16x8*)(sXC + (tt * 16 + fr) * 72 + ks * 32 + fq * 8);
#pragma unroll
            for (int dd = 0; dd < 2; ++dd) {
                const int dt_ = dpair * 2 + dd;
                f32x4 accA = {0.f, 0.f, 0.f, 0.f}, accX = {0.f, 0.f, 0.f, 0.f};
#pragma unroll
                for (int ks = 0; ks < 2; ++ks) {
                    const bf16x8 wa = *(const LAS bf16x8*)(sWa + (dt_ * 16 + fr) * 72 + ks * 32 + fq * 8);
                    const bf16x8 wx = *(const LAS bf16x8*)(sWx + (dt_ * 16 + fr) * 72 + ks * 32 + fq * 8);
                    accA = MFMA16(ax[ks], wa, accA); accX = MFMA16(ax[ks], wx, accX);
                }
#pragma unroll
                for (int j = 0; j < 4; ++j) {
                    const int t = tt * 16 + fq * 4 + j, d = dt_ * 16 + fr;
                    const float r = sigmoidf_(accA[j] + ba[dd]), ig = sigmoidf_(accX[j] + bx[dd]);
                    const float a = __expf(-8.f * r * sp[dd]);
                    const float mult = sqrtf(fmaxf(1.f - a * a, 0.f));
                    sA[t * 64 + d] = a;
                    sU[t * 64 + d] = mult * ig * bf2f(sXC[t * 72 + d]);
                }
            }
        }
        __syncthreads();
        {
            float Pl = 1.f, Hl = 0.f;
#pragma unroll
            for (int i = 0; i < 8; ++i) { const float a = sA[(seg * 8 + i) * 64 + sc], u = sU[(seg * 8 + i) * 64 + sc]; Hl = a * Hl + u; Pl *= a; }
            sPs[seg * 64 + sc] = Pl; sHs[seg * 64 + sc] = Hl;
        }
        __syncthreads();
        float H = sCar[sc];
        for (int s2 = 0; s2 < seg; ++s2) H = sPs[s2 * 64 + sc] * H + sHs[s2 * 64 + sc];
#pragma unroll
        for (int i = 0; i < 8; ++i) {
            const int t = seg * 8 + i;
            H = sA[t * 64 + sc] * H + sU[t * 64 + sc];
            sU[t * 64 + sc] = H;
        }
        __syncthreads();
        if (seg == 7) sCar[sc] = H;
        {
            const f32x4 h0 = *(const LAS f32x4*)(sU + crow * 64 + cg * 8), h1 = *(const LAS f32x4*)(sU + crow * 64 + cg * 8 + 4);
            u32x4 o;
            o.x = cvt_pk_bf16(gelu_tanhf_(bflo(gw.x)) * h0[0], gelu_tanhf_(bfhi(gw.x)) * h0[1]);
            o.y = cvt_pk_bf16(gelu_tanhf_(bflo(gw.y)) * h0[2], gelu_tanhf_(bfhi(gw.y)) * h0[3]);
            o.z = cvt_pk_bf16(gelu_tanhf_(bflo(gw.z)) * h1[0], gelu_tanhf_(bfhi(gw.z)) * h1[1]);
            o.w = cvt_pk_bf16(gelu_tanhf_(bflo(gw.w)) * h1[2], gelu_tanhf_(bfhi(gw.w)) * h1[3]);
            if (FP8_OUT) {
                float yv[8] = {bflo(o.x), bfhi(o.x), bflo(o.y), bfhi(o.y), bflo(o.z), bfhi(o.z), bflo(o.w), bfhi(o.w)};
                *(u32x2*)(P.ws + WS_MIX8 + (size_t)(t0 + crow) * MIXW + ch0) = cvt8_fp8(yv, 1.f);
            } else *(u32x4*)(proj + ga) = o;
        }
        if (c + 1 < 64) {
            *(LAS u32x4*)(sR + crow * 72 + cg * 8) = raw;
            if (crow >= 61) *(LAS u32x4*)(sRHalo + ((c + 1) & 1) * (3 * 72) + (crow - 61) * 72 + cg * 8) = raw;
        }
        __syncthreads();
        if (c + 1 < 64) RG_CONV(c + 1);
        __syncthreads();
    }
#undef RG_CONV
}

__device__ void attn_tile(const Params& P, int layer, int b, int qb, int kvh, LAS unsigned char* lds) {
    const int tid = otid(), lane = tid & 63, wid = tid >> 6, fr = lane & 15, fq = lane >> 4;
    bf16_t* proj = (bf16_t*)(P.ws + WS_PROJ);
    LAS bf16_t* sK = (LAS bf16_t*)lds;
    LAS bf16_t* sVT = sK + 256 * 72;
    LAS bf16_t* sP = sVT + 64 * 280 + wid * (16 * 168);
    const int tb = b * SEQ + qb * 128;
#pragma unroll
    for (int it = 0; it < 4; ++it) {
        const int idx = it * NTHREADS + tid;
        { const int kk = idx >> 3, dg = idx & 7;
          u32x4 v = {0u, 0u, 0u, 0u};
          if (qb > 0 || kk >= 128) v = *(const u32x4*)(proj + (size_t)(tb - 128 + kk) * PROJ_LD + C_K + kvh * 64 + dg * 8);
          *(LAS u32x4*)(sK + kk * 72 + dg * 8) = v; }
        { const int kk = idx & 255, dg = idx >> 8;
          u32x4 v = {0u, 0u, 0u, 0u};
          if (qb > 0 || kk >= 128) v = *(const u32x4*)(proj + (size_t)(tb - 128 + kk) * PROJ_LD + C_V + kvh * 64 + dg * 8);
          const unsigned wv[4] = {v.x, v.y, v.z, v.w};
#pragma unroll
          for (int j = 0; j < 4; ++j) { sVT[(dg * 8 + 2 * j) * 280 + kk] = (bf16_t)(wv[j] & 0xffffu); sVT[(dg * 8 + 2 * j + 1) * 280 + kk] = (bf16_t)(wv[j] >> 16); } }
    }
    if (tid < 192) { const int d = tid / 3, part = tid % 3; *(LAS u32x4*)(sVT + d * 280 + 256 + part * 8) = (u32x4){0u, 0u, 0u, 0u}; }
    __syncthreads();
    const int q0 = wid * 16;
    for (int r = 0; r < 4; ++r) {
        const int hq = kvh * 4 + r;
        const float sink = P.attn_sinks[layer * 8 + hq];
        bf16x8 qf[2];
#pragma unroll
        for (int ks = 0; ks < 2; ++ks) qf[ks] = *(const bf16x8*)(proj + (size_t)(tb + q0 + fr) * PROJ_LD + C_Q + hq * 64 + ks * 32 + fq * 8);
        f32x4 S[9];
#pragma unroll
        for (int kt = 0; kt < 9; ++kt) {
            f32x4 a = {0.f, 0.f, 0.f, 0.f};
#pragma unroll
            for (int ks = 0; ks < 2; ++ks) { const bf16x8 kf = *(const LAS bf16x8*)(sK + ((wid + kt) * 16 + fr) * 72 + ks * 32 + fq * 8); a = MFMA16(qf[ks], kf, a); }
            S[kt] = a;
        }
        float mx[4], sm[4];
#pragma unroll
        for (int j = 0; j < 4; ++j) mx[j] = -INFINITY;
#pragma unroll
        for (int kt = 0; kt < 9; ++kt)
#pragma unroll
            for (int j = 0; j < 4; ++j) {
                const int qi = q0 + fq * 4 + j, kk = (wid + kt) * 16 + fr, kj = kk - 128;
                const bool valid = (kj <= qi) && (kj > qi - 128) && (qb > 0 || kk >= 128);
                const float s = valid ? S[kt][j] * 0.125f : -INFINITY;
                S[kt][j] = s; mx[j] = fmaxf(mx[j], s);
            }
#pragma unroll
        for (int j = 0; j < 4; ++j) {
            float m = mx[j];
            m = fmaxf(m, __shfl_xor(m, 1)); m = fmaxf(m, __shfl_xor(m, 2)); m = fmaxf(m, __shfl_xor(m, 4)); m = fmaxf(m, __shfl_xor(m, 8));
            mx[j] = fmaxf(m, sink); sm[j] = 0.f;
        }
#pragma unroll
        for (int kt = 0; kt < 9; ++kt)
#pragma unroll
            for (int j = 0; j < 4; ++j) { const float p = __expf(S[kt][j] - mx[j]); S[kt][j] = p; sm[j] += p; }
#pragma unroll
        for (int j = 0; j < 4; ++j) {
            float s = sm[j];
            s += __shfl_xor(s, 1); s += __shfl_xor(s, 2); s += __shfl_xor(s, 4); s += __shfl_xor(s, 8);
            sm[j] = 1.f / (s + __expf(sink - mx[j]));
        }
#pragma unroll
        for (int kt = 0; kt < 9; ++kt)
#pragma unroll
            for (int j = 0; j < 4; ++j) sP[(fq * 4 + j) * 168 + kt * 16 + fr] = f2bf(S[kt][j] * sm[j]);
#pragma unroll
        for (int j = 0; j < 4; ++j) sP[(fq * 4 + j) * 168 + 144 + fr] = 0;
        f32x4 O[4];
#pragma unroll
        for (int dt_ = 0; dt_ < 4; ++dt_) O[dt_] = (f32x4){0.f, 0.f, 0.f, 0.f};
#pragma unroll
        for (int ks = 0; ks < 5; ++ks) {
            const bf16x8 pa = *(const LAS bf16x8*)(sP + fr * 168 + ks * 32 + fq * 8);
#pragma unroll
            for (int dt_ = 0; dt_ < 4; ++dt_) { const bf16x8 vb = *(const LAS bf16x8*)(sVT + (dt_ * 16 + fr) * 280 + wid * 16 + ks * 32 + fq * 8); O[dt_] = MFMA16(pa, vb, O[dt_]); }
        }
        if (FP8_OUT) {
            LAS unsigned char* sO = (LAS unsigned char*)sP;
#pragma unroll
            for (int dt_ = 0; dt_ < 4; ++dt_)
#pragma unroll
                for (int j = 0; j < 4; ++j) { const int d8 = __builtin_amdgcn_cvt_pk_fp8_f32(O[dt_][j], 0.f, 0, false); sO[(fq * 4 + j) * 80 + dt_ * 16 + fr] = (unsigned char)(d8 & 0xff); }
            const int orow = lane >> 2, och = lane & 3;
            const u32x4 ov = *(const LAS u32x4*)(sO + orow * 80 + och * 16);
            *(u32x4*)(P.ws + WS_MIX8 + (size_t)(tb + q0 + orow) * MIXW + 1536 + hq * 64 + och * 16) = ov;
        } else {
#pragma unroll
            for (int dt_ = 0; dt_ < 4; ++dt_)
#pragma unroll
                for (int j = 0; j < 4; ++j) proj[(size_t)(tb + q0 + fq * 4 + j) * PROJ_LD + C_Q + hq * 64 + dt_ * 16 + fr] = f2bf(O[dt_][j]);
        }
    }
    __syncthreads();
}

__device__ void phase_mixers(const Params& P, int layer, LAS unsigned char* lds) {
    unsigned* ctr = (unsigned*)(P.ws + WS_CTL) + 64 * (1 + layer);
    LAS int* sTile = (LAS int*)(lds + LDS_BYTES - 16);
    for (;;) {
        if (otid() == 0) *sTile = (int)atomicAdd(ctr, 1u);
        __syncthreads();
        const int tile = *sTile;
        __syncthreads();
        if (tile >= 256 + 128 + 1024) break;
#ifdef TS_SUB
        const unsigned long long tq0 = __builtin_amdgcn_s_memrealtime();
#endif
        if (tile < 256) { if (MIX_MASK & 1) ssd_tile(P, layer, tile >> 4, tile & 15, lds); }
        else if (tile < 384) { const int j = tile - 256; if (MIX_MASK & 2) rglru_tile(P, layer, j >> 3, j & 7, lds); }
        else { const int j = tile - 384; if (MIX_MASK & 4) attn_tile(P, layer, j >> 6, (j >> 1) & 31, j & 1, lds); }
#ifdef TS_SUB
        if (obid() == 0 && otid() == 0) { unsigned long long* pr = (unsigned long long*)(P.ws + WS_CTL + 40960); const int cat = tile < 256 ? 9 : (tile < 384 ? 10 : 11); pr[cat] += __builtin_amdgcn_s_memrealtime() - tq0; }
#endif
    }
}

__device__ void phase_ssdnorm(const Params& P) {
    const int lane = otid() & 63, wid = otid() >> 6;
    const bf16_t* proj = (const bf16_t*)(P.ws + WS_PROJ);
    const float* SSQ = (const float*)(P.ws + WS_SSQ);
    const int g = lane >> 5;
    constexpr int NR = 8;
    for (int t0 = (obid() * 8 + wid) * NR; t0 < T_TOK; t0 += gridDim.x * 8 * NR) {
        u32x4 in[NR][2]; f32x4 s0[NR], s1[NR];
#pragma unroll
        for (int k = 0; k < NR; ++k) {
            const bf16_t* src = proj + (size_t)(t0 + k) * PROJ_LD + C_Z + lane * 16;
            in[k][0] = *(const u32x4*)src; in[k][1] = *(const u32x4*)(src + 8);
            s0[k] = *(const f32x4*)(SSQ + (size_t)(t0 + k) * 16 + g * 8); s1[k] = *(const f32x4*)(SSQ + (size_t)(t0 + k) * 16 + g * 8 + 4);
        }
#pragma unroll
        for (int k = 0; k < NR; ++k) {
            const float sc = rsqrtf(((s0[k][0] + s0[k][1]) + (s0[k][2] + s0[k][3]) + (s1[k][0] + s1[k][1]) + (s1[k][2] + s1[k][3])) * (1.f / 512.f) + LN_EPS);
            u32x4 o;
#pragma unroll
            for (int i = 0; i < 2; ++i) {
                float v[8];
#pragma unroll
                for (int c = 0; c < 4; ++c) { v[2 * c] = bflo(in[k][i][c]); v[2 * c + 1] = bfhi(in[k][i][c]); }
                const u32x2 w = cvt8_fp8(v, sc);
                if (i) { o.z = w.x; o.w = w.y; } else { o.x = w.x; o.y = w.y; }
            }
            *(u32x4*)(P.ws + WS_MIX8 + (size_t)(t0 + k) * MIXW + 512 + lane * 16) = o;
        }
    }
}

__device__ void phase_ssdnorm_bf16(const Params& P) {
    bf16_t* proj = (bf16_t*)(P.ws + WS_PROJ);
    const float* SSQ = (const float*)(P.ws + WS_SSQ);
    for (size_t i = (size_t)obid() * NTHREADS + otid(); i < (size_t)T_TOK * 128; i += (size_t)gridDim.x * NTHREADS) {
        const size_t t = i >> 7; const int c8 = (int)(i & 127) * 8, g = c8 >> 9;
        const f32x4 s0 = *(const f32x4*)(SSQ + t * 16 + g * 8), s1 = *(const f32x4*)(SSQ + t * 16 + g * 8 + 4);
        const float ss = s0[0] + s0[1] + s0[2] + s0[3] + s1[0] + s1[1] + s1[2] + s1[3];
        const float sc = rsqrtf(ss * (1.f / 512.f) + LN_EPS);
        u32x4* p = (u32x4*)(proj + t * PROJ_LD + C_Z + c8);
        const u32x4 w = *p;
        u32x4 o; o.x = cvt_pk_bf16(bflo(w.x) * sc, bfhi(w.x) * sc); o.y = cvt_pk_bf16(bflo(w.y) * sc, bfhi(w.y) * sc);
        o.z = cvt_pk_bf16(bflo(w.z) * sc, bfhi(w.z) * sc); o.w = cvt_pk_bf16(bflo(w.w) * sc, bfhi(w.w) * sc);
        *p = o;
    }
}

__device__ __forceinline__ unsigned mono_(float f) { const unsigned u = __float_as_uint(f); return (u & 0x80000000u) ? ~u : (u | 0x80000000u); }
__device__ __forceinline__ float unmono_(unsigned u) { return __uint_as_float((u & 0x80000000u) ? (u ^ 0x80000000u) : ~u); }

__device__ void phase_peer_topk(const Params& P, int layer, LAS unsigned char* lds) {
    const int tid = otid(), lane = tid & 63, wid = tid >> 6, fr = lane & 15, fq = lane >> 4;
    const bf16_t* QP = (const bf16_t*)(P.ws + WS_QP);
    const bf16_t* keys = (const bf16_t*)(P.ws + WS_KEYS) + (size_t)layer * 2 * 128 * 64;
    unsigned short* IDX = (unsigned short*)(P.ws + WS_IDX);
    float* GATE = (float*)(P.ws + WS_GATE);
    LAS float* sSc = (LAS float*)lds;
    LAS unsigned* sTop = (LAS unsigned*)lds;
#define CE_D(a, b) do { const unsigned hi_ = umax_(a, b), lo_ = umin_(a, b); a = hi_; b = lo_; } while (0)
#define CE_A(a, b) do { const unsigned hi_ = umax_(a, b), lo_ = umin_(a, b); a = lo_; b = hi_; } while (0)
    for (int tile = obid(); tile < T_TOK / 32; tile += gridDim.x) {
        const int tok0 = tile * 32;
        unsigned top[16];
#pragma unroll
        for (int k = 0; k < 16; ++k) top[k] = 0u;
        bf16x8 qa[2][2][2];
#pragma unroll
        for (int i = 0; i < 2; ++i)
#pragma unroll
            for (int mt = 0; mt < 2; ++mt)
#pragma unroll
                for (int ks = 0; ks < 2; ++ks) qa[i][mt][ks] = *(const bf16x8*)(QP + (size_t)(tok0 + mt * 16 + fr) * DM + wid * 128 + i * 64 + ks * 32 + fq * 8);
        for (int ps = 0; ps < 2; ++ps) {
            bf16x8 kb[2][4][2];
#pragma unroll
            for (int i = 0; i < 2; ++i)
#pragma unroll
                for (int nt = 0; nt < 4; ++nt)
#pragma unroll
                    for (int ks = 0; ks < 2; ++ks) kb[i][nt][ks] = *(const bf16x8*)(keys + (size_t)(i * 128 + ps * 64 + nt * 16 + fr) * 64 + ks * 32 + fq * 8);
#pragma unroll
            for (int i = 0; i < 2; ++i)
#pragma unroll
                for (int mt = 0; mt < 2; ++mt)
#pragma unroll
                    for (int nt = 0; nt < 4; ++nt) {
                        f32x4 acc = {0.f, 0.f, 0.f, 0.f};
#pragma unroll
                        for (int ks = 0; ks < 2; ++ks) acc = MFMA16(qa[i][mt][ks], kb[i][nt][ks], acc);
#pragma unroll
                        for (int j = 0; j < 4; ++j) sSc[((wid * 2 + i) * 32 + mt * 16 + fq * 4 + j) * 65 + nt * 16 + fr] = acc[j];
                    }
            __syncthreads();
#pragma unroll 1
            for (int gq = 0; gq < 4; ++gq) {
                unsigned g_[16];
#pragma unroll
                for (int e = 0; e < 16; ++e) { const float sv_ = sSc[tid * 65 + gq * 16 + e]; g_[e] = (mono_(sv_) & ~0x7Fu) | (unsigned)(127 - (ps * 64 + gq * 16 + e)); }
                CE_D(g_[0], g_[1]); CE_A(g_[2], g_[3]); CE_D(g_[4], g_[5]); CE_A(g_[6], g_[7]); CE_D(g_[8], g_[9]); CE_A(g_[10], g_[11]); CE_D(g_[12], g_[13]); CE_A(g_[14], g_[15]); CE_D(g_[0], g_[2]); CE_D(g_[1], g_[3]); CE_A(g_[4], g_[6]); CE_A(g_[5], g_[7]); CE_D(g_[8], g_[10]); CE_D(g_[9], g_[11]); CE_A(g_[12], g_[14]); CE_A(g_[13], g_[15]); CE_D(g_[0], g_[1]); CE_D(g_[2], g_[3]); CE_A(g_[4], g_[5]); CE_A(g_[6], g_[7]); CE_D(g_[8], g_[9]); CE_D(g_[10], g_[11]); CE_A(g_[12], g_[13]); CE_A(g_[14], g_[15]); CE_D(g_[0], g_[4]); CE_D(g_[1], g_[5]); CE_D(g_[2], g_[6]); CE_D(g_[3], g_[7]); CE_A(g_[8], g_[12]); CE_A(g_[9], g_[13]); CE_A(g_[10], g_[14]); CE_A(g_[11], g_[15]); CE_D(g_[0], g_[2]); CE_D(g_[1], g_[3]); CE_D(g_[4], g_[6]); CE_D(g_[5], g_[7]); CE_A(g_[8], g_[10]); CE_A(g_[9], g_[11]); CE_A(g_[12], g_[14]); CE_A(g_[13], g_[15]); CE_D(g_[0], g_[1]); CE_D(g_[2], g_[3]); CE_D(g_[4], g_[5]); CE_D(g_[6], g_[7]); CE_A(g_[8], g_[9]); CE_A(g_[10], g_[11]); CE_A(g_[12], g_[13]); CE_A(g_[14], g_[15]); CE_D(g_[0], g_[8]); CE_D(g_[1], g_[9]); CE_D(g_[2], g_[10]); CE_D(g_[3], g_[11]); CE_D(g_[4], g_[12]); CE_D(g_[5], g_[13]); CE_D(g_[6], g_[14]); CE_D(g_[7], g_[15]); CE_D(g_[0], g_[4]); CE_D(g_[1], g_[5]); CE_D(g_[2], g_[6]); CE_D(g_[3], g_[7]); CE_D(g_[8], g_[12]); CE_D(g_[9], g_[13]); CE_D(g_[10], g_[14]); CE_D(g_[11], g_[15]); CE_D(g_[0], g_[2]); CE_D(g_[1], g_[3]); CE_D(g_[4], g_[6]); CE_D(g_[5], g_[7]); CE_D(g_[8], g_[10]); CE_D(g_[9], g_[11]); CE_D(g_[12], g_[14]); CE_D(g_[13], g_[15]); CE_D(g_[0], g_[1]); CE_D(g_[2], g_[3]); CE_D(g_[4], g_[5]); CE_D(g_[6], g_[7]); CE_D(g_[8], g_[9]); CE_D(g_[10], g_[11]); CE_D(g_[12], g_[13]); CE_D(g_[14], g_[15]);
#pragma unroll
                for (int e = 0; e < 16; ++e) top[e] = umax_(top[e], g_[15 - e]);
                CE_D(top[0], top[8]); CE_D(top[1], top[9]); CE_D(top[2], top[10]); CE_D(top[3], top[11]); CE_D(top[4], top[12]); CE_D(top[5], top[13]); CE_D(top[6], top[14]); CE_D(top[7], top[15]); CE_D(top[0], top[4]); CE_D(top[1], top[5]); CE_D(top[2], top[6]); CE_D(top[3], top[7]); CE_D(top[8], top[12]); CE_D(top[9], top[13]); CE_D(top[10], top[14]); CE_D(top[11], top[15]); CE_D(top[0], top[2]); CE_D(top[1], top[3]); CE_D(top[4], top[6]); CE_D(top[5], top[7]); CE_D(top[8], top[10]); CE_D(top[9], top[11]); CE_D(top[12], top[14]); CE_D(top[13], top[15]); CE_D(top[0], top[1]); CE_D(top[2], top[3]); CE_D(top[4], top[5]); CE_D(top[6], top[7]); CE_D(top[8], top[9]); CE_D(top[10], top[11]); CE_D(top[12], top[13]); CE_D(top[14], top[15]);
            }
            __syncthreads();
        }
#pragma unroll
        for (int q = 0; q < 4; ++q) *(LAS u32x4*)(sTop + tid * 16 + q * 4) = (u32x4){top[q * 4], top[q * 4 + 1], top[q * 4 + 2], top[q * 4 + 3]};
        __syncthreads();
        if (tid < 256) {
            const int token = tid & 31, h = tid >> 5;
            const int row1 = (h * 2) * 32 + token, row2 = (h * 2 + 1) * 32 + token;
            float s1[16], s2[16];
#pragma unroll
            for (int q = 0; q < 4; ++q) {
                const u32x4 a = *(const LAS u32x4*)(sTop + row1 * 16 + q * 4), bq = *(const LAS u32x4*)(sTop + row2 * 16 + q * 4);
#pragma unroll
                for (int e = 0; e < 4; ++e) { s1[q * 4 + e] = unmono_(a[e] & ~0x7Fu); s2[q * 4 + e] = unmono_(bq[e] & ~0x7Fu); }
            }
            unsigned best[16];
#pragma unroll
            for (int k = 0; k < 16; ++k) best[k] = 0u;
#pragma unroll
            for (int a = 0; a < 16; ++a)
#pragma unroll
                for (int bb = 0; bb < 16; ++bb) {
                    if ((a + 1) * (bb + 1) <= 16) {
                        unsigned x = (mono_(s1[a] + s2[bb]) & ~0xFFu) | (unsigned)(255 - (a * 16 + bb));
#pragma unroll
                        for (int q = 0; q < 16; ++q) { const unsigned hi = umax_(best[q], x); x = umin_(best[q], x); best[q] = hi; }
                    }
                }
            float val[16], gsum = 0.f;
            const float vmax = unmono_(best[0] & ~0xFFu);
#pragma unroll
            for (int k = 0; k < 16; ++k) { val[k] = __expf(unmono_(best[k] & ~0xFFu) - vmax); gsum += val[k]; }
            const float ginv = 1.f / gsum;
            const size_t ob = (size_t)(tok0 + token) * 128 + h * 16;
#pragma unroll
            for (int k = 0; k < 16; ++k) {
                const int code = 255 - (int)(best[k] & 0xFFu), a = code >> 4, bb = code & 15;
                const int i1 = 127 - (int)(sTop[row1 * 16 + a] & 0x7Fu), i2 = 127 - (int)(sTop[row2 * 16 + bb] & 0x7Fu);
                IDX[ob + k] = (unsigned short)(i1 * 128 + i2);
                GATE[ob + k] = val[k] * ginv;
            }
        }
        __syncthreads();
    }
}

#define FP4_PAIR(word, b) __builtin_amdgcn_cvt_scalef32_pk_f32_fp4((word), 1.0f, (b))
typedef _Float16 h16x2 __attribute__((ext_vector_type(2)));
#define FP4_H2(word, b) __builtin_amdgcn_cvt_scalef32_pk_f16_fp4((word), 1.0f, (b))
template <int CTLW>
__device__ __forceinline__ int peer_pull(const Params& P, int layer, int slice, int lane) {
    int tq = 0;
    if (lane == 0) tq = (int)atomicAdd((unsigned*)(P.ws + WS_CTL) + CTLW + 64 * (layer * 8 + slice), 16u);
    return __builtin_amdgcn_readfirstlane(tq);
}
template <int QW> __device__ void phase_peer_e1(const Params& P, int layer) {
    const int lane = otid() & 63, es = lane >> 3, ck = lane & 7;
    const bf16_t* hb = (const bf16_t*)(P.ws + WS_HB);
    const unsigned char* U4 = P.ws + WS_U8 + (size_t)layer * 16384 * 512;
    const unsigned short* IDX = (const unsigned short*)(P.ws + WS_IDX);
    unsigned* PD = (unsigned*)(P.ws + WS_PD);
    const int myx = (int)(xb_xcc_id() & 3u);
    const int src = (lane & 7) * 8 + (lane >> 3);
#define E1_IDX(dst, u) do { const unsigned short* ip_ = IDX + (size_t)(tq + (u)) * 128 + es; _Pragma("unroll") for (int i_ = 0; i_ < 16; ++i_) dst[i_] = (int)ip_[i_ * 8]; } while (0)
#define E1_ROWS(dst, ix) do { _Pragma("unroll") for (int i_ = 0; i_ < 16; ++i_) dst[i_] = *(const u32x4*)(Us + (size_t)ix[i_] * 128); } while (0)
#define E1_X(dst, u) do { const bf16_t* xp_ = hb + (size_t)(tq + (u)) * DM + j * 256 + ck * 32; _Pragma("unroll") for (int i_ = 0; i_ < 4; ++i_) dst[i_] = *(const u32x4*)(xp_ + 8 * i_); } while (0)
#define E1_COMPUTE(wv, xr, u) do { h16x2 X_[16]; _Pragma("unroll") for (int a_ = 0; a_ < 4; ++a_) _Pragma("unroll") for (int i_ = 0; i_ < 4; ++i_) X_[4 * a_ + i_] = (h16x2){(_Float16)bflo(xr[a_][i_]), (_Float16)bfhi(xr[a_][i_])}; \
        float k0_ = 0.f, k1_ = 0.f; \
        _Pragma("unroll") for (int i_ = 0; i_ < 16; ++i_) { \
            float d0_ = 0.f, d1_ = 0.f; \
            _Pragma("unroll") for (int q_ = 0; q_ < 4; ++q_) { d0_ = __builtin_amdgcn_fdot2(FP4_H2(wv[i_][q_], 0), X_[4 * q_], d0_, false); d1_ = __builtin_amdgcn_fdot2(FP4_H2(wv[i_][q_], 1), X_[4 * q_ + 1], d1_, false); \
                d0_ = __builtin_amdgcn_fdot2(FP4_H2(wv[i_][q_], 2), X_[4 * q_ + 2], d0_, false); d1_ = __builtin_amdgcn_fdot2(FP4_H2(wv[i_][q_], 3), X_[4 * q_ + 3], d1_, false); } \
            float d_ = d0_ + d1_; \
            d_ += dpp_<0xB1>(d_); d_ += dpp_<0x4E>(d_); d_ += dpp_<0x141>(d_); \
            if (i_ < 8) k0_ = (ck == i_) ? d_ : k0_; else k1_ = (ck == i_ - 8) ? d_ : k1_; } \
        PD[((size_t)(tq + (u)) * 4 + j) * 64 + lane] = cvt_pk_bf16(__shfl(k0_, src), __shfl(k1_, src)); } while (0)
    for (int k = 0; k < 4; ++k) {
        const int j = (myx + k) & 3;
        const unsigned char* Us = U4 + (size_t)j * (16384 * 128) + ck * 16;
        for (;;) {
            int tq = 0;
            if (lane == 0) tq = (int)atomicAdd((unsigned*)(P.ws + WS_CTL) + QW + 64 * (layer * 8 + j), 16u);
            tq = __builtin_amdgcn_readfirstlane(tq);
            if (tq >= T_TOK) break;
            int ix[16];
            E1_IDX(ix, 0);
            for (int u = 0; u < 16; ++u) {
                u32x4 wA[16], xA[4];
                E1_X(xA, u);
                E1_ROWS(wA, ix);
                if (u + 1 < 16) E1_IDX(ix, u + 1);
                E1_COMPUTE(wA, xA, u);
            }
        }
    }
#undef E1_IDX
#undef E1_ROWS
#undef E1_X
#undef E1_COMPUTE
}
template <bool DUMMY2> __device__ void phase_peer_e2(const Params& P, int layer) {
    const unsigned* PD = (const unsigned*)(P.ws + WS_PD);
    const unsigned short* IDX = (const unsigned short*)(P.ws + WS_IDX);
    float* GATE = (float*)(P.ws + WS_GATE);
    unsigned* IW = DUMMY2 ? (unsigned*)(P.ws + WS_STAT + (size_t)T_TOK * 64) : (unsigned*)GATE;
    const float* SU = (const float*)(P.ws + WS_SU) + layer * 16384;
    const float* SV = (const float*)(P.ws + WS_SV) + layer * 16384;
    for (size_t i4 = (size_t)obid() * NTHREADS + otid(); i4 < (size_t)T_TOK * 16; i4 += (size_t)gridDim.x * NTHREADS) {
        const size_t t = i4 >> 4; const int e = (int)(i4 & 15) * 4;
        f32x4 dlo = {0.f, 0.f, 0.f, 0.f}, dhi = {0.f, 0.f, 0.f, 0.f};
#pragma unroll
        for (int j = 0; j < 4; ++j) { const u32x4 w = *(const u32x4*)(PD + (t * 4 + j) * 64 + e);
#pragma unroll
            for (int c = 0; c < 4; ++c) { dlo[c] += bflo(w[c]); dhi[c] += bfhi(w[c]); } }
        const u32x2 ia = *(const u32x2*)(IDX + t * 128 + e), ib = *(const u32x2*)(IDX + t * 128 + 64 + e);
        const int il[4] = {(int)(ia.x & 0xffffu), (int)(ia.x >> 16), (int)(ia.y & 0xffffu), (int)(ia.y >> 16)};
        const int ih[4] = {(int)(ib.x & 0xffffu), (int)(ib.x >> 16), (int)(ib.y & 0xffffu), (int)(ib.y >> 16)};
        const f32x4 gl = *(const f32x4*)(GATE + t * 128 + e), gh = *(const f32x4*)(GATE + t * 128 + 64 + e);
        u32x4 ol, oh;
#pragma unroll
        for (int c = 0; c < 4; ++c) {
            const float wl = gl[c] * SV[il[c]] * gelu_cdf_(SU[il[c]] * dlo[c]), wh = gh[c] * SV[ih[c]] * gelu_cdf_(SU[ih[c]] * dhi[c]);
            ol[c] = (cvt_pk_bf16(0.f, wl) & 0xffff0000u) | (unsigned)il[c];
            oh[c] = (cvt_pk_bf16(0.f, wh) & 0xffff0000u) | (unsigned)ih[c];
        }
        *(u32x4*)(IW + t * 128 + e) = ol; *(u32x4*)(IW + t * 128 + 64 + e) = oh;
    }
}
template <int QW, bool DUMMY> __device__ void phase_peer_e3(const Params& P, int layer) {
    const int lane = otid() & 63, es = lane >> 3, ck = lane & 7;
    const unsigned char* V4 = P.ws + WS_V8 + (size_t)layer * 16384 * 512;
    const unsigned* IW = (const unsigned*)(P.ws + WS_GATE);
    float* STAT = (float*)(P.ws + WS_STAT);
    const int myx = (int)(xb_xcc_id() & 3u);
    const bool b5 = (lane & 32) != 0, b4 = (lane & 16) != 0, b3 = (lane & 8) != 0;
    for (int k = 0; k < 4; ++k) {
        const int j = (myx + k) & 3;
        const unsigned char* Vs = V4 + (size_t)j * (16384 * 128) + ck * 16;
        for (;;) {
            const int tq = peer_pull<QW>(P, layer, j, lane);
            if (tq >= T_TOK) break;
            unsigned iwn[16];
#pragma unroll
            for (int i = 0; i < 16; ++i) iwn[i] = IW[(size_t)tq * 128 + i * 8 + es];
            for (int t = tq; t < tq + 16; ++t) {
                int idx[16]; float wg[16];
#pragma unroll
                for (int i = 0; i < 16; ++i) { idx[i] = (int)(iwn[i] & 0xffffu); wg[i] = __uint_as_float(iwn[i] & 0xffff0000u); }
                u32x4 w[16];
#pragma unroll
                for (int i = 0; i < 16; ++i) w[i] = *(const u32x4*)(Vs + (size_t)idx[i] * 128);
                if (t + 1 < tq + 16) {
#pragma unroll
                    for (int i = 0; i < 16; ++i) iwn[i] = IW[(size_t)(t + 1) * 128 + i * 8 + es];
                }
                bf16_t* hrow = (bf16_t*)(P.ws + WS_HB) + (size_t)t * DM + j * 256 + ck * 32 + es * 4;
                bf16_t* yrow = DUMMY ? (bf16_t*)(P.ws + WS_PD) + (size_t)t * DM + j * 256 + ck * 32 + es * 4 : hrow;
                float* strow = DUMMY ? (float*)(P.ws + WS_PD) + (size_t)T_TOK * DM : STAT;
                const u32x2 hv = *(const u32x2*)hrow;
                h16x2 acc[16];
#pragma unroll
                for (int c = 0; c < 16; ++c) acc[c] = (h16x2){(_Float16)0.f, (_Float16)0.f};
#pragma unroll
                for (int i = 0; i < 16; ++i) {
                    const _Float16 wh = (_Float16)wg[i]; const h16x2 w2 = {wh, wh};
#pragma unroll
                    for (int q = 0; q < 4; ++q) { acc[4 * q] += FP4_H2(w[i][q], 0) * w2; acc[4 * q + 1] += FP4_H2(w[i][q], 1) * w2; acc[4 * q + 2] += FP4_H2(w[i][q], 2) * w2; acc[4 * q + 3] += FP4_H2(w[i][q], 3) * w2; }
                }
                h16x2 r16[8];
#pragma unroll
                for (int c = 0; c < 8; ++c) {
                    const h16x2 keep = b5 ? acc[8 + c] : acc[c], send = b5 ? acc[c] : acc[8 + c];
                    r16[c] = keep + __builtin_bit_cast(h16x2, __shfl_xor(__builtin_bit_cast(int, send), 32));
                }
                h16x2 r8[4];
#pragma unroll
                for (int c = 0; c < 4; ++c) {
                    const h16x2 keep = b4 ? r16[4 + c] : r16[c], send = b4 ? r16[c] : r16[4 + c];
                    r8[c] = keep + __builtin_bit_cast(h16x2, __shfl_xor(__builtin_bit_cast(int, send), 16));
                }
                f32x2 r4[2];
#pragma unroll
                for (int c = 0; c < 2; ++c) {
                    const h16x2 keep = b3 ? r8[2 + c] : r8[c], send = b3 ? r8[c] : r8[2 + c];
                    const h16x2 got = __builtin_bit_cast(h16x2, __builtin_amdgcn_mov_dpp(__builtin_bit_cast(int, send), 0x128, 0xf, 0xf, true));
                    r4[c] = (f32x2){(float)keep[0] + (float)got[0], (float)keep[1] + (float)got[1]};
                }
                float y[4];
                y[0] = DN_ALPHA * bflo(hv.x) + r4[0][0]; y[1] = DN_ALPHA * bfhi(hv.x) + r4[0][1]; y[2] = DN_ALPHA * bflo(hv.y) + r4[1][0]; y[3] = DN_ALPHA * bfhi(hv.y) + r4[1][1];
                u32x2 ov; ov.x = cvt_pk_bf16(y[0], y[1]); ov.y = cvt_pk_bf16(y[2], y[3]);
                *(u32x2*)yrow = ov;
                float s1 = (y[0] + y[1]) + (y[2] + y[3]), s2 = (y[0] * y[0] + y[1] * y[1]) + (y[2] * y[2] + y[3] * y[3]);
                s1 = wave_sum_dpp(s1); s2 = wave_sum_dpp(s2);
                if (lane == 0) { strow[((size_t)t * 4 + j) * 2] = s1; strow[((size_t)t * 4 + j) * 2 + 1] = s2; }
            }
        }
    }
}
__device__ void phase_peer_e4(const Params& P, int layer) {
    ln_rows_bf16<true>((bf16_t*)(P.ws + WS_HB), P.ws + WS_MIX8, (layer == DEPTH - 1) ? P.out : nullptr, (const float*)(P.ws + WS_STAT), P.ln2_g + layer * DM, P.ln2_b + layer * DM);
}

constexpr int N_SUB = 12;
constexpr int N_PHASES = 1 + N_SUB * DEPTH;
__global__ void __launch_bounds__(NTHREADS, 2) fwd_megakernel(Params P) {
    extern __shared__ __attribute__((aligned(16))) unsigned char lds_raw[];
    LAS unsigned char* lds = (LAS unsigned char*)lds_raw;
    cg::grid_group grid = cg::this_grid();
    unsigned char* ws = P.ws;
    volatile LAS unsigned* xb_st = (volatile LAS unsigned*)(lds + LDS_BYTES - 32);
    if (otid() < 2) xb_st[otid()] = 0u;
    __syncthreads();
    const XcdBarrier xbar = xcd_barrier_post((unsigned*)(ws + WS_CTL + 4096), xb_st);
#ifdef DEBUG_COPY
    const int ph_end = P.ph_hi + 1;
#else
    const int ph_end = P.ph_hi;
#endif
    for (int ph = P.ph_lo; ph < ph_end; ++ph) {
        if (ph > P.ph_lo) {
            if (ph == 1) {
                asm volatile("s_waitcnt vmcnt(0)" ::: "memory");
                __syncthreads();
                grid.sync();
                if (otid() < 64) { __builtin_amdgcn_fence(__ATOMIC_ACQUIRE, "agent"); asm volatile("s_waitcnt vmcnt(0)" ::: "memory"); }
                __syncthreads();
            } else {
                xcd_barrier(xbar);
            }
        }
#ifdef TS_SUB
        if (obid() == 0 && otid() == 0) ((unsigned long long*)(ws + WS_CTL + 32768))[ph] = __builtin_amdgcn_s_memrealtime();
#endif
        if (ph == 0) { phase_prep(P, lds); continue; }
#ifdef DEBUG_COPY
        if (ph == P.ph_hi) {
            const bf16_t* proj = (const bf16_t*)(ws + WS_PROJ);
            const float* DTp = (const float*)(ws + WS_DT);
            for (size_t i = (size_t)obid() * NTHREADS + otid(); i < (size_t)T_TOK * 1024; i += (size_t)gridDim.x * NTHREADS) {
                const size_t t = i >> 10; const int c = (int)(i & 1023);
                float v;
                if (c < 256) v = bf2f(proj[t * PROJ_LD + C_K + c]);
                else if (c < 1008) v = bf2f(proj[t * PROJ_LD + C_XBC + (c - 256) * 2]);
                else v = DTp[t * 16 + (c - 1008)];
                P.out[i] = v;
            }
            continue;
        }
#endif
        const int layer = (ph - 1) / N_SUB, sub = (ph - 1) % N_SUB;
        if (sub == 0 || sub == 4 || sub == 6) {
            pg8::Gemm g; pg8::Epi E; int N; bool f8;
            if (sub == 0) {
                f8 = FP8_IN;
                if (FP8_IN) g = pg8::Gemm{(const bf16_t*)(ws + WS_MIX8), (const bf16_t*)(ws + WS_WIN8 + (size_t)layer * N_IN * 1024), T_TOK, N_IN, 512, 512, 1 << 30, 0};
                else g = pg8::Gemm{(const bf16_t*)(ws + WS_HB), (const bf16_t*)(ws + WS_WIN) + (size_t)layer * N_IN * 1024, T_TOK, N_IN, 1024, 1024, 1 << 30, 0};
                E.mode = 0; E.eb = pg8::EpiBf16{(bf16_t*)(ws + WS_PROJ), PROJ_LD, 3584, (size_t)3600, FP8_IN ? 1.f / 32.f : 1.f}; E.er = pg8::EpiResBf16{nullptr, 0, 0.f, 1.f}; N = N_IN;
            } else if (sub == 4) {
                f8 = FP8_OUT;
                if (FP8_OUT) g = pg8::Gemm{(const bf16_t*)(ws + WS_MIX8), (const bf16_t*)(ws + WS_WOUT8 + (size_t)layer * 1024 * MIXW), T_TOK, 1024, 1024, 1024, 1 << 30, 0};
                else g = pg8::Gemm{(const bf16_t*)(ws + WS_PROJ) + C_GATE, (const bf16_t*)(ws + WS_WOUT) + (size_t)layer * 1024 * MIXW, T_TOK, 1024, MIXW, PROJ_LD, 24, (C_Q - (C_GATE + 1536)) * 2};
                E.mode = 1; E.eb = pg8::EpiBf16{nullptr, 0, 0, (size_t)0, 1.f}; E.er = pg8::EpiResBf16{(bf16_t*)(ws + WS_HB), DM, DN_ALPHA, FP8_OUT ? 1.f / 64.f : 1.f}; N = 1024;
            } else {
                f8 = FP8_Q;
                if (FP8_Q) g = pg8::Gemm{(const bf16_t*)(ws + WS_MIX8), (const bf16_t*)(ws + WS_WQ8 + (size_t)layer * 1024 * 1024), T_TOK, 1024, 512, 512, 1 << 30, 0};
                else g = pg8::Gemm{(const bf16_t*)(ws + WS_HB), (const bf16_t*)(ws + WS_WQ) + (size_t)layer * 1024 * 1024, T_TOK, 1024, 1024, 1024, 1 << 30, 0};
                E.mode = 0; E.eb = pg8::EpiBf16{(bf16_t*)(ws + WS_QP), DM, 0, (size_t)0, FP8_Q ? 1.f / 32.f : 1.f}; E.er = pg8::EpiResBf16{nullptr, 0, 0.f, 1.f}; N = 1024;
            }
            pg8::StaticOrder S; S.init(T_TOK, N, (int)gridDim.x, (int)obid());
            __syncthreads();
            if (f8) pg8::gemm_phase<true>(lds, g, S, E); else pg8::gemm_phase<false>(lds, g, S, E);
#ifdef EXP_GEMM_TWICE
            if (sub == EXP_GEMM_TWICE) { xcd_barrier(xbar); __syncthreads(); if (f8) pg8::gemm_phase<true>(lds, g, S, E); else pg8::gemm_phase<false>(lds, g, S, E); }
#endif
            if (sub == 0) phase_dt(P, layer);
        } else if (sub == 1) {
            phase_conv(P, layer);
        } else if (sub == 2) {
#ifndef SKIP_MIX
            phase_mixers(P, layer, lds);
#endif
        } else if (sub == 3) {
            if (FP8_OUT) phase_ssdnorm(P); else phase_ssdnorm_bf16(P);
        } else if (sub == 5) {
            ln_rows_bf16<false>((bf16_t*)(ws + WS_HB), ws + WS_MIX8, nullptr, nullptr, P.ln1_g + layer * DM, P.ln1_b + layer * DM);
        } else if (sub == 7) {
            phase_peer_topk(P, layer, lds);
#ifdef EXP_TOPK_TWICE
            xcd_barrier(xbar);
            phase_peer_topk(P, layer, lds);
#endif
        } else if (sub == 8) {
            phase_peer_e1<CTLW_QE1>(P, layer);
#ifdef EXP_E1_TWICE
            xcd_barrier(xbar);
            phase_peer_e1<7168>(P, layer);
#endif
        } else if (sub == 9) {
#ifdef EXP_E2_DUMMY
            phase_peer_e2<true>(P, layer);
            xcd_barrier(xbar);
#endif
            phase_peer_e2<false>(P, layer);
        } else if (sub == 10) {
#ifdef EXP_E3_DUMMY
            phase_peer_e3<7168, true>(P, layer);
            xcd_barrier(xbar);
#endif
            phase_peer_e3<CTLW_QE3, false>(P, layer);
        } else {
            phase_peer_e4(P, layer);
        }
    }
#ifdef TS_SUB
    if (obid() == 0 && otid() == 0) {
        unsigned long long* ts = (unsigned long long*)(ws + WS_CTL + 32768);
        const unsigned long long now = __builtin_amdgcn_s_memrealtime();
        ts[P.ph_hi] = now;
        unsigned long long d = 0;
        for (int ph = 0; ph < P.ph_hi; ++ph) {
            const bool sel = (TS_SUB == 20) ? (ph == 0) : (ph > 0 && ((ph - 1) % N_SUB) == TS_SUB);
            if (sel) d += ts[ph + 1] - ts[ph];
        }
        if (TS_SUB == 21) d = (ts[P.ph_hi] - ts[0]) / TS_AMP;
        if (TS_SUB >= 9 && TS_SUB < 20) d = ((unsigned long long*)(ws + WS_CTL + 40960))[TS_SUB];
        d *= TS_AMP;
        while (__builtin_amdgcn_s_memrealtime() - now < d) __builtin_amdgcn_s_sleep(32);
    }
#endif
}

extern "C" void kernel_launch(void* const* d_in, const int* in_sizes, int n_in, void* d_out, int out_size, void* d_ws, size_t ws_size, hipStream_t stream) {
    static int grid_blocks = 0;
    if (grid_blocks == 0) {
        if (n_in != 27 || out_size != T_TOK * DM || ws_size < WS_END) { fprintf(stderr, "kernel_launch: unexpected shapes (n_in %d out %d ws %zu need %zu)\n", n_in, out_size, ws_size, (size_t)WS_END); grid_blocks = -1; return; }
        int dev = 0, cus = 0, per_cu = 0;
        hipGetDevice(&dev);
        hipDeviceGetAttribute(&cus, hipDeviceAttributeMultiprocessorCount, dev);
        if (hipFuncSetAttribute((const void*)fwd_megakernel, hipFuncAttributeMaxDynamicSharedMemorySize, LDS_BYTES) != hipSuccess) { fprintf(stderr, "kernel_launch: hipFuncSetAttribute failed\n"); grid_blocks = -1; return; }
        hipOccupancyMaxActiveBlocksPerMultiprocessor(&per_cu, (const void*)fwd_megakernel, NTHREADS, LDS_BYTES);
        if (per_cu < 1) { fprintf(stderr, "kernel_launch: occupancy query says %d blocks per CU\n", per_cu); grid_blocks = -1; return; }
        grid_blocks = cus;
    }
    if (grid_blocks < 0) return;
    hipMemsetAsync((char*)d_ws + WS_CTL, 0, 65536, stream);
    Params p{};
    const float** pp = (const float**)&p;
    for (int i = 0; i < 27; ++i) pp[i] = (const float*)d_in[i];
    p.out = (float*)d_out; p.ws = (unsigned char*)d_ws; p.ph_lo = 0; p.ph_hi = PH_HI;
    void* args[] = {&p};
    hipError_t e = hipLaunchCooperativeKernel((const void*)fwd_megakernel, dim3(grid_blocks), dim3(NTHREADS), args, LDS_BYTES, stream);
    if (e != hipSuccess) fprintf(stderr, "cooperative launch failed: %s (grid %d)\n", hipGetErrorString(e), grid_blocks);
}
```

```cpp
#include <hip/hip_runtime.h>
#include <hip/hip_cooperative_groups.h>
#include <cstdio>
#include <cstdint>
namespace cg = cooperative_groups;
#ifndef PH_HI
#define PH_HI N_PHASES
#endif
#ifdef TS_SUB
#ifndef TS_AMP
#define TS_AMP 4
#endif
#endif
#ifndef FP8_IN
#define FP8_IN 0
#endif
#ifndef FP8_OUT
#define FP8_OUT 1
#endif
#ifndef FP8_Q
#define FP8_Q 0
#endif
#if FP8_OUT && (FP8_IN || FP8_Q)
#error "the fp8 mix buffer shares workspace with the fp8 copies of the other GEMMs"
#endif
#ifndef MIX_MASK
#define MIX_MASK 7
#endif

#define LAS __attribute__((address_space(3)))
typedef unsigned short bf16_t;
typedef short bf16x8 __attribute__((ext_vector_type(8)));
typedef float f32x4 __attribute__((ext_vector_type(4)));
typedef float f32x2 __attribute__((ext_vector_type(2)));
typedef unsigned u32x4 __attribute__((ext_vector_type(4)));
typedef unsigned u32x2 __attribute__((ext_vector_type(2)));
using bf16x2v = __attribute__((ext_vector_type(2))) __bf16;

constexpr int T_TOK = 65536, DM = 1024, SEQ = 4096, NBATCH = 16, DEPTH = 2;
constexpr int W_IN_LD = 4368;
constexpr int PROJ_LD = 4352;
constexpr int C_RGX = 0, C_GATE = 512, C_Z = 1024, C_XBC = 2048, C_DT = 3584, C_Q = 3584, C_K = 4096, C_V = 4224;
constexpr int N_IN = 4352;
constexpr int MIXW = 2048;
constexpr float DN_ALPHA = 1.41421356237f;
constexpr float LN_EPS = 1e-5f;
constexpr int NTHREADS = 512;
constexpr int LDS_BYTES = 147456;

constexpr size_t WS_CTL  = 0;
constexpr size_t WS_WIN  = 65536;
constexpr size_t WS_WDT  = WS_WIN  + (size_t)2 * N_IN * 1024 * 2;
constexpr size_t WS_WOUT = WS_WDT  + (size_t)2 * 16 * 1024 * 2;
constexpr size_t WS_WQ   = WS_WOUT + (size_t)2 * 1024 * 2048 * 2;
constexpr size_t WS_KEYS = WS_WQ   + (size_t)2 * 1024 * 1024 * 2;
constexpr size_t WS_WA   = WS_KEYS + (size_t)2 * 2 * 128 * 64 * 2;
constexpr size_t WS_WX   = WS_WA   + (size_t)2 * 8 * 64 * 64 * 2;
constexpr size_t WS_U    = WS_WX   + (size_t)2 * 8 * 64 * 64 * 2;
constexpr size_t WS_V    = WS_U    + (size_t)2 * 16384 * 1024 * 2;
constexpr size_t WS_HB   = WS_V    + (size_t)2 * 16384 * 1024 * 2;
constexpr size_t WS_DT   = WS_HB   + (size_t)T_TOK * 1024 * 2;
constexpr size_t WS_SSQ  = WS_DT   + (size_t)T_TOK * 16 * 4;
constexpr size_t WS_PROJ = WS_SSQ  + (size_t)T_TOK * 16 * 4;
constexpr size_t WS_PEND = WS_PROJ + (size_t)T_TOK * PROJ_LD * 2;
constexpr size_t WS_HB8  = WS_PEND;
constexpr size_t WS_WIN8 = WS_HB8 + (size_t)T_TOK * 1024;
constexpr size_t WS_WQ8  = WS_WIN8 + (size_t)2 * N_IN * 1024;
constexpr size_t WS_MIX8 = WS_PEND;
constexpr size_t WS_WOUT8 = WS_MIX8 + (size_t)T_TOK * MIXW;
constexpr size_t WS_END  = WS_WOUT8 + (size_t)2 * 1024 * MIXW;
constexpr size_t WS_U8 = WS_U, WS_SU = WS_U + (size_t)2 * 16384 * 1024;
constexpr size_t WS_V8 = WS_V, WS_SV = WS_V + (size_t)2 * 16384 * 1024;
constexpr size_t WS_QP   = WS_PROJ;
constexpr size_t WS_IDX  = WS_QP  + (size_t)T_TOK * 1024 * 2;
constexpr size_t WS_GATE = WS_IDX + (size_t)T_TOK * 128 * 4;
constexpr size_t WS_PD   = WS_GATE + (size_t)T_TOK * 128 * 4;
constexpr size_t WS_STAT = WS_PD + (size_t)T_TOK * 8 * 128 * 4;
static_assert(WS_STAT + (size_t)T_TOK * 8 * 2 * 4 <= WS_PEND, "PEER buffers must fit inside the proj region");
static_assert(WS_END <= ((size_t)1 << 30), "workspace must fit 1 GiB");
constexpr int CTLW_QE1 = 5120, CTLW_QE3 = 6144;

struct Params {
    const float* x; const float* emb_g; const float* emb_b; const float* w_in; const float* rg_conv_w; const float* rg_conv_b;
    const float* rg_wa; const float* rg_ba; const float* rg_wx; const float* rg_bx; const float* rg_lambda;
    const float* ssm_conv_w; const float* ssm_conv_b; const float* ssm_dt_bias; const float* ssm_a_log; const float* ssm_d; const float* ssm_norm_g;
    const float* attn_sinks; const float* w_out; const float* ln1_g; const float* ln1_b;
    const float* peer_wq; const float* peer_keys; const float* peer_u; const float* peer_v; const float* ln2_g; const float* ln2_b;
    float* out; unsigned char* ws; int ph_lo, ph_hi;
};

typedef __bf16 bf16x2n __attribute__((ext_vector_type(2)));
__device__ __forceinline__ unsigned cvt_pk_bf16(float lo, float hi) { const f32x2 v = {lo, hi}; const bf16x2n r = __builtin_convertvector(v, bf16x2n); return __builtin_bit_cast(unsigned, r); }
__device__ __forceinline__ bf16_t f2bf(float f) { return (bf16_t)(cvt_pk_bf16(f, 0.f) & 0xffffu); }
__device__ __forceinline__ float bf2f(bf16_t b) { return __uint_as_float(((unsigned)b) << 16); }
__device__ __forceinline__ float bflo(unsigned w) { return __uint_as_float(w << 16); }
__device__ __forceinline__ float bfhi(unsigned w) { return __uint_as_float(w & 0xffff0000u); }
__device__ __forceinline__ float sigmoidf_(float x) { return __builtin_amdgcn_rcpf(1.f + __expf(-x)); }
__device__ __forceinline__ float siluf_(float x) { return x * __builtin_amdgcn_rcpf(1.f + __expf(-x)); }
__device__ __forceinline__ float softplusf_(float x) { return x > 20.f ? x : log1pf(__expf(x)); }
__device__ __forceinline__ float gelu_tanhf_(float x) { const float u = 0.7978845608028654f * (x + 0.044715f * x * x * x); const float t = 1.f - 2.f * __builtin_amdgcn_rcpf(__expf(2.f * u) + 1.f); return 0.5f * x * (1.f + t); }
__device__ __forceinline__ float gelu_erff_(float x) { return 0.5f * x * (1.f + erff(x * 0.70710678118654752f)); }
__device__ __forceinline__ float wave_sum(float v) {
#pragma unroll
    for (int o = 32; o > 0; o >>= 1) v += __shfl_xor(v, o);
    return v;
}
template <int CTRL> __device__ __forceinline__ float dpp_(float x) { return __builtin_bit_cast(float, __builtin_amdgcn_mov_dpp(__builtin_bit_cast(int, x), CTRL, 0xf, 0xf, true)); }
__device__ __forceinline__ float row_sum16(float x) { x += dpp_<0xB1>(x); x += dpp_<0x4E>(x); x += dpp_<0x141>(x); x += dpp_<0x128>(x); return x; }
__device__ __forceinline__ float row_max16(float x) { x = fmaxf(x, dpp_<0xB1>(x)); x = fmaxf(x, dpp_<0x4E>(x)); x = fmaxf(x, dpp_<0x141>(x)); x = fmaxf(x, dpp_<0x128>(x)); return x; }
__device__ __forceinline__ float rdlane(float x, int l) { return __builtin_bit_cast(float, __builtin_amdgcn_readlane(__builtin_bit_cast(int, x), l)); }
__device__ __forceinline__ float wave_sum_dpp(float x) { x = row_sum16(x); return (rdlane(x, 0) + rdlane(x, 16)) + (rdlane(x, 32) + rdlane(x, 48)); }
__device__ __forceinline__ float gelu_cdf_(float v) {
    const float av = fabsf(v), t = __builtin_amdgcn_rcpf(av * 0.2316418882f + 1.0f);
    float q = t * 0.5307027145f + (-0.7265760135f); q = q * t + 0.7107068705f; q = q * t + (-0.142248368f); q = q * t + 0.127414796f; q = q * t;
    const float e = __builtin_amdgcn_exp2f(v * v * (-0.72134752044f));
    const float m = v * (q * e), r = v - m;
    return v < 0.f ? m : r;
}
__device__ __forceinline__ float dot2bf(unsigned a, unsigned b, float acc) { return __builtin_amdgcn_fdot2_f32_bf16(__builtin_bit_cast(bf16x2v, a), __builtin_bit_cast(bf16x2v, b), acc, false); }
__device__ __forceinline__ unsigned umax_(unsigned a, unsigned b) { return a > b ? a : b; }
__device__ __forceinline__ unsigned umin_(unsigned a, unsigned b) { return a < b ? a : b; }
__device__ __forceinline__ u32x2 cvt8_fp8(const float* v, float sc) {
    int a = 0, b = 0;
    a = __builtin_amdgcn_cvt_pk_fp8_f32(v[0] * sc, v[1] * sc, a, false); a = __builtin_amdgcn_cvt_pk_fp8_f32(v[2] * sc, v[3] * sc, a, true);
    b = __builtin_amdgcn_cvt_pk_fp8_f32(v[4] * sc, v[5] * sc, b, false); b = __builtin_amdgcn_cvt_pk_fp8_f32(v[6] * sc, v[7] * sc, b, true);
    u32x2 r; r.x = (unsigned)a; r.y = (unsigned)b; return r;
}
__device__ __forceinline__ int otid() { int t = (int)threadIdx.x; asm volatile("" : "+v"(t)); return t; }
__device__ __forceinline__ int obid() { int b = (int)blockIdx.x; asm volatile("" : "+s"(b)); return b; }
#define MFMA16(a, b, c) __builtin_amdgcn_mfma_f32_16x16x32_bf16((a), (b), (c), 0, 0, 0)

#define XB_TMO      128
#define XB_XCNT(j)  (256  + 64 * (j))
#define XB_XSUB(j)  (1280 + 64 * (j))
#define XB_XGEN(j)  (2304 + 64 * (j))
#define XB_TOP      3328
#define XB_TOPGEN   3392
#define XCD_BAR_WORDS 3456
#define XB_SPIN_CAP (1u << 22)
__device__ __forceinline__ unsigned xb_ld(unsigned* p)              { return __hip_atomic_load(p, __ATOMIC_RELAXED, __HIP_MEMORY_SCOPE_AGENT); }
__device__ __forceinline__ unsigned xb_add(unsigned* p, unsigned v) { return __hip_atomic_fetch_add(p, v, __ATOMIC_RELAXED, __HIP_MEMORY_SCOPE_AGENT); }
__device__ __forceinline__ unsigned xb_xcc_id() { return (unsigned)__builtin_amdgcn_s_getreg((3 << 11) | 20) & 0xFu; }
#define XB_SPIN(cond, bar) do { unsigned _sp = 0; while (cond) { __builtin_amdgcn_s_sleep(1); \
    if ((++_sp & 255u) == 0u) { if (xb_ld(&(bar)[XB_TMO])) break; if (_sp > XB_SPIN_CAP) { atomicAdd(&(bar)[XB_TMO], 1u); break; } } } } while (0)
struct XcdBarrier { unsigned* bar; unsigned x; volatile LAS unsigned* st; };
__device__ __forceinline__ XcdBarrier xcd_barrier_post(unsigned* bar, volatile LAS unsigned* st) {
    XcdBarrier b; b.bar = bar; b.x = xb_xcc_id(); b.st = st;
    if (otid() == 0) (void)xb_add(&bar[XB_XCNT(b.x)], 1u);
    return b;
}
__device__ __forceinline__ void xcd_barrier_complete(unsigned* bar, unsigned x, unsigned& nloc, unsigned& nx) {
    const unsigned G = gridDim.x * gridDim.y * gridDim.z;
    unsigned sum, cnt, mine, sp = 0u;
    for (;;) {
        sum = 0u; cnt = 0u; mine = 0u;
#pragma unroll
        for (unsigned j = 0; j < 16; ++j) { const unsigned c = xb_ld(&bar[XB_XCNT(j)]); sum += c; cnt += (c > 0u) ? 1u : 0u; mine = (j == x) ? c : mine; }
        if (sum == G) break;
        __builtin_amdgcn_s_sleep(1);
        if ((++sp & 255u) == 0u) { if (xb_ld(&bar[XB_TMO])) break; if (sp > XB_SPIN_CAP) { atomicAdd(&bar[XB_TMO], 1u); break; } }
    }
    nloc = mine > 0u ? mine : 1u; nx = cnt > 0u ? cnt : 1u;
}
__device__ __forceinline__ void xcd_barrier(const XcdBarrier& b) {
    asm volatile("s_waitcnt vmcnt(0)" ::: "memory");
    __syncthreads();
    if (otid() == 0) {
        unsigned* bar = b.bar;
        __builtin_amdgcn_s_waitcnt(0);
        unsigned nloc = b.st[0], nx = b.st[1];
        if (nloc == 0u) { xcd_barrier_complete(bar, b.x, nloc, nx); b.st[0] = nloc; b.st[1] = nx; }
        const unsigned old = xb_add(&bar[XB_XSUB(b.x)], 1u);
        const unsigned gen = old / nloc;
        if (old + 1u == (gen + 1u) * nloc) {
            __builtin_amdgcn_fence(__ATOMIC_RELEASE, "agent");
            asm volatile("s_waitcnt vmcnt(0)" ::: "memory");
            const unsigned og = xb_add(&bar[XB_TOP], 1u);
            const unsigned tg = og / nx;
            if (og + 1u == (tg + 1u) * nx) xb_add(&bar[XB_TOPGEN], 1u);
            else XB_SPIN(xb_ld(&bar[XB_TOPGEN]) == tg, bar);
            __builtin_amdgcn_fence(__ATOMIC_ACQUIRE, "agent");
            xb_add(&bar[XB_XGEN(b.x)], 1u);
            asm volatile("s_waitcnt vmcnt(0)" ::: "memory");
        } else {
            XB_SPIN(xb_ld(&bar[XB_XGEN(b.x)]) == gen, bar);
            __builtin_amdgcn_fence(__ATOMIC_ACQUIRE, "agent");
            asm volatile("s_waitcnt vmcnt(0)" ::: "memory");
        }
    }
    __syncthreads();
}

namespace pg8 {
typedef int v8i32_t __attribute__((ext_vector_type(8)));
typedef int v4i32_t __attribute__((ext_vector_type(4)));
constexpr int BM = 256, BK = 64, HALF = 128, HTB = HALF * BK * 2, STAGE_BYTES = 8 * HTB, NXCD = 8, WGM = 4;
__device__ __forceinline__ int lds_byte(int r, int c) { const int st = (r >> 4) * 2 + (c >> 5), rr = r & 15, cc = c & 31, ob = rr * 64 + cc * 2; return st * 1024 + (ob ^ (((ob >> 9) & 1) << 5)); }
__device__ __forceinline__ void stage_rc(int b, int& R, int& C) { const int st = b / 1024, sb = b % 1024, swz = sb ^ (((sb >> 9) & 1) << 5); R = (st >> 1) * 16 + swz / 64; C = (st & 1) * 32 + (swz % 64) / 2; }
__device__ __forceinline__ int perm32(int rho) { const int n = rho >> 4, i = rho & 15; return 8 * (i >> 2) + 4 * n + (i & 3); }
struct Unit { int pm, pn; };
struct Gemm { const bf16_t* A; const bf16_t* Bt; int M, N, K, lda, ksplit, kextra; };
struct StaticOrder {
    int nM, nN, nwg, G, c;
    __device__ void init(int M, int N, int G_, int c_) { nM = M / BM; nN = N / BM; nwg = nM * nN; G = G_; c = c_; }
    __device__ bool next(int i, Unit& u) const {
        const long L = (long)i * G + c; if (L >= nwg) return false;
        int wgid = (int)L; { const int q = nwg / NXCD, r = nwg % NXCD, xcd = wgid % NXCD, off = wgid / NXCD; wgid = (xcd < r ? xcd * (q + 1) : r * (q + 1) + (xcd - r) * q) + off; }
        const int nig = WGM * nN, gid = wgid / nig, fm = gid * WGM, gsz = (nM - fm) < WGM ? (nM - fm) : WGM;
        u.pm = fm + ((wgid % nig) % gsz); u.pn = (wgid % nig) / gsz; return true;
    }
};
struct EpiBf16 {
    static constexpr bool PERM = true;
    bf16_t* O; int ldc; int split_cols; size_t split_stride; float oscale;
    __device__ __forceinline__ void operator()(const f32x4 (&acc)[2][2][4][2], const Unit& u, int wr, int wc, int fr, int fq) const {
        const int row0 = u.pm * BM + wr * 64 + fr; int colt = u.pn * BM; bf16_t* base = O;
        if (split_cols) { const int t = colt / split_cols; base += (size_t)t * split_stride; colt -= t * split_cols; }
        const int col0 = colt + wc * 32 + 8 * fq;
#pragma unroll
        for (int ai = 0; ai < 2; ++ai)
#pragma unroll
            for (int m = 0; m < 4; ++m) { bf16_t* rowp = base + (size_t)(row0 + ai * HALF + m * 16) * ldc + col0;
#pragma unroll
                for (int bj = 0; bj < 2; ++bj) { const f32x4 v0 = acc[ai][bj][m][0] * oscale, v1 = acc[ai][bj][m][1] * oscale;
                    u32x4 w; w.x = cvt_pk_bf16(v0[0], v0[1]); w.y = cvt_pk_bf16(v0[2], v0[3]); w.z = cvt_pk_bf16(v1[0], v1[1]); w.w = cvt_pk_bf16(v1[2], v1[3]);
                    *(u32x4*)(rowp + bj * HALF) = w; } }
    }
};
struct EpiResBf16 {
    bf16_t* H; int ldc; float alpha; float oscale;
    __device__ __forceinline__ void operator()(const f32x4 (&acc)[2][2][4][2], const Unit& u, int wr, int wc, int fr, int fq) const {
        const int row0 = u.pm * BM + wr * 64 + fr, col0 = u.pn * BM + wc * 32 + 8 * fq;
#pragma unroll
        for (int ai = 0; ai < 2; ++ai) {
            u32x4 hres[4][2];
#pragma unroll
            for (int m = 0; m < 4; ++m)
#pragma unroll
                for (int bj = 0; bj < 2; ++bj) hres[m][bj] = *(const u32x4*)(H + (size_t)(row0 + ai * HALF + m * 16) * ldc + col0 + bj * HALF);
#pragma unroll
            for (int m = 0; m < 4; ++m) { bf16_t* rowp = H + (size_t)(row0 + ai * HALF + m * 16) * ldc + col0;
#pragma unroll
                for (int bj = 0; bj < 2; ++bj) { u32x4* p = (u32x4*)(rowp + bj * HALF); const u32x4 h = hres[m][bj]; const f32x4 v0 = acc[ai][bj][m][0] * oscale, v1 = acc[ai][bj][m][1] * oscale;
                    u32x4 w; w.x = cvt_pk_bf16(alpha * bflo(h.x) + v0[0], alpha * bfhi(h.x) + v0[1]); w.y = cvt_pk_bf16(alpha * bflo(h.y) + v0[2], alpha * bfhi(h.y) + v0[3]);
                    w.z = cvt_pk_bf16(alpha * bflo(h.z) + v1[0], alpha * bfhi(h.z) + v1[1]); w.w = cvt_pk_bf16(alpha * bflo(h.w) + v1[2], alpha * bfhi(h.w) + v1[3]);
                    *p = w; } }
        }
    }
};
struct Epi {
    int mode; EpiBf16 eb; EpiResBf16 er;
};
template <bool FP8>
__device__ __forceinline__ void gemm_phase(LAS unsigned char* lds, const Gemm g, const StaticOrder& S, const Epi& E) {
    const int tid = otid(), wid = __builtin_amdgcn_readfirstlane(tid >> 6), lane = tid & 63, wr = wid >> 2, wc = wid & 3, fr = lane & 15, fq = lane >> 4;
    const int K = g.K, nt = K / BK, lda = g.lda;
    unsigned voffA[2], voffB[2];
#pragma unroll
    for (int i = 0; i < 2; ++i) { int R, C; stage_rc(tid * 16 + i * 8192, R, C); const int Rb = (R & ~31) + perm32(R & 31);
        voffA[i] = (unsigned)(R * lda + C) * 2u; voffB[i] = (unsigned)(Rb * K + C) * 2u; }
    const size_t kstep = (size_t)(BK * 2);
    const size_t hstepA = (size_t)HALF * lda * 2, hstepB = (size_t)HALF * K * 2;
    const size_t tstepA = 2 * hstepA, tstepB = 2 * hstepB;
    const int ksplit = g.ksplit; const size_t kextra = (size_t)g.kextra;
#define PG8_AKOFF(t) ((size_t)(t) * kstep + (((t) >= ksplit) ? kextra : (size_t)0))
    const unsigned ldsw = (unsigned)wid * 1024u;
    const int aoff = lds_byte(wr * 64 + fr, fq * 8), boff = lds_byte(wc * 32 + fr, fq * 8);
#define PG8_SA(b, h) (((b) * 2 + (h)) * HTB)
#define PG8_SB(b, h) ((4 + (b) * 2 + (h)) * HTB)
#define PG8_STAGE(bufoff, gbase, voff) do { _Pragma("unroll") for (int _i = 0; _i < 2; ++_i) \
        __builtin_amdgcn_global_load_lds((const unsigned*)((const char*)(gbase) + (voff)[_i]), (LAS unsigned*)(lds + (bufoff) + ldsw + _i * 8192), 16, 0, 0); } while (0)
#define PG8_LDA(dst, b, h) do { _Pragma("unroll") for (int m = 0; m < 4; ++m) dst[m] = __builtin_shufflevector(*(const LAS v4i32_t*)(lds + PG8_SA(b, h) + aoff + m * 2048), *(const LAS v4i32_t*)(lds + PG8_SA(b, h) + aoff + m * 2048 + 1024), 0, 1, 2, 3, 4, 5, 6, 7); } while (0)
#define PG8_LDB(dst, b, h) do { _Pragma("unroll") for (int n = 0; n < 2; ++n) dst[n] = __builtin_shufflevector(*(const LAS v4i32_t*)(lds + PG8_SB(b, h) + boff + n * 2048), *(const LAS v4i32_t*)(lds + PG8_SB(b, h) + boff + n * 2048 + 1024), 0, 1, 2, 3, 4, 5, 6, 7); } while (0)
#define PG8_MMA8(ai, bj, At, Bt) do { __builtin_amdgcn_s_setprio(1); _Pragma("unroll") for (int m = 0; m < 4; ++m) _Pragma("unroll") for (int n = 0; n < 2; ++n) \
        asm volatile("s_nop 1\n\tv_mfma_scale_f32_16x16x128_f8f6f4 %0, %1, %2, %0, %3, %3 op_sel_hi:[0,0,0]" : "+v"(acc[ai][bj][m][n]) : "v"(Bt[n]), "v"(At[m]), "v"(mxscale)); \
        __builtin_amdgcn_s_setprio(0); } while (0)
#define PG8_MMA16(ai, bj, At, Bt) do { __builtin_amdgcn_s_setprio(1); _Pragma("unroll") for (int m = 0; m < 4; ++m) _Pragma("unroll") for (int n = 0; n < 2; ++n) { \
        acc[ai][bj][m][n] = __builtin_amdgcn_mfma_f32_16x16x32_bf16(__builtin_bit_cast(bf16x8, __builtin_shufflevector(Bt[n], Bt[n], 0, 1, 2, 3)), __builtin_bit_cast(bf16x8, __builtin_shufflevector(At[m], At[m], 0, 1, 2, 3)), acc[ai][bj][m][n], 0, 0, 0); \
        acc[ai][bj][m][n] = __builtin_amdgcn_mfma_f32_16x16x32_bf16(__builtin_bit_cast(bf16x8, __builtin_shufflevector(Bt[n], Bt[n], 4, 5, 6, 7)), __builtin_bit_cast(bf16x8, __builtin_shufflevector(At[m], At[m], 4, 5, 6, 7)), acc[ai][bj][m][n], 0, 0, 0); } \
        __builtin_amdgcn_s_setprio(0); } while (0)
#define PG8_MM(ai, bj, At, Bt) do { if (FP8) PG8_MMA8(ai, bj, At, Bt); else PG8_MMA16(ai, bj, At, Bt); } while (0)
#define PG8_WAIT_V(n) asm volatile("s_waitcnt vmcnt(" #n ")" ::: "memory")
#define PG8_WAIT_L(n) asm volatile("s_waitcnt lgkmcnt(" #n ")" ::: "memory")
#define PG8_BAR __builtin_amdgcn_s_barrier()
#define PG8_SCHED __builtin_amdgcn_sched_barrier(0)
    Unit cur, nxt; int ui = 0;
    if (!S.next(0, cur)) return;
    f32x4 acc[2][2][4][2];
#pragma unroll
    for (int a = 0; a < 2; ++a)
#pragma unroll
        for (int b = 0; b < 2; ++b)
#pragma unroll
            for (int m = 0; m < 4; ++m)
#pragma unroll
                for (int n = 0; n < 2; ++n) acc[a][b][m][n] = (f32x4){0.f, 0.f, 0.f, 0.f};
    v8i32_t At[4], B0[2], B1[2];
    const int mxscale = 0x7F7F7F7F;
    const char* cA = (const char*)g.A + (size_t)cur.pm * tstepA; const char* cB = (const char*)g.Bt + (size_t)cur.pn * tstepB;
    PG8_STAGE(PG8_SB(0, 0), cB, voffB); PG8_STAGE(PG8_SA(0, 0), cA, voffA); PG8_STAGE(PG8_SB(0, 1), cB + hstepB, voffB); PG8_STAGE(PG8_SA(0, 1), cA + hstepA, voffA);
    if (wr == 1) PG8_BAR;
    PG8_WAIT_V(4); PG8_BAR;
    PG8_STAGE(PG8_SB(1, 0), cB + kstep, voffB); PG8_STAGE(PG8_SA(1, 0), cA + PG8_AKOFF(1), voffA); PG8_STAGE(PG8_SB(1, 1), cB + hstepB + kstep, voffB);
    PG8_WAIT_V(6); PG8_BAR;
    for (;;) {
        const bool has_next = S.next(ui + 1, nxt);
        const char* nA = has_next ? (const char*)g.A + (size_t)nxt.pm * tstepA : cA; const char* nB = has_next ? (const char*)g.Bt + (size_t)nxt.pn * tstepB : cB;
        for (int t = 0; t < nt; t += 2) {
            const bool last = (t == nt - 2);
            const char* a1 = cA + PG8_AKOFF(t + 1);
            const char* a2 = last ? nA : cA + PG8_AKOFF(t + 2); const char* b2 = last ? nB : cB + (size_t)(t + 2) * kstep;
            const char* a3 = last ? nA + PG8_AKOFF(1) : cA + PG8_AKOFF(t + 3); const char* b3 = b2 + kstep;
            PG8_LDB(B0, 0, 0); PG8_SCHED; PG8_LDA(At, 0, 0); PG8_STAGE(PG8_SA(1, 1), a1 + hstepA, voffA);
            PG8_WAIT_L(8); PG8_BAR; PG8_WAIT_L(0); PG8_MM(0, 0, At, B0); PG8_BAR; PG8_SCHED;
            PG8_LDB(B1, 0, 1); PG8_STAGE(PG8_SB(0, 0), b2, voffB);
            PG8_BAR; PG8_WAIT_L(0); PG8_MM(0, 1, At, B1); PG8_BAR;
            PG8_LDA(At, 0, 1); PG8_STAGE(PG8_SA(0, 0), a2, voffA);
            PG8_BAR; PG8_WAIT_L(0); PG8_MM(1, 0, At, B0); PG8_BAR; PG8_SCHED;
            PG8_STAGE(PG8_SB(0, 1), b2 + hstepB, voffB);
            PG8_WAIT_V(6); PG8_BAR; PG8_MM(1, 1, At, B1); PG8_BAR;
            PG8_LDB(B0, 1, 0); PG8_SCHED; PG8_LDA(At, 1, 0); PG8_STAGE(PG8_SA(0, 1), a2 + hstepA, voffA);
            PG8_WAIT_L(8); PG8_BAR; PG8_WAIT_L(0); PG8_MM(0, 0, At, B0); PG8_BAR; PG8_SCHED;
            PG8_LDB(B1, 1, 1); PG8_STAGE(PG8_SB(1, 0), b3, voffB);
            PG8_BAR; PG8_WAIT_L(0); PG8_MM(0, 1, At, B1); PG8_BAR;
            PG8_LDA(At, 1, 1); PG8_STAGE(PG8_SA(1, 0), a3, voffA);
            PG8_BAR; PG8_WAIT_L(0); PG8_MM(1, 0, At, B0); PG8_BAR; PG8_SCHED;
            PG8_STAGE(PG8_SB(1, 1), b3 + hstepB, voffB);
            PG8_WAIT_V(6); PG8_BAR; PG8_MM(1, 1, At, B1); PG8_BAR;
        }
        asm volatile("s_nop 15\n\ts_nop 15" ::: "memory");
        if (E.mode == 0) E.eb(acc, cur, wr, wc, fr, fq); else E.er(acc, cur, wr, wc, fr, fq);
        if (!has_next) break;
#pragma unroll
        for (int a = 0; a < 2; ++a)
#pragma unroll
            for (int b = 0; b < 2; ++b)
#pragma unroll
                for (int m = 0; m < 4; ++m)
#pragma unroll
                    for (int n = 0; n < 2; ++n) acc[a][b][m][n] = (f32x4){0.f, 0.f, 0.f, 0.f};
        cur = nxt; cA = nA; cB = nB; ++ui;
    }
    PG8_WAIT_V(0);
    if (wr == 0) PG8_BAR;
    PG8_BAR;
#undef PG8_AKOFF
#undef PG8_SA
#undef PG8_SB
#undef PG8_STAGE
#undef PG8_LDA
#undef PG8_LDB
#undef PG8_MMA8
#undef PG8_MMA16
#undef PG8_MM
#undef PG8_WAIT_V
#undef PG8_WAIT_L
#undef PG8_BAR
#undef PG8_SCHED
}
}

__device__ __forceinline__ void tr_tile(LAS float* s, const float* src, int ld_src, int k0, int c0, bf16_t* dst, int ld_dst, int n0, const float* scale, unsigned char* dst8 = nullptr, float sc8 = 32.f) {
    const int tid = otid();
    {
        const int r = tid >> 4, c4 = (tid & 15) * 4;
#pragma unroll
        for (int p = 0; p < 2; ++p) {
            const int rr = r + p * 32;
            f32x4 v = *(const f32x4*)(src + (size_t)(k0 + rr) * ld_src + c0 + c4);
            if (scale) { const float sc = scale[rr]; v = v * sc; }
            s[rr * 65 + c4 + 0] = v[0]; s[rr * 65 + c4 + 1] = v[1]; s[rr * 65 + c4 + 2] = v[2]; s[rr * 65 + c4 + 3] = v[3];
        }
    }
    __syncthreads();
    {
        const int n = tid >> 3, kq = (tid & 7) * 8;
        float v[8];
#pragma unroll
        for (int j = 0; j < 8; ++j) v[j] = s[(kq + j) * 65 + n];
        u32x4 w; w.x = cvt_pk_bf16(v[0], v[1]); w.y = cvt_pk_bf16(v[2], v[3]); w.z = cvt_pk_bf16(v[4], v[5]); w.w = cvt_pk_bf16(v[6], v[7]);
        *(u32x4*)(dst + (size_t)(n0 + n) * ld_dst + k0 + kq) = w;
        if (dst8) *(u32x2*)(dst8 + (size_t)(n0 + n) * ld_dst + k0 + kq) = cvt8_fp8(v, sc8);
    }
    __syncthreads();
}

__device__ __forceinline__ void convert_rows(const float* src, bf16_t* dst, size_t n_elems) {
    const size_t n8 = n_elems / 8;
    for (size_t i = (size_t)obid() * NTHREADS + otid(); i < n8; i += (size_t)gridDim.x * NTHREADS) {
        const f32x4 a = *(const f32x4*)(src + i * 8), b = *(const f32x4*)(src + i * 8 + 4);
        u32x4 w; w.x = cvt_pk_bf16(a[0], a[1]); w.y = cvt_pk_bf16(a[2], a[3]); w.z = cvt_pk_bf16(b[0], b[1]); w.w = cvt_pk_bf16(b[2], b[3]);
        *(u32x4*)(dst + i * 8) = w;
    }
}

__device__ __forceinline__ void ln_rows_f32(const float* in, bf16_t* hb, unsigned char* hb8, const float* g, const float* bta) {
    const int lane = otid() & 63, wid = otid() >> 6;
    f32x4 gg[4], bb[4];
#pragma unroll
    for (int i = 0; i < 4; ++i) { gg[i] = ((const f32x4*)g)[lane + 64 * i]; bb[i] = ((const f32x4*)bta)[lane + 64 * i]; }
    constexpr int NR = 4;
    for (int r0 = (obid() * 8 + wid) * NR; r0 < T_TOK; r0 += gridDim.x * 8 * NR) {
        f32x4 vv[NR][4];
#pragma unroll
        for (int k = 0; k < NR; ++k) { const f32x4* xr = (const f32x4*)(in + (size_t)(r0 + k) * DM);
#pragma unroll
            for (int i = 0; i < 4; ++i) vv[k][i] = xr[lane + 64 * i]; }
#pragma unroll
        for (int k = 0; k < NR; ++k) {
            const int r = r0 + k;
            f32x4 v[4]; float s = 0.f;
#pragma unroll
            for (int i = 0; i < 4; ++i) { v[i] = vv[k][i]; s += v[i][0] + v[i][1] + v[i][2] + v[i][3]; }
            s = wave_sum(s);
            const float mu = s * (1.f / DM);
            float q = 0.f;
#pragma unroll
            for (int i = 0; i < 4; ++i) { v[i] = v[i] - mu; q += v[i][0] * v[i][0] + v[i][1] * v[i][1] + v[i][2] * v[i][2] + v[i][3] * v[i][3]; }
            q = wave_sum(q);
            const float rs = rsqrtf(q * (1.f / DM) + LN_EPS);
            u32x2* hrow = (u32x2*)(hb + (size_t)r * DM);
#pragma unroll
            for (int i = 0; i < 4; ++i) {
                const f32x4 o = v[i] * rs * gg[i] + bb[i];
                u32x2 w; w.x = cvt_pk_bf16(o[0], o[1]); w.y = cvt_pk_bf16(o[2], o[3]);
                hrow[lane + 64 * i] = w;
                if (FP8_IN || FP8_Q) { int d8 = 0; d8 = __builtin_amdgcn_cvt_pk_fp8_f32(o[0], o[1], d8, false); d8 = __builtin_amdgcn_cvt_pk_fp8_f32(o[2], o[3], d8, true);
                    ((unsigned*)(hb8 + (size_t)r * DM))[lane + 64 * i] = (unsigned)d8; }
            }
        }
    }
}
template <bool HAVE_STAT>
__device__ __forceinline__ void ln_rows_bf16(bf16_t* hb, unsigned char* hb8, float* out_f32, const float* STAT, const float* g, const float* bta) {
    const int lane = otid() & 63, wid = otid() >> 6;
    f32x4 gg[4], bb[4];
#pragma unroll
    for (int i = 0; i < 2; ++i) { gg[2 * i] = *(const f32x4*)(g + i * 512 + lane * 8); gg[2 * i + 1] = *(const f32x4*)(g + i * 512 + lane * 8 + 4);
        bb[2 * i] = *(const f32x4*)(bta + i * 512 + lane * 8); bb[2 * i + 1] = *(const f32x4*)(bta + i * 512 + lane * 8 + 4); }
    constexpr int NR = 4;
    for (int r0 = (obid() * 8 + wid) * NR; r0 < T_TOK; r0 += gridDim.x * 8 * NR) {
        u32x4 ra[NR], rb[NR]; f32x4 st[NR][2];
#pragma unroll
        for (int k = 0; k < NR; ++k) {
            const bf16_t* hrow = hb + (size_t)(r0 + k) * DM;
            ra[k] = *(const u32x4*)(hrow + lane * 8); rb[k] = *(const u32x4*)(hrow + 512 + lane * 8);
            if (HAVE_STAT) {
#pragma unroll
                for (int q = 0; q < 2; ++q) st[k][q] = *(const f32x4*)(STAT + (size_t)(r0 + k) * 8 + 4 * q);
            }
        }
#pragma unroll
        for (int k = 0; k < NR; ++k) {
            const int r = r0 + k;
            bf16_t* hrow = hb + (size_t)r * DM;
            float v[16];
#pragma unroll
            for (int i = 0; i < 4; ++i) { v[2 * i] = bflo(ra[k][i]); v[2 * i + 1] = bfhi(ra[k][i]); v[8 + 2 * i] = bflo(rb[k][i]); v[8 + 2 * i + 1] = bfhi(rb[k][i]); }
            float mu, rs;
            if (HAVE_STAT) {
                const float s1 = (st[k][0][0] + st[k][0][2]) + (st[k][1][0] + st[k][1][2]);
                const float s2 = (st[k][0][1] + st[k][0][3]) + (st[k][1][1] + st[k][1][3]);
                mu = s1 * (1.f / DM);
                rs = rsqrtf(fmaxf(s2 * (1.f / DM) - mu * mu, 0.f) + LN_EPS);
            } else {
                float sm = 0.f;
#pragma unroll
                for (int i = 0; i < 16; ++i) sm += v[i];
                sm = wave_sum(sm);
                mu = sm * (1.f / DM);
                float q = 0.f;
#pragma unroll
                for (int i = 0; i < 16; ++i) { const float d = v[i] - mu; q += d * d; }
                q = wave_sum(q);
                rs = rsqrtf(q * (1.f / DM) + LN_EPS);
            }
            float o[16];
#pragma unroll
            for (int i = 0; i < 4; ++i)
#pragma unroll
                for (int c = 0; c < 4; ++c) o[4 * i + c] = (v[4 * i + c] - mu) * rs * gg[i][c] + bb[i][c];
            u32x4 w0, w1;
            w0.x = cvt_pk_bf16(o[0], o[1]); w0.y = cvt_pk_bf16(o[2], o[3]); w0.z = cvt_pk_bf16(o[4], o[5]); w0.w = cvt_pk_bf16(o[6], o[7]);
            w1.x = cvt_pk_bf16(o[8], o[9]); w1.y = cvt_pk_bf16(o[10], o[11]); w1.z = cvt_pk_bf16(o[12], o[13]); w1.w = cvt_pk_bf16(o[14], o[15]);
            if (!out_f32) { *(u32x4*)(hrow + lane * 8) = w0; *(u32x4*)(hrow + 512 + lane * 8) = w1; }
            if (FP8_IN || FP8_Q) { *(u32x2*)(hb8 + (size_t)r * DM + lane * 8) = cvt8_fp8(o, 1.f); *(u32x2*)(hb8 + (size_t)r * DM + 512 + lane * 8) = cvt8_fp8(o + 8, 1.f); }
            if (out_f32) {
                float* orow = out_f32 + (size_t)r * DM;
                *(f32x4*)(orow + lane * 8) = (f32x4){o[0], o[1], o[2], o[3]}; *(f32x4*)(orow + lane * 8 + 4) = (f32x4){o[4], o[5], o[6], o[7]};
                *(f32x4*)(orow + 512 + lane * 8) = (f32x4){o[8], o[9], o[10], o[11]}; *(f32x4*)(orow + 512 + lane * 8 + 4) = (f32x4){o[12], o[13], o[14], o[15]};
            }
        }
    }
}

__device__ void phase_prep(const Params& P, LAS unsigned char* lds) {
    unsigned char* ws = P.ws;
#ifdef TS_SUB
    if (obid() == 0 && otid() < 16) ((unsigned long long*)(ws + WS_CTL + 40960))[otid()] = 0ull;
#endif
    if (obid() == 0 && otid() < 2 * DEPTH) __hip_atomic_store((unsigned*)(ws + WS_CTL) + 64 * (1 + otid()), 0u, __ATOMIC_RELAXED, __HIP_MEMORY_SCOPE_AGENT);
    if (obid() == 0 && otid() < 32) __hip_atomic_store((unsigned*)(ws + WS_CTL) + ((otid() < 16) ? CTLW_QE1 : CTLW_QE3 - 16 * 64) + 64 * otid(), 0u, __ATOMIC_RELAXED, __HIP_MEMORY_SCOPE_AGENT);
    LAS float* s = (LAS float*)lds;
    const int n_win = 2 * 68 * 16, n_wout = 2 * 16 * 32, n_wq = 2 * 16 * 16, n_g = 2 * 8 * 2;
    const int total = n_win + n_wout + n_wq + n_g;
    for (int j = obid(); j < total; j += gridDim.x) {
        if (j < n_win) {
            const int l = j / (68 * 16), r = j % (68 * 16), nt = r / 16, kt = r % 16;
            const int n0 = nt * 64, c0 = n0 < 3584 ? n0 : n0 + 16;
            tr_tile(s, P.w_in + (size_t)l * 1024 * W_IN_LD, W_IN_LD, kt * 64, c0, (bf16_t*)(ws + WS_WIN) + (size_t)l * N_IN * 1024, 1024, n0, nullptr, FP8_IN ? ws + WS_WIN8 + (size_t)l * N_IN * 1024 : nullptr);
        } else if (j < n_win + n_wout) {
            const int jj = j - n_win, l = jj / (16 * 32), r = jj % (16 * 32), nt = r / 32, kt = r % 32;
            const int k0 = kt * 64;
            const float* sc = (k0 >= 512 && k0 < 1536) ? P.ssm_norm_g + l * 1024 + (k0 - 512) : nullptr;
            tr_tile(s, P.w_out + (size_t)l * MIXW * 1024, 1024, k0, nt * 64, (bf16_t*)(ws + WS_WOUT) + (size_t)l * 1024 * MIXW, MIXW, nt * 64, sc, FP8_OUT ? ws + WS_WOUT8 + (size_t)l * 1024 * MIXW : nullptr, 64.f);
        } else if (j < n_win + n_wout + n_wq) {
            const int jj = j - n_win - n_wout, l = jj / 256, r = jj % 256, nt = r / 16, kt = r % 16;
            tr_tile(s, P.peer_wq + (size_t)l * 1024 * 1024, 1024, kt * 64, nt * 64, (bf16_t*)(ws + WS_WQ) + (size_t)l * 1024 * 1024, 1024, nt * 64, nullptr, FP8_Q ? ws + WS_WQ8 + (size_t)l * 1024 * 1024 : nullptr);
        } else {
            const int jj = j - n_win - n_wout - n_wq, which = jj / 16, lb = jj % 16;
            const float* src = (which ? P.rg_wx : P.rg_wa) + (size_t)lb * 4096;
            bf16_t* dst = (bf16_t*)(ws + (which ? WS_WX : WS_WA)) + (size_t)lb * 4096;
            tr_tile(s, src, 64, 0, 0, dst, 64, 0, nullptr);
        }
    }
    for (int i = obid() * NTHREADS + otid(); i < 2 * 16 * 1024; i += gridDim.x * NTHREADS) {
        const int l = i >> 14, j = (i >> 10) & 15, k = i & 1023;
        ((bf16_t*)(ws + WS_WDT))[i] = f2bf(P.w_in[((size_t)l * 1024 + k) * W_IN_LD + C_DT + j]);
    }
    convert_rows(P.peer_keys, (bf16_t*)(ws + WS_KEYS), (size_t)2 * 2 * 128 * 64);
    {
        const int lane = otid() & 63, wid = otid() >> 6;
        constexpr int NRT = 4;
        for (int rq = (obid() * 8 + wid) * NRT; rq < 2 * 2 * 16384; rq += gridDim.x * 8 * NRT) {
            f32x4 vv[NRT][4];
#pragma unroll
            for (int k = 0; k < NRT; ++k) { const int r = rq + k, which = r >> 15, row = r & 32767;
                const float* src = (which ? P.peer_v : P.peer_u) + (size_t)row * DM + lane * 16;
#pragma unroll
                for (int i = 0; i < 4; ++i) vv[k][i] = *(const f32x4*)(src + 4 * i); }
#pragma unroll
            for (int k = 0; k < NRT; ++k) {
                const int r = rq + k, which = r >> 15, row = r & 32767;
                f32x4 v[4]; float amax = 0.f;
#pragma unroll
                for (int i = 0; i < 4; ++i) { v[i] = vv[k][i]; amax = fmaxf(amax, fmaxf(fmaxf(fabsf(v[i][0]), fabsf(v[i][1])), fmaxf(fabsf(v[i][2]), fabsf(v[i][3])))); }
#pragma unroll
                for (int o = 32; o > 0; o >>= 1) amax = fmaxf(amax, __shfl_xor(amax, o));
                const bf16_t scb = f2bf(amax * (1.f / 6.f));
                const float inv = amax > 0.f ? 1.f / bf2f(scb) : 0.f;
                u32x2 w;
#pragma unroll
                for (int i = 0; i < 2; ++i) { unsigned q = 0;
                    q = __builtin_amdgcn_cvt_scalef32_pk_fp4_f32(q, v[2 * i][0] * inv, v[2 * i][1] * inv, 1.0f, 0); q = __builtin_amdgcn_cvt_scalef32_pk_fp4_f32(q, v[2 * i][2] * inv, v[2 * i][3] * inv, 1.0f, 1);
                    q = __builtin_amdgcn_cvt_scalef32_pk_fp4_f32(q, v[2 * i + 1][0] * inv, v[2 * i + 1][1] * inv, 1.0f, 2); q = __builtin_amdgcn_cvt_scalef32_pk_fp4_f32(q, v[2 * i + 1][2] * inv, v[2 * i + 1][3] * inv, 1.0f, 3);
                    w[i] = q; }
                {   const int a0 = (lane & 15) * 16, i_ = a0 >> 6, ck_ = (a0 >> 3) & 7;
                    unsigned char* rowp = ws + (which ? WS_V8 : WS_U8) + (size_t)(row >> 14) * (16384 * 512) + (size_t)(lane >> 4) * (16384 * 128) + (size_t)(row & 16383) * 128;
                    if (which) *(u32x2*)(rowp + (lane & 15) * 8) = w;
                    else { *(unsigned*)(rowp + ck_ * 16 + i_ * 4) = w[0]; *(unsigned*)(rowp + (ck_ + 1) * 16 + i_ * 4) = w[1]; } }
                if (lane == 0) ((bf16_t*)(ws + WS_SU))[(size_t)row * 2 + which] = scb;
            }
        }
    }
    ln_rows_f32(P.x, (bf16_t*)(ws + WS_HB), ws + WS_MIX8, P.emb_g, P.emb_b);
}

__device__ void phase_dt(const Params& P, int layer, LAS unsigned char* lds) {
    const int tid = otid(), lane = tid & 63, wid = tid >> 6;
    const bf16_t* hb = (const bf16_t*)(P.ws + WS_HB);
    const bf16_t* wdt = (const bf16_t*)(P.ws + WS_WDT) + (size_t)layer * 16 * 1024;
    float* DT = (float*)(P.ws + WS_DT);
    const float bias = P.ssm_dt_bias[layer * 16 + (lane & 15)];
    constexpr int WP = 2064, AP = 144, PF = 4;
    LAS unsigned char* sW = lds;
    LAS unsigned char* sA = lds + 16 * WP + wid * (16 * AP);
    __syncthreads();
    for (int i = tid; i < 16 * 128; i += NTHREADS) { const int n = i >> 7, c = i & 127; *(LAS u32x4*)(sW + n * WP + c * 16) = *(const u32x4*)(wdt + (size_t)n * DM + c * 8); }
    __syncthreads();
    for (int task = obid() * 8 + wid; task < T_TOK / 16; task += gridDim.x * 8) {
        const int t0 = task * 16;
        f32x4 acc = {0.f, 0.f, 0.f, 0.f};
        const bf16_t* ap = hb + (size_t)(t0 + (lane >> 3)) * DM + (lane & 7) * 8;
        u32x4 ra[PF][2];
#pragma unroll
        for (int q = 0; q < PF; ++q) { ra[q][0] = *(const u32x4*)(ap + q * 64); ra[q][1] = *(const u32x4*)(ap + (size_t)8 * DM + q * 64); }
#pragma unroll
        for (int st = 0; st < 16; ++st) {
            const u32x4 c0 = ra[st % PF][0], c1 = ra[st % PF][1];
            if (st + PF < 16) { ra[st % PF][0] = *(const u32x4*)(ap + (st + PF) * 64); ra[st % PF][1] = *(const u32x4*)(ap + (size_t)8 * DM + (st + PF) * 64); }
            *(LAS u32x4*)(sA + (lane >> 3) * AP + (lane & 7) * 16) = c0; *(LAS u32x4*)(sA + ((lane >> 3) + 8) * AP + (lane & 7) * 16) = c1;
            const LAS unsigned char* fa = sA + (lane & 15) * AP + (lane >> 4) * 16;
            const LAS unsigned char* fb = sW + (lane & 15) * WP + st * 128 + (lane >> 4) * 16;
            const bf16x8 a0 = *(const LAS bf16x8*)fa, a1 = *(const LAS bf16x8*)(fa + 64), b0 = *(const LAS bf16x8*)fb, b1 = *(const LAS bf16x8*)(fb + 64);
            acc = MFMA16(a0, b0, acc); acc = MFMA16(a1, b1, acc);
        }
#pragma unroll
        for (int j = 0; j < 4; ++j) DT[(size_t)(t0 + (lane >> 4) * 4 + j) * 16 + (lane & 15)] = softplusf_(acc[j] + bias);
    }
    __syncthreads();
}

constexpr int CTLW_CONV = 4608;
__device__ void phase_conv(const Params& P, int layer, LAS unsigned char* lds) {
    const int tid = otid();
    bf16_t* proj = (bf16_t*)(P.ws + WS_PROJ);
    for (int tile = obid(); tile < 256; tile += gridDim.x) {
        const int half = tile < 128 ? 1 : 0, b = (tile & 127) >> 3, slab = tile & 7;
        unsigned* flag = (unsigned*)(P.ws + WS_CTL) + CTLW_CONV + layer * 128 + (tile & 127);
        const int cg = tid & 7, chx = 1024 + slab * 64 + cg * 8;
        float cw[4][8], cb[8];
#pragma unroll
        for (int j = 0; j < 8; ++j) {
            cb[j] = P.ssm_conv_b[layer * 1536 + chx + j];
#pragma unroll
            for (int i = 0; i < 4; ++i) cw[i][j] = P.ssm_conv_w[(layer * 4 + i) * 1536 + chx + j];
        }
        bf16_t* base = proj + ((size_t)b * SEQ + half * 2048) * PROJ_LD + C_XBC + chx;
        const int r0 = tid >> 3;
        u32x4 raw[4], rawn[4];
#define CONV_LOAD(dst, c) do { _Pragma("unroll") for (int it = 0; it < 4; ++it) dst[it] = *(const u32x4*)(base + (size_t)((c) * 256 + r0 + it * 64) * PROJ_LD); } while (0)
        CONV_LOAD(raw, 0); CONV_LOAD(rawn, 1);
        if (tid < 24) { u32x4 h = {0u, 0u, 0u, 0u}; if (half) h = *(const u32x4*)(base - (size_t)(3 - r0) * PROJ_LD); *(LAS u32x4*)(lds + 2 * (256 * 128) + (253 + r0) * 128 + cg * 16) = h; }
        if (half) { __syncthreads(); if (tid == 0) __hip_atomic_store(flag, 1u, __ATOMIC_RELEASE, __HIP_MEMORY_SCOPE_AGENT); }
        for (int c = 0; c < 8; ++c) {
            LAS unsigned char* img = lds + (c % 3) * (256 * 128), *prv = lds + ((c + 2) % 3) * (256 * 128);
#pragma unroll
            for (int it = 0; it < 4; ++it) *(LAS u32x4*)(img + (r0 + it * 64) * 128 + cg * 16) = raw[it];
            if (c == 7 && !half) { if (tid == 0) { while (__hip_atomic_load(flag, __ATOMIC_ACQUIRE, __HIP_MEMORY_SCOPE_AGENT) == 0u) __builtin_amdgcn_s_sleep(4); } }
            __syncthreads();
#pragma unroll
            for (int it = 0; it < 4; ++it) raw[it] = rawn[it];
            if (c < 6) CONV_LOAD(rawn, c + 2);
#pragma unroll
            for (int it = 0; it < 4; ++it) {
                float v[8];
#pragma unroll
                for (int j = 0; j < 8; ++j) v[j] = cb[j];
#pragma unroll
                for (int i = 0; i < 4; ++i) {
                    const int rr = r0 + it * 64 - 3 + i;
                    const u32x4 w = (it > 0 || rr >= 0) ? *(const LAS u32x4*)(img + rr * 128 + cg * 16) : *(const LAS u32x4*)(prv + (256 + rr) * 128 + cg * 16);
                    v[0] += cw[i][0] * bflo(w.x); v[1] += cw[i][1] * bfhi(w.x); v[2] += cw[i][2] * bflo(w.y); v[3] += cw[i][3] * bfhi(w.y);
                    v[4] += cw[i][4] * bflo(w.z); v[5] += cw[i][5] * bfhi(w.z); v[6] += cw[i][6] * bflo(w.w); v[7] += cw[i][7] * bfhi(w.w);
                }
#pragma unroll
                for (int j = 0; j < 8; ++j) v[j] = siluf_(v[j]);
                u32x4 res;
                res.x = cvt_pk_bf16(v[0], v[1]); res.y = cvt_pk_bf16(v[2], v[3]); res.z = cvt_pk_bf16(v[4], v[5]); res.w = cvt_pk_bf16(v[6], v[7]);
                *(u32x4*)(base + (size_t)(c * 256 + r0 + it * 64) * PROJ_LD) = res;
            }
        }
#undef CONV_LOAD
        __syncthreads();
    }
}

typedef short v4i16_t __attribute__((ext_vector_type(4)));
__device__ __forceinline__ bf16x8 tr_frag(const LAS bf16_t* base, int stride, int kbase, int n0, int fr, int fq) {
    const LAS bf16_t* p = base + (kbase + fq * 8 + (fr >> 2)) * stride + n0 + (fr & 3) * 4;
    const v4i16_t lo = __builtin_amdgcn_ds_read_tr16_b64_v4i16((LAS v4i16_t*)p);
    const v4i16_t hi = __builtin_amdgcn_ds_read_tr16_b64_v4i16((LAS v4i16_t*)(p + 4 * stride));
    return (bf16x8){lo[0], lo[1], lo[2], lo[3], hi[0], hi[1], hi[2], hi[3]};
}

__device__ void ssd_tile(const Params& P, int layer, int b, int h, LAS unsigned char* lds) {
    const int tid = otid(), lane = tid & 63, wid = tid >> 6, fr = lane & 15, fq = lane >> 4;
    bf16_t* proj = (bf16_t*)(P.ws + WS_PROJ);
    const float* DT = (const float*)(P.ws + WS_DT);
    float* SSQ = (float*)(P.ws + WS_SSQ);
    const int g = h >> 3;
    LAS bf16_t* sC = (LAS bf16_t*)lds;
    LAS bf16_t* sB = sC + 64 * 136;
    LAS bf16_t* sS = sB + 64 * 136;
    LAS bf16_t* sXH = sS + 64 * 136;
    LAS bf16_t* sXD = sXH + 64 * 72;
    LAS bf16_t* sM = sXD + 64 * 72;
    LAS float* sY = (LAS float*)(sM + 64 * 72);
    LAS float* sAcs = sY + 64 * 68;
    LAS float* sDt = sAcs + 128;
    LAS bf16_t* sXR = (LAS bf16_t*)(sDt + 128);
    LAS bf16_t* sXHalo = sXR + 64 * 72;
    const float a_h = -__expf(P.ssm_a_log[layer * 16 + h]);
    const float d_h = P.ssm_d[layer * 16 + h];
    int goff[5], loff[5];
#pragma unroll
    for (int it = 0; it < 5; ++it) {
        const int i = it * NTHREADS + tid, row = i / 40, c2 = i % 40;
        int ch, lo;
        if (c2 < 8) { ch = h * 64 + c2 * 8; lo = (int)(sXR - sC) + row * 72 + c2 * 8; }
        else if (c2 < 24) { ch = 1024 + g * 128 + (c2 - 8) * 8; lo = (int)(sB - sC) + row * 136 + (c2 - 8) * 8; }
        else { ch = 1280 + g * 128 + (c2 - 24) * 8; lo = row * 136 + (c2 - 24) * 8; }
        goff[it] = row * PROJ_LD + C_XBC + ch; loff[it] = lo;
    }
    const bf16_t* pbase = proj + (size_t)b * SEQ * PROJ_LD;
    float cw[4][8], cb[8];
#pragma unroll
    for (int j = 0; j < 8; ++j) {
        const int ch = h * 64 + (tid & 7) * 8 + j;
        cb[j] = P.ssm_conv_b[layer * 1536 + ch];
#pragma unroll
        for (int i = 0; i < 4; ++i) cw[i][j] = P.ssm_conv_w[(layer * 4 + i) * 1536 + ch];
    }
    for (int i = tid; i < 3 * 72 / 2; i += NTHREADS) ((LAS unsigned*)(sXHalo + 3 * 72))[i] = 0u;
    for (int i = tid; i < 64 * 136 / 2; i += NTHREADS) ((LAS unsigned*)sS)[i] = 0u;
    f32x4 accS[4];
#pragma unroll
    for (int q = 0; q < 4; ++q) accS[q] = (f32x4){0.f, 0.f, 0.f, 0.f};
    u32x4 raw[5];
#pragma unroll
    for (int it = 0; it < 5; ++it) raw[it] = *(const u32x4*)(pbase + goff[it]);
    float dtn = 0.f, dtc = 0.f;
    if (wid == 0) { dtc = DT[(size_t)(b * SEQ + lane) * 16 + h]; dtn = DT[(size_t)(b * SEQ + 64 + lane) * 16 + h]; }
#pragma unroll
    for (int it = 0; it < 5; ++it) {
        *(LAS u32x4*)(sC + loff[it]) = raw[it];
        const int i_ = it * NTHREADS + tid, row_ = i_ / 40, c2_ = i_ % 40;
        if (c2_ < 8 && row_ >= 61) *(LAS u32x4*)(sXHalo + (row_ - 61) * 72 + c2_ * 8) = raw[it];
    }
    if (wid == 0) {
        float v = dtc * a_h;
#pragma unroll
        for (int o = 1; o < 64; o <<= 1) { const float n = __shfl_up(v, o); if (lane >= o) v += n; }
        sDt[lane] = dtc; sAcs[lane] = v;
    }
    __syncthreads();
    const int dl = tid >> 3, dp8 = (tid & 7) * 8;
    for (int c = 0; c < 64; ++c) {
        const int t0 = b * SEQ + c * 64;
        if (c + 1 < 64) {
            const bf16_t* nb = pbase + (size_t)(c + 1) * 64 * PROJ_LD;
#pragma unroll
            for (int it = 0; it < 5; ++it) raw[it] = *(const u32x4*)(nb + goff[it]);
            if (wid == 0) {
                float v = dtn * a_h;
#pragma unroll
                for (int o = 1; o < 64; o <<= 1) { const float n = __shfl_up(v, o); if (lane >= o) v += n; }
                sDt[((c + 1) & 1) * 64 + lane] = dtn; sAcs[((c + 1) & 1) * 64 + lane] = v;
                if (c + 2 < 64) dtn = DT[(size_t)(t0 + 128 + lane) * 16 + h];
            }
        }
        const LAS float* cAcs = sAcs + (c & 1) * 64; const LAS float* cDt = sDt + (c & 1) * 64;
        const size_t ga = (size_t)(t0 + dl) * PROJ_LD + C_Z + h * 64 + dp8;
        const u32x4 zw = *(const u32x4*)(proj + ga);
        {
            const LAS bf16_t* halo = sXHalo + ((c + 1) & 1) * (3 * 72);
            float v[8];
#pragma unroll
            for (int j = 0; j < 8; ++j) v[j] = cb[j];
#pragma unroll
            for (int i = 0; i < 4; ++i) {
                const int r = dl - 3 + i;
                const u32x4 w = (r >= 0) ? *(const LAS u32x4*)(sXR + r * 72 + dp8) : *(const LAS u32x4*)(halo + (r + 3) * 72 + dp8);
                v[0] += cw[i][0] * bflo(w.x); v[1] += cw[i][1] * bfhi(w.x); v[2] += cw[i][2] * bflo(w.y); v[3] += cw[i][3] * bfhi(w.y);
                v[4] += cw[i][4] * bflo(w.z); v[5] += cw[i][5] * bfhi(w.z); v[6] += cw[i][6] * bflo(w.w); v[7] += cw[i][7] * bfhi(w.w);
            }
#pragma unroll
            for (int j = 0; j < 8; ++j) v[j] = siluf_(v[j]);
            const float dd = cDt[dl] * __expf(cAcs[63] - cAcs[dl]);
            u32x4 o1; o1.x = cvt_pk_bf16(v[0], v[1]); o1.y = cvt_pk_bf16(v[2], v[3]); o1.z = cvt_pk_bf16(v[4], v[5]); o1.w = cvt_pk_bf16(v[6], v[7]);
            u32x4 o3; o3.x = cvt_pk_bf16(v[0] * dd, v[1] * dd); o3.y = cvt_pk_bf16(v[2] * dd, v[3] * dd); o3.z = cvt_pk_bf16(v[4] * dd, v[5] * dd); o3.w = cvt_pk_bf16(v[6] * dd, v[7] * dd);
            *(LAS u32x4*)(sXH + dl * 72 + dp8) = o1;
            *(LAS u32x4*)(sXD + dl * 72 + dp8) = o3;
        }
        const int lt = wid >> 1, ph = wid & 1;
        f32x4 accY[2];
        {
            bf16x8 aC[4];
#pragma unroll
            for (int ks = 0; ks < 4; ++ks) aC[ks] = *(const LAS bf16x8*)(sC + (lt * 16 + fr) * 136 + ks * 32 + fq * 8);
            const int lrow = lt * 16 + fr;
            const float acs_l = cAcs[lrow];
#pragma unroll
            for (int tt = 0; tt < 2; ++tt) {
                const int st = ph * 2 + tt;
                f32x4 accG = {0.f, 0.f, 0.f, 0.f};
#pragma unroll
                for (int ks = 0; ks < 4; ++ks) { const bf16x8 bb = *(const LAS bf16x8*)(sB + (st * 16 + fr) * 136 + ks * 32 + fq * 8); accG = MFMA16(bb, aC[ks], accG); }
                const f32x4 acs_s = *(const LAS f32x4*)(cAcs + st * 16 + fq * 4), dt_s = *(const LAS f32x4*)(cDt + st * 16 + fq * 4);
                float val[4];
#pragma unroll
                for (int j = 0; j < 4; ++j) { const int s_idx = st * 16 + fq * 4 + j; val[j] = (s_idx <= lrow) ? accG[j] * __expf(acs_l - acs_s[j]) * dt_s[j] : 0.f; }
                u32x2 wm; wm.x = cvt_pk_bf16(val[0], val[1]); wm.y = cvt_pk_bf16(val[2], val[3]);
                *(LAS u32x2*)(sM + lrow * 72 + st * 16 + fq * 4) = wm;
            }
            const float eal = __expf(acs_l);
#pragma unroll
            for (int tt = 0; tt < 2; ++tt) {
                const int pt = ph * 2 + tt;
                f32x4 a = {0.f, 0.f, 0.f, 0.f};
#pragma unroll
                for (int ks = 0; ks < 4; ++ks) { const bf16x8 bb = *(const LAS bf16x8*)(sS + (pt * 16 + fr) * 136 + ks * 32 + fq * 8); a = MFMA16(bb, aC[ks], a); }
                accY[tt] = a * eal;
            }
        }
        __syncthreads();
        {
            const int lrow = lt * 16 + fr;
#pragma unroll
            for (int tt = 0; tt < 2; ++tt) {
                const int pt = ph * 2 + tt;
#pragma unroll
                for (int ks = 0; ks < 2; ++ks) {
                    const bf16x8 am = *(const LAS bf16x8*)(sM + lrow * 72 + ks * 32 + fq * 8);
                    const bf16x8 bx = tr_frag(sXH, 72, ks * 32, pt * 16, fr, fq);
                    accY[tt] = MFMA16(bx, am, accY[tt]);
                }
                *(LAS f32x4*)(sY + lrow * 68 + pt * 16 + fq * 4) = accY[tt];
            }
            const float dec = __expf(cAcs[63]);
            const int pt2 = wid >> 1;
            bf16x8 ax[2];
#pragma unroll
            for (int ks = 0; ks < 2; ++ks) ax[ks] = tr_frag(sXD, 72, ks * 32, pt2 * 16, fr, fq);
#pragma unroll
            for (int q = 0; q < 4; ++q) {
                const int nt = ph * 4 + q;
                f32x4 a = accS[q] * dec;
#pragma unroll
                for (int ks = 0; ks < 2; ++ks) { const bf16x8 bb = tr_frag(sB, 136, ks * 32, nt * 16, fr, fq); a = MFMA16(bb, ax[ks], a); }
                accS[q] = a;
                u32x2 ws_; ws_.x = cvt_pk_bf16(a[0], a[1]); ws_.y = cvt_pk_bf16(a[2], a[3]);
                *(LAS u32x2*)(sS + (pt2 * 16 + fr) * 136 + nt * 16 + fq * 4) = ws_;
            }
        }
        __syncthreads();
        {
            const u32x4 xw = *(const LAS u32x4*)(sXH + dl * 72 + dp8);
            const f32x4 y0 = *(const LAS f32x4*)(sY + dl * 68 + dp8), y1 = *(const LAS f32x4*)(sY + dl * 68 + dp8 + 4);
            float y[8];
            y[0] = (y0[0] + d_h * bflo(xw.x)) * siluf_(bflo(zw.x)); y[1] = (y0[1] + d_h * bfhi(xw.x)) * siluf_(bfhi(zw.x));
            y[2] = (y0[2] + d_h * bflo(xw.y)) * siluf_(bflo(zw.y)); y[3] = (y0[3] + d_h * bfhi(xw.y)) * siluf_(bfhi(zw.y));
            y[4] = (y1[0] + d_h * bflo(xw.z)) * siluf_(bflo(zw.z)); y[5] = (y1[1] + d_h * bfhi(xw.z)) * siluf_(bfhi(zw.z));
            y[6] = (y1[2] + d_h * bflo(xw.w)) * siluf_(bflo(zw.w)); y[7] = (y1[3] + d_h * bfhi(xw.w)) * siluf_(bfhi(zw.w));
            float q = 0.f;
#pragma unroll
            for (int j = 0; j < 8; ++j) q += y[j] * y[j];
            q += dpp_<0xB1>(q); q += dpp_<0x4E>(q); q += dpp_<0x141>(q);
            if ((tid & 7) == 0) SSQ[(size_t)(t0 + dl) * 16 + h] = q;
            u32x4 o; o.x = cvt_pk_bf16(y[0], y[1]); o.y = cvt_pk_bf16(y[2], y[3]); o.z = cvt_pk_bf16(y[4], y[5]); o.w = cvt_pk_bf16(y[6], y[7]);
            *(u32x4*)(proj + ga) = o;
        }
        if (c + 1 < 64) {
#pragma unroll
            for (int it = 0; it < 5; ++it) {
                *(LAS u32x4*)(sC + loff[it]) = raw[it];
                const int i_ = it * NTHREADS + tid, row_ = i_ / 40, c2_ = i_ % 40;
                if (c2_ < 8 && row_ >= 61) *(LAS u32x4*)(sXHalo + ((c + 1) & 1) * (3 * 72) + (row_ - 61) * 72 + c2_ * 8) = raw[it];
            }
        }
        __syncthreads();
    }
}

__device__ void rglru_tile(const Params& P, int layer, int b, int n, LAS unsigned char* lds) {
    const int tid = otid(), lane = tid & 63, wid = tid >> 6, fr = lane & 15, fq = lane >> 4;
    bf16_t* proj = (bf16_t*)(P.ws + WS_PROJ);
    LAS bf16_t* sXC = (LAS bf16_t*)lds;
    LAS bf16_t* sWa = sXC + 64 * 72;
    LAS bf16_t* sWx = sWa + 64 * 72;
    LAS float* sA = (LAS float*)(sWx + 64 * 72);
    LAS float* sU = sA + 64 * 64;
    LAS float* sPs = sU + 64 * 64;
    LAS float* sHs = sPs + 8 * 64;
    LAS float* sCar = sHs + 8 * 64;
    LAS bf16_t* sR = (LAS bf16_t*)(sCar + 64);
    LAS bf16_t* sRHalo = sR + 64 * 72;
    {
        const int d = tid >> 3, c8 = (tid & 7) * 8;
        const bf16_t* wa = (const bf16_t*)(P.ws + WS_WA) + (size_t)(layer * 8 + n) * 4096;
        const bf16_t* wx = (const bf16_t*)(P.ws + WS_WX) + (size_t)(layer * 8 + n) * 4096;
        *(LAS u32x4*)(sWa + d * 72 + c8) = *(const u32x4*)(wa + d * 64 + c8);
        *(LAS u32x4*)(sWx + d * 72 + c8) = *(const u32x4*)(wx + d * 64 + c8);
    }
    if (tid < 64) sCar[tid] = 0.f;
    for (int i = tid; i < 3 * 72 / 2; i += NTHREADS) ((LAS unsigned*)(sRHalo + 3 * 72))[i] = 0u;
    const int cg = tid & 7, crow = tid >> 3, ch0 = n * 64 + cg * 8;
    float cw[4][8], cb[8];
#pragma unroll
    for (int j = 0; j < 8; ++j) {
        cb[j] = P.rg_conv_b[layer * 512 + ch0 + j];
#pragma unroll
        for (int i = 0; i < 4; ++i) cw[i][j] = P.rg_conv_w[(layer * 4 + i) * 512 + ch0 + j];
    }
    const int tt = wid & 3, dpair = wid >> 2;
    float ba[2], bx[2], sp[2];
#pragma unroll
    for (int dd = 0; dd < 2; ++dd) {
        const int ch = layer * 512 + n * 64 + (dpair * 2 + dd) * 16 + fr;
        ba[dd] = P.rg_ba[ch]; bx[dd] = P.rg_bx[ch]; sp[dd] = softplusf_(-P.rg_lambda[ch]);
    }
    const int sc = tid & 63, seg = wid;
    const bf16_t* pbase = proj + (size_t)b * SEQ * PROJ_LD;
    const int goff = crow * PROJ_LD + C_RGX + ch0;
#define RG_CONV(cc) do { const LAS bf16_t* halo_ = sRHalo + (((cc) + 1) & 1) * (3 * 72); float v_[8]; \
        _Pragma("unroll") for (int j_ = 0; j_ < 8; ++j_) v_[j_] = cb[j_]; \
        _Pragma("unroll") for (int i_ = 0; i_ < 4; ++i_) { const int r_ = crow - 3 + i_; \
            const u32x4 w_ = (r_ >= 0) ? *(const LAS u32x4*)(sR + r_ * 72 + cg * 8) : *(const LAS u32x4*)(halo_ + (r_ + 3) * 72 + cg * 8); \
            v_[0] += cw[i_][0] * bflo(w_.x); v_[1] += cw[i_][1] * bfhi(w_.x); v_[2] += cw[i_][2] * bflo(w_.y); v_[3] += cw[i_][3] * bfhi(w_.y); \
            v_[4] += cw[i_][4] * bflo(w_.z); v_[5] += cw[i_][5] * bfhi(w_.z); v_[6] += cw[i_][6] * bflo(w_.w); v_[7] += cw[i_][7] * bfhi(w_.w); } \
        u32x4 o_; o_.x = cvt_pk_bf16(v_[0], v_[1]); o_.y = cvt_pk_bf16(v_[2], v_[3]); o_.z = cvt_pk_bf16(v_[4], v_[5]); o_.w = cvt_pk_bf16(v_[6], v_[7]); \
        *(LAS u32x4*)(sXC + crow * 72 + cg * 8) = o_; } while (0)
    u32x4 raw = *(const u32x4*)(pbase + goff);
    *(LAS u32x4*)(sR + crow * 72 + cg * 8) = raw;
    if (crow >= 61) *(LAS u32x4*)(sRHalo + (crow - 61) * 72 + cg * 8) = raw;
    __syncthreads();
    RG_CONV(0);
    __syncthreads();
    for (int c = 0; c < 64; ++c) {
        const int t0 = b * SEQ + c * 64;
        if (c + 1 < 64) raw = *(const u32x4*)(pbase + (size_t)(c + 1) * 64 * PROJ_LD + goff);
        const size_t ga = (size_t)(t0 + crow) * PROJ_LD + C_GATE + ch0;
        const u32x4 gw = *(const u32x4*)(proj + ga);
        {
            bf16x8 ax[2];
#pragma unroll
            for (int ks = 0; ks < 2; ++ks) ax[ks] = *(const LAS bf16x8*)(sXC + (tt * 16 + fr) * 72 + ks * 32 + fq * 8);
#pragma unroll
            for (int dd = 0; dd < 2; ++dd) {
                const int dt_ = dpair * 2 + dd;
                f32x4 accA = {0.f, 0.f, 0.f, 0.f}, accX = {0.f, 0.f, 0.f, 0.f};
#pragma unroll
                for (int ks = 0; ks < 2; ++ks) {
                    const bf16x8 wa = *(const LAS bf16x8*)(sWa + (dt_ * 16 + fr) * 72 + ks * 32 + fq * 8);
                    const bf16x8 wx = *(const LAS bf16x8*)(sWx + (dt_ * 16 + fr) * 72 + ks * 32 + fq * 8);
                    accA = MFMA16(ax[ks], wa, accA); accX = MFMA16(ax[ks], wx, accX);
                }
#pragma unroll
                for (int j = 0; j < 4; ++j) {
                    const int t = tt * 16 + fq * 4 + j, d = dt_ * 16 + fr;
                    const float r = sigmoidf_(accA[j] + ba[dd]), ig = sigmoidf_(accX[j] + bx[dd]);
                    const float a = __expf(-8.f * r * sp[dd]);
                    const float mult = __builtin_amdgcn_sqrtf(fmaxf(1.f - a * a, 0.f));
                    sA[t * 64 + d] = a;
                    sU[t * 64 + d] = mult * ig * bf2f(sXC[t * 72 + d]);
                }
            }
        }
        __syncthreads();
        float av_[8], uv_[8];
        {
            float Pl = 1.f, Hl = 0.f;
#pragma unroll
            for (int i = 0; i < 8; ++i) { av_[i] = sA[(seg * 8 + i) * 64 + sc]; uv_[i] = sU[(seg * 8 + i) * 64 + sc]; }
#pragma unroll
            for (int i = 0; i < 8; ++i) { Hl = av_[i] * Hl + uv_[i]; Pl *= av_[i]; }
            sPs[seg * 64 + sc] = Pl; sHs[seg * 64 + sc] = Hl;
        }
        __syncthreads();
        float H = sCar[sc];
        {
            float ps_[7], hs_[7];
#pragma unroll
            for (int s2 = 0; s2 < 7; ++s2) { ps_[s2] = sPs[s2 * 64 + sc]; hs_[s2] = sHs[s2 * 64 + sc]; }
#pragma unroll
            for (int s2 = 0; s2 < 7; ++s2) if (s2 < seg) H = ps_[s2] * H + hs_[s2];
        }
#pragma unroll
        for (int i = 0; i < 8; ++i) { H = av_[i] * H + uv_[i]; sU[(seg * 8 + i) * 64 + sc] = H; }
        __syncthreads();
        if (seg == 7) sCar[sc] = H;
        {
            const f32x4 h0 = *(const LAS f32x4*)(sU + crow * 64 + cg * 8), h1 = *(const LAS f32x4*)(sU + crow * 64 + cg * 8 + 4);
            u32x4 o;
            o.x = cvt_pk_bf16(gelu_tanhf_(bflo(gw.x)) * h0[0], gelu_tanhf_(bfhi(gw.x)) * h0[1]);
            o.y = cvt_pk_bf16(gelu_tanhf_(bflo(gw.y)) * h0[2], gelu_tanhf_(bfhi(gw.y)) * h0[3]);
            o.z = cvt_pk_bf16(gelu_tanhf_(bflo(gw.z)) * h1[0], gelu_tanhf_(bfhi(gw.z)) * h1[1]);
            o.w = cvt_pk_bf16(gelu_tanhf_(bflo(gw.w)) * h1[2], gelu_tanhf_(bfhi(gw.w)) * h1[3]);
            if (FP8_OUT) {
                float yv[8] = {bflo(o.x), bfhi(o.x), bflo(o.y), bfhi(o.y), bflo(o.z), bfhi(o.z), bflo(o.w), bfhi(o.w)};
                *(u32x2*)(P.ws + WS_MIX8 + (size_t)(t0 + crow) * MIXW + ch0) = cvt8_fp8(yv, 1.f);
            } else *(u32x4*)(proj + ga) = o;
        }
        if (c + 1 < 64) {
            *(LAS u32x4*)(sR + crow * 72 + cg * 8) = raw;
            if (crow >= 61) *(LAS u32x4*)(sRHalo + ((c + 1) & 1) * (3 * 72) + (crow - 61) * 72 + cg * 8) = raw;
        }
        __syncthreads();
        if (c + 1 < 64) RG_CONV(c + 1);
        __syncthreads();
    }
#undef RG_CONV
}

__device__ void attn_tile(const Params& P, int layer, int b, int qb, int kvh, LAS unsigned char* lds) {
    const int tid = otid(), lane = tid & 63, wid = tid >> 6, fr = lane & 15, fq = lane >> 4;
    bf16_t* proj = (bf16_t*)(P.ws + WS_PROJ);
    LAS bf16_t* sK = (LAS bf16_t*)lds;
    LAS bf16_t* sV = sK + 256 * 72;
    LAS bf16_t* sP = sV + 280 * 72 + wid * (16 * 168);
    const int tb = b * SEQ + qb * 128;
#pragma unroll
    for (int it = 0; it < 4; ++it) {
        const int idx = it * NTHREADS + tid;
        { const int kk = idx >> 3, dg = idx & 7;
          u32x4 v = {0u, 0u, 0u, 0u};
          if (qb > 0 || kk >= 128) v = *(const u32x4*)(proj + (size_t)(tb - 128 + kk) * PROJ_LD + C_K + kvh * 64 + dg * 8);
          *(LAS u32x4*)(sK + kk * 72 + dg * 8) = v; }
        { const int kk = idx >> 3, dg = idx & 7;
          u32x4 v = {0u, 0u, 0u, 0u};
          if (qb > 0 || kk >= 128) v = *(const u32x4*)(proj + (size_t)(tb - 128 + kk) * PROJ_LD + C_V + kvh * 64 + dg * 8);
          *(LAS u32x4*)(sV + kk * 72 + dg * 8) = v; }
    }
    if (tid < 216) *(LAS u32x4*)(sV + 256 * 72 + tid * 8) = (u32x4){0u, 0u, 0u, 0u};
    __syncthreads();
    const int q0 = wid * 16;
    for (int r = 0; r < 4; ++r) {
        const int hq = kvh * 4 + r;
        const float sink = P.attn_sinks[layer * 8 + hq];
        bf16x8 qf[2];
#pragma unroll
        for (int ks = 0; ks < 2; ++ks) qf[ks] = *(const bf16x8*)(proj + (size_t)(tb + q0 + fr) * PROJ_LD + C_Q + hq * 64 + ks * 32 + fq * 8);
        f32x4 S[9];
        __builtin_amdgcn_s_setprio(1);
#pragma unroll
        for (int kt = 0; kt < 9; ++kt) {
            f32x4 a = {0.f, 0.f, 0.f, 0.f};
#pragma unroll
            for (int ks = 0; ks < 2; ++ks) { const bf16x8 kf = *(const LAS bf16x8*)(sK + ((wid + kt) * 16 + fr) * 72 + ks * 32 + fq * 8); a = MFMA16(kf, qf[ks], a); }
            S[kt] = a;
        }
        __builtin_amdgcn_s_setprio(0);
        const int qi = q0 + fr;
        float mxl = -INFINITY;
#pragma unroll
        for (int kt = 0; kt < 9; ++kt)
#pragma unroll
            for (int j = 0; j < 4; ++j) {
                const int kk = (wid + kt) * 16 + fq * 4 + j, kj = kk - 128;
                const bool valid = (kj <= qi) && (kj > qi - 128) && (qb > 0 || kk >= 128);
                const float sv = valid ? S[kt][j] * 0.125f : -INFINITY;
                S[kt][j] = sv; mxl = fmaxf(mxl, sv);
            }
        mxl = fmaxf(mxl, __shfl_xor(mxl, 16)); mxl = fmaxf(mxl, __shfl_xor(mxl, 32));
        const float mxv = fmaxf(mxl, sink);
        float sml = 0.f;
#pragma unroll
        for (int kt = 0; kt < 9; ++kt)
#pragma unroll
            for (int j = 0; j < 4; ++j) { const float pe = __expf(S[kt][j] - mxv); S[kt][j] = pe; sml += pe; }
        sml += __shfl_xor(sml, 16); sml += __shfl_xor(sml, 32);
        const float pinv = __builtin_amdgcn_rcpf(sml + __expf(sink - mxv));
#pragma unroll
        for (int kt = 0; kt < 9; ++kt) {
            u32x2 wp; wp.x = cvt_pk_bf16(S[kt][0] * pinv, S[kt][1] * pinv); wp.y = cvt_pk_bf16(S[kt][2] * pinv, S[kt][3] * pinv);
            *(LAS u32x2*)(sP + fr * 168 + kt * 16 + fq * 4) = wp;
        }
        *(LAS u32x2*)(sP + fr * 168 + 144 + fq * 4) = (u32x2){0u, 0u};
        f32x4 O[4];
#pragma unroll
        for (int dt_ = 0; dt_ < 4; ++dt_) O[dt_] = (f32x4){0.f, 0.f, 0.f, 0.f};
        __builtin_amdgcn_s_setprio(1);
#pragma unroll
        for (int ks = 0; ks < 5; ++ks) {
            const bf16x8 pa = *(const LAS bf16x8*)(sP + fr * 168 + ks * 32 + fq * 8);
#pragma unroll
            for (int dt_ = 0; dt_ < 4; ++dt_) { const bf16x8 vb = tr_frag(sV, 72, wid * 16 + ks * 32, dt_ * 16, fr, fq); O[dt_] = MFMA16(vb, pa, O[dt_]); }
        }
        __builtin_amdgcn_s_setprio(0);
        if (FP8_OUT) {
            LAS unsigned char* sO = (LAS unsigned char*)sP;
#pragma unroll
            for (int dt_ = 0; dt_ < 4; ++dt_) {
                int d8 = __builtin_amdgcn_cvt_pk_fp8_f32(O[dt_][0], O[dt_][1], 0, false); d8 = __builtin_amdgcn_cvt_pk_fp8_f32(O[dt_][2], O[dt_][3], d8, true);
                *(LAS int*)(sO + fr * 80 + dt_ * 16 + fq * 4) = d8;
            }
            const int orow = lane >> 2, och = lane & 3;
            const u32x4 ov = *(const LAS u32x4*)(sO + orow * 80 + och * 16);
            *(u32x4*)(P.ws + WS_MIX8 + (size_t)(tb + q0 + orow) * MIXW + 1536 + hq * 64 + och * 16) = ov;
        } else {
#pragma unroll
            for (int dt_ = 0; dt_ < 4; ++dt_) { u32x2 wo; wo.x = cvt_pk_bf16(O[dt_][0], O[dt_][1]); wo.y = cvt_pk_bf16(O[dt_][2], O[dt_][3]);
                *(u32x2*)(proj + (size_t)(tb + q0 + fr) * PROJ_LD + C_Q + hq * 64 + dt_ * 16 + fq * 4) = wo; }
        }
    }
    __syncthreads();
}

__device__ void phase_mixers(const Params& P, int layer, LAS unsigned char* lds) {
    unsigned* ctr = (unsigned*)(P.ws + WS_CTL) + 64 * (1 + layer);
    LAS int* sTile = (LAS int*)(lds + LDS_BYTES - 16);
    for (;;) {
        if (otid() == 0) *sTile = (int)atomicAdd(ctr, 1u);
        __syncthreads();
        const int tile = *sTile;
        __syncthreads();
        if (tile >= 256 + 128 + 1024) break;
#ifdef TS_SUB
        const unsigned long long tq0 = __builtin_amdgcn_s_memrealtime();
#endif
        if (tile < 256) { if (MIX_MASK & 1) ssd_tile(P, layer, tile >> 4, tile & 15, lds); }
        else if (tile < 384) { const int j = tile - 256; if (MIX_MASK & 2) rglru_tile(P, layer, j >> 3, j & 7, lds); }
        else { const int j = tile - 384; if (MIX_MASK & 4) attn_tile(P, layer, j >> 6, (j >> 1) & 31, j & 1, lds); }
#ifdef TS_SUB
        if (obid() == 0 && otid() == 0) { unsigned long long* pr = (unsigned long long*)(P.ws + WS_CTL + 40960); const int cat = tile < 256 ? 9 : (tile < 384 ? 10 : 11); pr[cat] += __builtin_amdgcn_s_memrealtime() - tq0; }
#endif
    }
}

__device__ void phase_ssdnorm(const Params& P) {
    const int lane = otid() & 63, wid = otid() >> 6;
    const bf16_t* proj = (const bf16_t*)(P.ws + WS_PROJ);
    const float* SSQ = (const float*)(P.ws + WS_SSQ);
    const int g = lane >> 5;
    constexpr int NR = 8;
    for (int t0 = (obid() * 8 + wid) * NR; t0 < T_TOK; t0 += gridDim.x * 8 * NR) {
        u32x4 in[NR][2]; f32x4 s0[NR], s1[NR];
#pragma unroll
        for (int k = 0; k < NR; ++k) {
            const bf16_t* src = proj + (size_t)(t0 + k) * PROJ_LD + C_Z + lane * 16;
            in[k][0] = *(const u32x4*)src; in[k][1] = *(const u32x4*)(src + 8);
            s0[k] = *(const f32x4*)(SSQ + (size_t)(t0 + k) * 16 + g * 8); s1[k] = *(const f32x4*)(SSQ + (size_t)(t0 + k) * 16 + g * 8 + 4);
        }
#pragma unroll
        for (int k = 0; k < NR; ++k) {
            const float sc = rsqrtf(((s0[k][0] + s0[k][1]) + (s0[k][2] + s0[k][3]) + (s1[k][0] + s1[k][1]) + (s1[k][2] + s1[k][3])) * (1.f / 512.f) + LN_EPS);
            u32x4 o;
#pragma unroll
            for (int i = 0; i < 2; ++i) {
                float v[8];
#pragma unroll
                for (int c = 0; c < 4; ++c) { v[2 * c] = bflo(in[k][i][c]); v[2 * c + 1] = bfhi(in[k][i][c]); }
                const u32x2 w = cvt8_fp8(v, sc);
                if (i) { o.z = w.x; o.w = w.y; } else { o.x = w.x; o.y = w.y; }
            }
            *(u32x4*)(P.ws + WS_MIX8 + (size_t)(t0 + k) * MIXW + 512 + lane * 16) = o;
        }
    }
}

__device__ void phase_ssdnorm_bf16(const Params& P) {
    bf16_t* proj = (bf16_t*)(P.ws + WS_PROJ);
    const float* SSQ = (const float*)(P.ws + WS_SSQ);
    for (size_t i = (size_t)obid() * NTHREADS + otid(); i < (size_t)T_TOK * 128; i += (size_t)gridDim.x * NTHREADS) {
        const size_t t = i >> 7; const int c8 = (int)(i & 127) * 8, g = c8 >> 9;
        const f32x4 s0 = *(const f32x4*)(SSQ + t * 16 + g * 8), s1 = *(const f32x4*)(SSQ + t * 16 + g * 8 + 4);
        const float ss = s0[0] + s0[1] + s0[2] + s0[3] + s1[0] + s1[1] + s1[2] + s1[3];
        const float sc = rsqrtf(ss * (1.f / 512.f) + LN_EPS);
        u32x4* p = (u32x4*)(proj + t * PROJ_LD + C_Z + c8);
        const u32x4 w = *p;
        u32x4 o; o.x = cvt_pk_bf16(bflo(w.x) * sc, bfhi(w.x) * sc); o.y = cvt_pk_bf16(bflo(w.y) * sc, bfhi(w.y) * sc);
        o.z = cvt_pk_bf16(bflo(w.z) * sc, bfhi(w.z) * sc); o.w = cvt_pk_bf16(bflo(w.w) * sc, bfhi(w.w) * sc);
        *p = o;
    }
}

__device__ __forceinline__ unsigned mono_(float f) { const int i = (int)__float_as_uint(f); return (unsigned)(i ^ ((i >> 31) | (int)0x80000000)); }
__device__ __forceinline__ float unmono_(unsigned u) { const int i = (int)u; return __uint_as_float((unsigned)(i ^ (~(i >> 31) | (int)0x80000000))); }

__device__ void phase_peer_topk(const Params& P, int layer, LAS unsigned char* lds) {
    const int tid = otid(), lane = tid & 63, wid = tid >> 6, fr = lane & 15, fq = lane >> 4;
    const bf16_t* QP = (const bf16_t*)(P.ws + WS_QP);
    const bf16_t* keys = (const bf16_t*)(P.ws + WS_KEYS) + (size_t)layer * 2 * 128 * 64;
    unsigned short* IDX = (unsigned short*)(P.ws + WS_IDX);
    float* GATE = (float*)(P.ws + WS_GATE);
    LAS float* sSc = (LAS float*)lds;
    LAS unsigned* sTop = (LAS unsigned*)lds;
#define CE_D(a, b) do { const unsigned hi_ = umax_(a, b), lo_ = umin_(a, b); a = hi_; b = lo_; } while (0)
#define CE_A(a, b) do { const unsigned hi_ = umax_(a, b), lo_ = umin_(a, b); a = lo_; b = hi_; } while (0)
    bf16x8 kb[2][2][4][2];
#pragma unroll
    for (int ps = 0; ps < 2; ++ps)
#pragma unroll
        for (int i = 0; i < 2; ++i)
#pragma unroll
            for (int nt = 0; nt < 4; ++nt)
#pragma unroll
                for (int ks = 0; ks < 2; ++ks) kb[ps][i][nt][ks] = *(const bf16x8*)(keys + (size_t)(i * 128 + ps * 64 + nt * 16 + fr) * 64 + ks * 32 + fq * 8);
    for (int tile = obid(); tile < T_TOK / 32; tile += gridDim.x) {
        const int tok0 = tile * 32;
        unsigned top[16];
#pragma unroll
        for (int k = 0; k < 16; ++k) top[k] = 0u;
        bf16x8 qa[2][2][2];
        {
            LAS unsigned char* patch = lds + wid * (64 * 68 * 4);
            u32x4 ql[2][4];
#pragma unroll
            for (int i = 0; i < 2; ++i)
#pragma unroll
                for (int lt = 0; lt < 4; ++lt) ql[i][lt] = *(const u32x4*)(QP + (size_t)(tok0 + lt * 8 + (lane >> 3)) * DM + wid * 128 + i * 64 + (lane & 7) * 8);
#pragma unroll
            for (int i = 0; i < 2; ++i)
#pragma unroll
                for (int lt = 0; lt < 4; ++lt) *(LAS u32x4*)(patch + (i * 32 + lt * 8 + (lane >> 3)) * 144 + (lane & 7) * 16) = ql[i][lt];
#pragma unroll
            for (int i = 0; i < 2; ++i)
#pragma unroll
                for (int mt = 0; mt < 2; ++mt)
#pragma unroll
                    for (int ks = 0; ks < 2; ++ks) qa[i][mt][ks] = *(const LAS bf16x8*)(patch + (i * 32 + mt * 16 + fr) * 144 + ks * 64 + fq * 16);
        }
#pragma unroll
        for (int ps = 0; ps < 2; ++ps) {
            __builtin_amdgcn_s_setprio(1);
#pragma unroll
            for (int i = 0; i < 2; ++i)
#pragma unroll
                for (int mt = 0; mt < 2; ++mt)
#pragma unroll
                    for (int nt = 0; nt < 4; ++nt) {
                        f32x4 acc = {0.f, 0.f, 0.f, 0.f};
#pragma unroll
                        for (int ks = 0; ks < 2; ++ks) acc = MFMA16(kb[ps][i][nt][ks], qa[i][mt][ks], acc);
                        *(LAS f32x4*)(sSc + ((wid * 2 + i) * 32 + mt * 16 + fr) * 68 + nt * 16 + fq * 4) = acc;
                    }
            __builtin_amdgcn_s_setprio(0);
            __syncthreads();
#pragma unroll 1
            for (int gq = 0; gq < 4; ++gq) {
                unsigned g_[16];
#pragma unroll
                for (int e4 = 0; e4 < 4; ++e4) { const f32x4 sv4 = *(const LAS f32x4*)(sSc + tid * 68 + gq * 16 + e4 * 4);
#pragma unroll
                    for (int e1 = 0; e1 < 4; ++e1) { const int e = e4 * 4 + e1; g_[e] = (mono_(sv4[e1]) & ~0x7Fu) | (unsigned)(127 - (ps * 64 + gq * 16 + e)); } }
                CE_D(g_[0], g_[13]); CE_D(g_[1], g_[12]); CE_D(g_[2], g_[15]); CE_D(g_[3], g_[14]); CE_D(g_[4], g_[8]); CE_D(g_[5], g_[6]); CE_D(g_[7], g_[11]); CE_D(g_[9], g_[10]); CE_D(g_[0], g_[5]); CE_D(g_[1], g_[7]); CE_D(g_[2], g_[9]); CE_D(g_[3], g_[4]); CE_D(g_[6], g_[13]); CE_D(g_[8], g_[14]); CE_D(g_[10], g_[15]); CE_D(g_[11], g_[12]); CE_D(g_[0], g_[1]); CE_D(g_[2], g_[3]); CE_D(g_[4], g_[5]); CE_D(g_[6], g_[8]); CE_D(g_[7], g_[9]); CE_D(g_[10], g_[11]); CE_D(g_[12], g_[13]); CE_D(g_[14], g_[15]); CE_D(g_[0], g_[2]); CE_D(g_[1], g_[3]); CE_D(g_[4], g_[10]); CE_D(g_[5], g_[11]); CE_D(g_[6], g_[7]); CE_D(g_[8], g_[9]); CE_D(g_[12], g_[14]); CE_D(g_[13], g_[15]); CE_D(g_[1], g_[2]); CE_D(g_[3], g_[12]); CE_D(g_[4], g_[6]); CE_D(g_[5], g_[7]); CE_D(g_[8], g_[10]); CE_D(g_[9], g_[11]); CE_D(g_[13], g_[14]); CE_D(g_[1], g_[4]); CE_D(g_[2], g_[6]); CE_D(g_[5], g_[8]); CE_D(g_[7], g_[10]); CE_D(g_[9], g_[13]); CE_D(g_[11], g_[14]); CE_D(g_[2], g_[4]); CE_D(g_[3], g_[6]); CE_D(g_[9], g_[12]); CE_D(g_[11], g_[13]); CE_D(g_[3], g_[5]); CE_D(g_[6], g_[8]); CE_D(g_[7], g_[9]); CE_D(g_[10], g_[12]); CE_D(g_[3], g_[4]); CE_D(g_[5], g_[6]); CE_D(g_[7], g_[8]); CE_D(g_[9], g_[10]); CE_D(g_[11], g_[12]); CE_D(g_[6], g_[7]); CE_D(g_[8], g_[9]);
                if (ps == 0 && gq == 0) {
#pragma unroll
                    for (int e = 0; e < 16; ++e) top[e] = g_[e];
                } else {
#pragma unroll
                    for (int e = 0; e < 16; ++e) top[e] = umax_(top[e], g_[15 - e]);
                    CE_D(top[0], top[8]); CE_D(top[1], top[9]); CE_D(top[2], top[10]); CE_D(top[3], top[11]); CE_D(top[4], top[12]); CE_D(top[5], top[13]); CE_D(top[6], top[14]); CE_D(top[7], top[15]); CE_D(top[0], top[4]); CE_D(top[1], top[5]); CE_D(top[2], top[6]); CE_D(top[3], top[7]); CE_D(top[8], top[12]); CE_D(top[9], top[13]); CE_D(top[10], top[14]); CE_D(top[11], top[15]); CE_D(top[0], top[2]); CE_D(top[1], top[3]); CE_D(top[4], top[6]); CE_D(top[5], top[7]); CE_D(top[8], top[10]); CE_D(top[9], top[11]); CE_D(top[12], top[14]); CE_D(top[13], top[15]); CE_D(top[0], top[1]); CE_D(top[2], top[3]); CE_D(top[4], top[5]); CE_D(top[6], top[7]); CE_D(top[8], top[9]); CE_D(top[10], top[11]); CE_D(top[12], top[13]); CE_D(top[14], top[15]);
                }
            }
            __syncthreads();
        }
#pragma unroll
        for (int q = 0; q < 4; ++q) *(LAS u32x4*)(sTop + tid * 16 + q * 4) = (u32x4){top[q * 4], top[q * 4 + 1], top[q * 4 + 2], top[q * 4 + 3]};
        __syncthreads();
        if (tid < 256) {
            const int token = tid & 31, h = tid >> 5;
            const int row1 = (h * 2) * 32 + token, row2 = (h * 2 + 1) * 32 + token;
            float s1[16], s2[16];
#pragma unroll
            for (int q = 0; q < 4; ++q) {
                const u32x4 a = *(const LAS u32x4*)(sTop + row1 * 16 + q * 4), bq = *(const LAS u32x4*)(sTop + row2 * 16 + q * 4);
#pragma unroll
                for (int e = 0; e < 4; ++e) { s1[q * 4 + e] = unmono_(a[e] & ~0x7Fu); s2[q * 4 + e] = unmono_(bq[e] & ~0x7Fu); }
            }
#define TK_KEY(a, b) ((mono_(s1[a] + s2[b]) & ~0xFFu) | (unsigned)(255 - ((a) * 16 + (b))))
            unsigned M_[16], N_[16], best[16];
#pragma unroll
            for (int k = 0; k < 16; ++k) M_[k] = TK_KEY(0, k);
#pragma unroll
            for (int i = 1; i < 16; ++i) M_[i] = umax_(M_[i], TK_KEY(16 - i, 0));
            CE_D(M_[0], M_[8]); CE_D(M_[1], M_[9]); CE_D(M_[2], M_[10]); CE_D(M_[3], M_[11]); CE_D(M_[4], M_[12]); CE_D(M_[5], M_[13]); CE_D(M_[6], M_[14]); CE_D(M_[7], M_[15]); CE_D(M_[0], M_[4]); CE_D(M_[1], M_[5]); CE_D(M_[2], M_[6]); CE_D(M_[3], M_[7]); CE_D(M_[8], M_[12]); CE_D(M_[9], M_[13]); CE_D(M_[10], M_[14]); CE_D(M_[11], M_[15]); CE_D(M_[0], M_[2]); CE_D(M_[1], M_[3]); CE_D(M_[4], M_[6]); CE_D(M_[5], M_[7]); CE_D(M_[8], M_[10]); CE_D(M_[9], M_[11]); CE_D(M_[12], M_[14]); CE_D(M_[13], M_[15]); CE_D(M_[0], M_[1]); CE_D(M_[2], M_[3]); CE_D(M_[4], M_[5]); CE_D(M_[6], M_[7]); CE_D(M_[8], M_[9]); CE_D(M_[10], M_[11]); CE_D(M_[12], M_[13]); CE_D(M_[14], M_[15]);
            N_[0] = TK_KEY(1, 1);
            N_[1] = TK_KEY(1, 2);
            N_[2] = TK_KEY(1, 3);
            N_[3] = TK_KEY(1, 4);
            N_[4] = TK_KEY(1, 5);
            N_[5] = TK_KEY(1, 6);
            N_[6] = TK_KEY(1, 7);
            N_[7] = TK_KEY(2, 1);
            N_[8] = TK_KEY(2, 2);
            N_[9] = TK_KEY(2, 3);
            N_[10] = TK_KEY(2, 4);
            N_[11] = TK_KEY(3, 1);
            N_[12] = TK_KEY(3, 2);
            N_[13] = TK_KEY(3, 3);
            N_[14] = TK_KEY(4, 1);
            N_[15] = TK_KEY(4, 2);
            CE_D(N_[0], N_[13]); CE_D(N_[1], N_[12]); CE_D(N_[2], N_[15]); CE_D(N_[3], N_[14]); CE_D(N_[4], N_[8]); CE_D(N_[5], N_[6]); CE_D(N_[7], N_[11]); CE_D(N_[9], N_[10]); CE_D(N_[0], N_[5]); CE_D(N_[1], N_[7]); CE_D(N_[2], N_[9]); CE_D(N_[3], N_[4]); CE_D(N_[6], N_[13]); CE_D(N_[8], N_[14]); CE_D(N_[10], N_[15]); CE_D(N_[11], N_[12]); CE_D(N_[0], N_[1]); CE_D(N_[2], N_[3]); CE_D(N_[4], N_[5]); CE_D(N_[6], N_[8]); CE_D(N_[7], N_[9]); CE_D(N_[10], N_[11]); CE_D(N_[12], N_[13]); CE_D(N_[14], N_[15]); CE_D(N_[0], N_[2]); CE_D(N_[1], N_[3]); CE_D(N_[4], N_[10]); CE_D(N_[5], N_[11]); CE_D(N_[6], N_[7]); CE_D(N_[8], N_[9]); CE_D(N_[12], N_[14]); CE_D(N_[13], N_[15]); CE_D(N_[1], N_[2]); CE_D(N_[3], N_[12]); CE_D(N_[4], N_[6]); CE_D(N_[5], N_[7]); CE_D(N_[8], N_[10]); CE_D(N_[9], N_[11]); CE_D(N_[13], N_[14]); CE_D(N_[1], N_[4]); CE_D(N_[2], N_[6]); CE_D(N_[5], N_[8]); CE_D(N_[7], N_[10]); CE_D(N_[9], N_[13]); CE_D(N_[11], N_[14]); CE_D(N_[2], N_[4]); CE_D(N_[3], N_[6]); CE_D(N_[9], N_[12]); CE_D(N_[11], N_[13]); CE_D(N_[3], N_[5]); CE_D(N_[6], N_[8]); CE_D(N_[7], N_[9]); CE_D(N_[10], N_[12]); CE_D(N_[3], N_[4]); CE_D(N_[5], N_[6]); CE_D(N_[7], N_[8]); CE_D(N_[9], N_[10]); CE_D(N_[11], N_[12]); CE_D(N_[6], N_[7]); CE_D(N_[8], N_[9]);
            { unsigned x = TK_KEY(5, 1);
#pragma unroll
              for (int q = 0; q < 16; ++q) { const unsigned hi = umax_(N_[q], x); x = umin_(N_[q], x); N_[q] = hi; } }
            { unsigned x = TK_KEY(6, 1);
#pragma unroll
              for (int q = 0; q < 16; ++q) { const unsigned hi = umax_(N_[q], x); x = umin_(N_[q], x); N_[q] = hi; } }
            { unsigned x = TK_KEY(7, 1);
#pragma unroll
              for (int q = 0; q < 16; ++q) { const unsigned hi = umax_(N_[q], x); x = umin_(N_[q], x); N_[q] = hi; } }
#pragma unroll
            for (int k = 0; k < 16; ++k) best[k] = umax_(M_[k], N_[15 - k]);
#undef TK_KEY
            unsigned kmax = best[0];
#pragma unroll
            for (int k = 1; k < 16; ++k) kmax = umax_(kmax, best[k]);
            float val[16], gsum = 0.f;
            const float vmax = unmono_(kmax & ~0xFFu);
#pragma unroll
            for (int k = 0; k < 16; ++k) { val[k] = __expf(unmono_(best[k] & ~0xFFu) - vmax); gsum += val[k]; }
            const float ginv = __builtin_amdgcn_rcpf(gsum);
            const size_t ob = (size_t)(tok0 + token) * 128 + h * 16;
#pragma unroll
            for (int k = 0; k < 16; ++k) {
                const int code = 255 - (int)(best[k] & 0xFFu), a = code >> 4, bb = code & 15;
                const int i1 = 127 - (int)(sTop[row1 * 16 + a] & 0x7Fu), i2 = 127 - (int)(sTop[row2 * 16 + bb] & 0x7Fu);
                IDX[ob + k] = (unsigned short)(i1 * 128 + i2);
                GATE[ob + k] = val[k] * ginv;
            }
        }
        __syncthreads();
    }
}

#define FP4_PAIR(word, b) __builtin_amdgcn_cvt_scalef32_pk_f32_fp4((word), 1.0f, (b))
typedef _Float16 h16x2 __attribute__((ext_vector_type(2)));
#define FP4_H2(word, b) __builtin_amdgcn_cvt_scalef32_pk_f16_fp4((word), 1.0f, (b))
template <int CTLW>
__device__ __forceinline__ int peer_pull(const Params& P, int layer, int slice, int lane) {
    int tq = 0;
    if (lane == 0) tq = (int)atomicAdd((unsigned*)(P.ws + WS_CTL) + CTLW + 64 * (layer * 8 + slice), 4u);
    return __builtin_amdgcn_readfirstlane(tq);
}
template <int QW> __device__ void phase_peer_e1(const Params& P, int layer) {
    const int lane = otid() & 63, es = lane >> 3, ck = lane & 7;
    const bf16_t* hb = (const bf16_t*)(P.ws + WS_HB);
    const unsigned char* U4 = P.ws + WS_U8 + (size_t)layer * 16384 * 512;
    const unsigned short* IDX = (const unsigned short*)(P.ws + WS_IDX);
    unsigned* PD = (unsigned*)(P.ws + WS_PD);
    const int myx = (int)(xb_xcc_id() & 3u);
#define E1_IDX(dst, u) do { const unsigned short* ip_ = IDX + (size_t)(tq + (u)) * 128 + es * 8; const u32x4 a_ = *(const u32x4*)ip_, b_ = *(const u32x4*)(ip_ + 64); \
        _Pragma("unroll") for (int i_ = 0; i_ < 4; ++i_) { dst[2 * i_] = (int)(a_[i_] & 0xffffu); dst[2 * i_ + 1] = (int)(a_[i_] >> 16); dst[8 + 2 * i_] = (int)(b_[i_] & 0xffffu); dst[9 + 2 * i_] = (int)(b_[i_] >> 16); } } while (0)
#define E1_ROWS(dst, ix) do { _Pragma("unroll") for (int i_ = 0; i_ < 16; ++i_) dst[i_] = *(const u32x4*)(Us + (size_t)ix[i_] * 128); } while (0)
#define E1_X(dst, u) do { const bf16_t* xp_ = hb + (size_t)(tq + (u)) * DM + j * 256 + ck * 8; _Pragma("unroll") for (int i_ = 0; i_ < 4; ++i_) dst[i_] = *(const u32x4*)(xp_ + 64 * i_); } while (0)
#define E1_COMPUTE(wv, xr, u) do { h16x2 X_[16]; _Pragma("unroll") for (int a_ = 0; a_ < 4; ++a_) _Pragma("unroll") for (int i_ = 0; i_ < 4; ++i_) X_[4 * a_ + i_] = (h16x2){(_Float16)bflo(xr[a_][i_]), (_Float16)bfhi(xr[a_][i_])}; \
        float k0_ = 0.f, k1_ = 0.f; \
        _Pragma("unroll") for (int i_ = 0; i_ < 16; ++i_) { \
            float d0_ = 0.f, d1_ = 0.f; \
            _Pragma("unroll") for (int q_ = 0; q_ < 4; ++q_) { d0_ = __builtin_amdgcn_fdot2(FP4_H2(wv[i_][q_], 0), X_[4 * q_], d0_, false); d1_ = __builtin_amdgcn_fdot2(FP4_H2(wv[i_][q_], 1), X_[4 * q_ + 1], d1_, false); \
                d0_ = __builtin_amdgcn_fdot2(FP4_H2(wv[i_][q_], 2), X_[4 * q_ + 2], d0_, false); d1_ = __builtin_amdgcn_fdot2(FP4_H2(wv[i_][q_], 3), X_[4 * q_ + 3], d1_, false); } \
            float d_ = d0_ + d1_; \
            d_ += dpp_<0xB1>(d_); d_ += dpp_<0x4E>(d_); d_ += dpp_<0x141>(d_); \
            if (i_ < 8) k0_ = (ck == i_) ? d_ : k0_; else k1_ = (ck == i_ - 8) ? d_ : k1_; } \
        PD[((size_t)(tq + (u)) * 4 + j) * 64 + lane] = cvt_pk_bf16(k0_, k1_); } while (0)
    for (int k = 0; k < 4; ++k) {
        const int j = (myx + k) & 3;
        const unsigned char* Us = U4 + (size_t)j * (16384 * 128) + ck * 16;
        unsigned* qh = (unsigned*)(P.ws + WS_CTL) + QW + 64 * (layer * 8 + j);
        int tq = 0;
        if (lane == 0) tq = (int)atomicAdd(qh, 16u);
        tq = __builtin_amdgcn_readfirstlane(tq);
        int ix[16];
        if (tq < T_TOK) E1_IDX(ix, 0);
        while (tq < T_TOK) {
            int tqn_v = 0;
            if (lane == 0) tqn_v = (int)atomicAdd(qh, 16u);
            for (int u = 0; u < 15; ++u) {
                u32x4 wA[16], xA[4];
                E1_X(xA, u);
                E1_ROWS(wA, ix);
                E1_IDX(ix, u + 1);
                E1_COMPUTE(wA, xA, u);
            }
            {
                u32x4 wA[16], xA[4];
                E1_X(xA, 15);
                E1_ROWS(wA, ix);
                const int tqn = __builtin_amdgcn_readfirstlane(tqn_v);
                if (tqn < T_TOK) { const int tq_save = tq; tq = tqn; E1_IDX(ix, 0); tq = tq_save; }
                E1_COMPUTE(wA, xA, 15);
                tq = tqn;
            }
        }
    }
#undef E1_IDX
#undef E1_ROWS
#undef E1_X
#undef E1_COMPUTE
}
typedef int e3v8_t __attribute__((ext_vector_type(8)));
template <int QW> __device__ void phase_peer_e1m(const Params& P, int layer, LAS unsigned char* lds) {
    const int tid = otid(), lane = tid & 63, wid = tid >> 6, es = lane >> 3, ck = lane & 7, m = lane & 15, kg = lane >> 4;
    const bf16_t* hb = (const bf16_t*)(P.ws + WS_HB);
    const unsigned char* U4 = P.ws + WS_U8 + (size_t)layer * 16384 * 512;
    const unsigned short* IDX = (const unsigned short*)(P.ws + WS_IDX);
    unsigned* PD = (unsigned*)(P.ws + WS_PD);
    const int myx = (int)(xb_xcc_id() & 3u);
    LAS unsigned char* img = lds + wid * 16384;
    LAS unsigned char* sB = lds + 131072 + wid * 1024;
    LAS unsigned* sPD = (LAS unsigned*)(sB + 512);
    __syncthreads();
    const int xcol = ((lane & 7) >> 1) * 64 + (lane >> 3) * 8 + (lane & 1) * 4;
    int wofs[2];
#pragma unroll
    for (int par = 0; par < 2; ++par) wofs[par] = es * 128 + ((ck ^ (par * 4 + (es >> 1))) * 16);
    const int aofs0 = m * 128 + ((kg ^ (m >> 1)) * 16), aofs1 = m * 128 + (((4 + kg) ^ (m >> 1)) * 16);
#define E1_IDX(dst, tok) do { const unsigned short* ip_ = IDX + (size_t)(tok) * 128 + es * 8; const u32x4 a_ = *(const u32x4*)ip_, b_ = *(const u32x4*)(ip_ + 64); \
        _Pragma("unroll") for (int i_ = 0; i_ < 4; ++i_) { dst[2 * i_] = (int)(a_[i_] & 0xffffu); dst[2 * i_ + 1] = (int)(a_[i_] >> 16); dst[8 + 2 * i_] = (int)(b_[i_] & 0xffffu); dst[9 + 2 * i_] = (int)(b_[i_] >> 16); } } while (0)
#define E1_ROWS(dst, ix) do { _Pragma("unroll") for (int i_ = 0; i_ < 16; ++i_) dst[i_] = *(const u32x4*)(Us + (unsigned)((ix[i_] << 7) + ck * 16)); } while (0)
#define E1_X(dst, tok) do { dst = *(const u32x2*)(hb + (size_t)(tok) * DM + j * 256 + xcol); } while (0)
#define E1_STAGE(wv, hv) do { \
        { const float h0 = bflo(hv.x), h1 = bfhi(hv.x), h2 = bflo(hv.y), h3 = bfhi(hv.y); \
          int hi = __builtin_amdgcn_cvt_pk_fp8_f32(h0, h1, 0, false); hi = __builtin_amdgcn_cvt_pk_fp8_f32(h2, h3, hi, true); \
          const f32x2 b01 = __builtin_amdgcn_cvt_pk_f32_fp8(hi, false), b23 = __builtin_amdgcn_cvt_pk_f32_fp8(hi, true); \
          int lo = __builtin_amdgcn_cvt_pk_fp8_f32(h0 - b01[0], h1 - b01[1], 0, false); lo = __builtin_amdgcn_cvt_pk_fp8_f32(h2 - b23[0], h3 - b23[1], lo, true); \
          *(LAS int*)(sB + lane * 4) = hi; *(LAS int*)(sB + 256 + lane * 4) = lo; } \
        _Pragma("unroll") for (int i_ = 0; i_ < 16; ++i_) *(LAS u32x4*)(img + i_ * 1024 + wofs[i_ & 1]) = wv[i_]; \
        asm volatile("" ::: "memory"); __builtin_amdgcn_wave_barrier(); } while (0)
#define E1_PROCESS(tok) do { \
        e3v8_t B0, B1; \
        { const LAS unsigned char* bp = sB + (lane & 1) * 256 + kg * 16; \
          const u32x4 a0 = *(const LAS u32x4*)bp, a1 = *(const LAS u32x4*)(bp + 64), a2 = *(const LAS u32x4*)(bp + 128), a3 = *(const LAS u32x4*)(bp + 192); \
          B0 = (e3v8_t){(int)a0.x, (int)a0.y, (int)a0.z, (int)a0.w, (int)a1.x, (int)a1.y, (int)a1.z, (int)a1.w}; \
          B1 = (e3v8_t){(int)a2.x, (int)a2.y, (int)a2.z, (int)a2.w, (int)a3.x, (int)a3.y, (int)a3.z, (int)a3.w}; } \
        u32x4 af0[8], af1[8]; \
        _Pragma("unroll") for (int g = 0; g < 8; ++g) { af0[g] = *(const LAS u32x4*)(img + g * 2048 + aofs0); af1[g] = *(const LAS u32x4*)(img + g * 2048 + aofs1); } \
        f32x4 d[8]; \
        __builtin_amdgcn_s_setprio(1); \
        _Pragma("unroll") for (int g = 0; g < 8; ++g) { \
            const e3v8_t A0 = {(int)af0[g].x, (int)af0[g].y, (int)af0[g].z, (int)af0[g].w, 0, 0, 0, 0}, A1 = {(int)af1[g].x, (int)af1[g].y, (int)af1[g].z, (int)af1[g].w, 0, 0, 0, 0}; \
            f32x4 acc = {0.f, 0.f, 0.f, 0.f}; \
            acc = __builtin_amdgcn_mfma_scale_f32_16x16x128_f8f6f4(A0, B0, acc, 4, 0, 0, 0x7F7F7F7F, 0, 0x7F7F7F7F); \
            acc = __builtin_amdgcn_mfma_scale_f32_16x16x128_f8f6f4(A1, B1, acc, 4, 0, 0, 0x7F7F7F7F, 0, 0x7F7F7F7F); \
            d[g] = acc; } \
        __builtin_amdgcn_s_setprio(0); \
        _Pragma("unroll") for (int g = 0; g < 8; ++g) _Pragma("unroll") for (int c = 0; c < 4; ++c) d[g][c] += dpp_<0xB1>(d[g][c]); \
        if (m == 0) {   \
            _Pragma("unroll") for (int g = 0; g < 4; ++g) _Pragma("unroll") for (int c = 0; c < 4; ++c) sPD[(4 * (kg & 1) + c) * 8 + 2 * g + (kg >> 1)] = cvt_pk_bf16(d[g][c], d[g + 4][c]); } \
        asm volatile("" ::: "memory"); __builtin_amdgcn_wave_barrier(); \
        PD[((size_t)(tok) * 4 + j) * 64 + lane] = sPD[lane]; \
        asm volatile("" ::: "memory"); __builtin_amdgcn_wave_barrier(); } while (0)
    for (int k = 0; k < 4; ++k) {
        const int j = (myx + k) & 3;
        const unsigned char* Us = U4 + (size_t)j * (16384 * 128);
        unsigned* qh = (unsigned*)(P.ws + WS_CTL) + QW + 64 * (layer * 8 + j);
        int tq = 0;
        if (lane == 0) tq = (int)atomicAdd(qh, 4u);
        tq = __builtin_amdgcn_readfirstlane(tq);
        int ix[16]; u32x4 wA[16]; u32x2 xA;
        if (tq < T_TOK) { E1_IDX(ix, tq); E1_X(xA, tq); E1_ROWS(wA, ix); E1_IDX(ix, tq + 1); }
        while (tq < T_TOK) {
            int tqn_v = 0, tqn = 0;
            if (lane == 0) tqn_v = (int)atomicAdd(qh, 4u);
            for (int u = 0; u < 4; ++u) {
                if (u == 2) tqn = __builtin_amdgcn_readfirstlane(tqn_v);
                const int t1 = (u + 1 < 4) ? tq + u + 1 : tqn, t2 = (u + 2 < 4) ? tq + u + 2 : tqn + (u + 2 - 4);
                E1_STAGE(wA, xA);
                if (t1 < T_TOK) { E1_X(xA, t1); E1_ROWS(wA, ix); }
                if (t2 < T_TOK) E1_IDX(ix, t2);
                E1_PROCESS(tq + u);
            }
            tq = tqn;
        }
    }
#undef E1_IDX
#undef E1_ROWS
#undef E1_X
#undef E1_STAGE
#undef E1_PROCESS
    __syncthreads();
}
template <bool DUMMY2> __device__ void phase_peer_e2(const Params& P, int layer) {
    const unsigned* PD = (const unsigned*)(P.ws + WS_PD);
    const unsigned short* IDX = (const unsigned short*)(P.ws + WS_IDX);
    float* GATE = (float*)(P.ws + WS_GATE);
    unsigned* IW = DUMMY2 ? (unsigned*)(P.ws + WS_STAT + (size_t)T_TOK * 64) : (unsigned*)GATE;
    const unsigned* SUV = (const unsigned*)(P.ws + WS_SU) + layer * 16384;
    for (size_t i4 = (size_t)obid() * NTHREADS + otid(); i4 < (size_t)T_TOK * 16; i4 += (size_t)gridDim.x * NTHREADS) {
        const size_t t = i4 >> 4; const int e = (int)(i4 & 15) * 4;
        f32x4 dlo = {0.f, 0.f, 0.f, 0.f}, dhi = {0.f, 0.f, 0.f, 0.f};
#pragma unroll
        for (int j = 0; j < 4; ++j) { const u32x4 w = *(const u32x4*)(PD + (t * 4 + j) * 64 + e);
#pragma unroll
            for (int c = 0; c < 4; ++c) { dlo[c] += bflo(w[c]); dhi[c] += bfhi(w[c]); } }
        const u32x2 ia = *(const u32x2*)(IDX + t * 128 + e), ib = *(const u32x2*)(IDX + t * 128 + 64 + e);
        const int il[4] = {(int)(ia.x & 0xffffu), (int)(ia.x >> 16), (int)(ia.y & 0xffffu), (int)(ia.y >> 16)};
        const int ih[4] = {(int)(ib.x & 0xffffu), (int)(ib.x >> 16), (int)(ib.y & 0xffffu), (int)(ib.y >> 16)};
        const f32x4 gl = *(const f32x4*)(GATE + t * 128 + e), gh = *(const f32x4*)(GATE + t * 128 + 64 + e);
        u32x4 ol, oh;
#pragma unroll
        for (int c = 0; c < 4; ++c) {
            const unsigned sl = SUV[il[c]], sh = SUV[ih[c]];
            const float wl = gl[c] * bfhi(sl) * gelu_cdf_(bflo(sl) * dlo[c]), wh = gh[c] * bfhi(sh) * gelu_cdf_(bflo(sh) * dhi[c]);
            ol[c] = (cvt_pk_bf16(0.f, wl) & 0xffff0000u) | (unsigned)il[c];
            oh[c] = (cvt_pk_bf16(0.f, wh) & 0xffff0000u) | (unsigned)ih[c];
        }
        *(u32x4*)(IW + t * 128 + e) = ol; *(u32x4*)(IW + t * 128 + 64 + e) = oh;
    }
}
template <int QW, bool DUMMY> __device__ void phase_peer_e3(const Params& P, int layer) {
    const int lane = otid() & 63, es = lane >> 3, ck = lane & 7;
    const unsigned char* V4 = P.ws + WS_V8 + (size_t)layer * 16384 * 512;
    const unsigned* IW = (const unsigned*)(P.ws + WS_GATE);
    float* STAT = (float*)(P.ws + WS_STAT);
    const int myx = (int)(xb_xcc_id() & 3u);
    const bool b5 = (lane & 32) != 0, b4 = (lane & 16) != 0, b3 = (lane & 8) != 0;
    for (int k = 0; k < 4; ++k) {
        const int j = (myx + k) & 3;
        const unsigned char* Vs = V4 + (size_t)j * (16384 * 128) + ck * 16;
        int tq = peer_pull<QW>(P, layer, j, lane);
        unsigned iwn[16];
        if (tq < T_TOK) {
#pragma unroll
            for (int q = 0; q < 4; ++q) { const u32x4 w4 = *(const u32x4*)(IW + (size_t)tq * 128 + q * 32 + es * 4); iwn[4 * q] = w4.x; iwn[4 * q + 1] = w4.y; iwn[4 * q + 2] = w4.z; iwn[4 * q + 3] = w4.w; }
        }
        while (tq < T_TOK) {
            int tqn_v = 0, tqn = 0;
            if (lane == 0) tqn_v = (int)atomicAdd((unsigned*)(P.ws + WS_CTL) + QW + 64 * (layer * 8 + j), 16u);
            for (int t = tq; t < tq + 16; ++t) {
                int idx[16]; float wg[16];
#pragma unroll
                for (int i = 0; i < 16; ++i) { idx[i] = (int)(iwn[i] & 0xffffu); wg[i] = __uint_as_float(iwn[i] & 0xffff0000u); }
                u32x4 w[16];
#pragma unroll
                for (int i = 0; i < 16; ++i) w[i] = *(const u32x4*)(Vs + (size_t)idx[i] * 128);
                int tnext = t + 1;
                if (t + 1 == tq + 16) { tqn = __builtin_amdgcn_readfirstlane(tqn_v); tnext = tqn; }
                if (tnext < T_TOK) {
#pragma unroll
                    for (int q = 0; q < 4; ++q) { const u32x4 w4 = *(const u32x4*)(IW + (size_t)tnext * 128 + q * 32 + es * 4); iwn[4 * q] = w4.x; iwn[4 * q + 1] = w4.y; iwn[4 * q + 2] = w4.z; iwn[4 * q + 3] = w4.w; }
                }
                const int colo = j * 256 + (es >> 1) * 64 + ck * 8 + (es & 1) * 4;
                bf16_t* hrow = (bf16_t*)(P.ws + WS_HB) + (size_t)t * DM + colo;
                bf16_t* yrow = DUMMY ? (bf16_t*)(P.ws + WS_PD) + (size_t)t * DM + colo : hrow;
                float* strow = DUMMY ? (float*)(P.ws + WS_PD) + (size_t)T_TOK * DM : STAT;
                const u32x2 hv = *(const u32x2*)hrow;
                h16x2 acc[16];
#pragma unroll
                for (int c = 0; c < 16; ++c) acc[c] = (h16x2){(_Float16)0.f, (_Float16)0.f};
#pragma unroll
                for (int i = 0; i < 16; ++i) {
                    const _Float16 wh = (_Float16)wg[i]; const h16x2 w2 = {wh, wh};
#pragma unroll
                    for (int q = 0; q < 4; ++q) { acc[4 * q] += FP4_H2(w[i][q], 0) * w2; acc[4 * q + 1] += FP4_H2(w[i][q], 1) * w2; acc[4 * q + 2] += FP4_H2(w[i][q], 2) * w2; acc[4 * q + 3] += FP4_H2(w[i][q], 3) * w2; }
                }
                h16x2 r16[8];
#pragma unroll
                for (int c = 0; c < 8; ++c) {
                    const h16x2 keep = b5 ? acc[8 + c] : acc[c], send = b5 ? acc[c] : acc[8 + c];
                    r16[c] = keep + __builtin_bit_cast(h16x2, __shfl_xor(__builtin_bit_cast(int, send), 32));
                }
                h16x2 r8[4];
#pragma unroll
                for (int c = 0; c < 4; ++c) {
                    const h16x2 keep = b4 ? r16[4 + c] : r16[c], send = b4 ? r16[c] : r16[4 + c];
                    r8[c] = keep + __builtin_bit_cast(h16x2, __shfl_xor(__builtin_bit_cast(int, send), 16));
                }
                f32x2 r4[2];
#pragma unroll
                for (int c = 0; c < 2; ++c) {
                    const h16x2 keep = b3 ? r8[2 + c] : r8[c], send = b3 ? r8[c] : r8[2 + c];
                    const h16x2 got = __builtin_bit_cast(h16x2, __builtin_amdgcn_mov_dpp(__builtin_bit_cast(int, send), 0x128, 0xf, 0xf, true));
                    r4[c] = (f32x2){(float)keep[0] + (float)got[0], (float)keep[1] + (float)got[1]};
                }
                float y[4];
                y[0] = DN_ALPHA * bflo(hv.x) + r4[0][0]; y[1] = DN_ALPHA * bfhi(hv.x) + r4[0][1]; y[2] = DN_ALPHA * bflo(hv.y) + r4[1][0]; y[3] = DN_ALPHA * bfhi(hv.y) + r4[1][1];
                u32x2 ov; ov.x = cvt_pk_bf16(y[0], y[1]); ov.y = cvt_pk_bf16(y[2], y[3]);
                *(u32x2*)yrow = ov;
                float s1 = (y[0] + y[1]) + (y[2] + y[3]), s2 = (y[0] * y[0] + y[1] * y[1]) + (y[2] * y[2] + y[3] * y[3]);
                s1 = wave_sum_dpp(s1); s2 = wave_sum_dpp(s2);
                if (lane == 0) { strow[((size_t)t * 4 + j) * 2] = s1; strow[((size_t)t * 4 + j) * 2 + 1] = s2; }
            }
            tq = tqn;
        }
    }
}
typedef int e3v2_t __attribute__((ext_vector_type(2)));
template <int QW> __device__ void phase_peer_e3m(const Params& P, int layer, LAS unsigned char* lds) {
    const int tid = otid(), lane = tid & 63, wid = tid >> 6, es = lane >> 3, ck = lane & 7, m = lane & 15, kg = lane >> 4;
    const unsigned char* V4 = P.ws + WS_V8 + (size_t)layer * 16384 * 512;
    const unsigned* IW = (const unsigned*)(P.ws + WS_GATE);
    float* STAT = (float*)(P.ws + WS_STAT);
    const int myx = (int)(xb_xcc_id() & 3u);
    LAS unsigned char* img = lds + wid * 16384;
    LAS unsigned char* sW = lds + 131072 + wid * 1280;
    LAS float* sO = (LAS float*)(sW + 256);
    __syncthreads();
    int wofs[2];
#pragma unroll
    for (int par = 0; par < 2; ++par) wofs[par] = es * 128 + ((ck ^ (par * 4 + (es >> 1))) * 16);
    const int rw0 = (4 * (lane >> 4) + (lane & 1) * 2) * 8 + ((lane >> 1) & 7);
    const int rbase = (kg * 32 + m) * 128;
    for (int k = 0; k < 4; ++k) {
        const int j = (myx + k) & 3;
        const unsigned char* Vs = V4 + (size_t)j * (16384 * 128);
        int tq = peer_pull<QW>(P, layer, j, lane);
        unsigned iwn[16]; u32x4 w[16]; u32x2 hv, ww;
#define E3_IW(tok) do { _Pragma("unroll") for (int q = 0; q < 4; ++q) { const u32x4 w4 = *(const u32x4*)(IW + (size_t)(tok) * 128 + q * 32 + es * 4); iwn[4 * q] = w4.x; iwn[4 * q + 1] = w4.y; iwn[4 * q + 2] = w4.z; iwn[4 * q + 3] = w4.w; } } while (0)
#define E3_ISSUE(tok) do { _Pragma("unroll") for (int i = 0; i < 16; ++i) w[i] = *(const u32x4*)(Vs + (unsigned)(((iwn[i] & 0xffffu) << 7) + ck * 16)); \
        ww = *(const u32x2*)(IW + (size_t)(tok) * 128 + 2 * lane); \
        hv = *(const u32x2*)((const bf16_t*)(P.ws + WS_HB) + (size_t)(tok) * DM + j * 256 + lane * 4); } while (0)
        if (tq < T_TOK) { E3_IW(tq); E3_ISSUE(tq); E3_IW(tq + 1); }
        while (tq < T_TOK) {
            int tqn_v = 0, tqn = 0;
            if (lane == 0) tqn_v = (int)atomicAdd((unsigned*)(P.ws + WS_CTL) + QW + 64 * (layer * 8 + j), 4u);
            for (int u = 0; u < 4; ++u) {
                if (u == 2) tqn = __builtin_amdgcn_readfirstlane(tqn_v);
                const int t = tq + u, t1 = (u + 1 < 4) ? tq + u + 1 : tqn, t2 = (u + 2 < 4) ? tq + u + 2 : tqn + (u + 2 - 4);
                const float w0 = __uint_as_float(ww.x & 0xffff0000u), w1 = __uint_as_float(ww.y & 0xffff0000u);
                float amax = row_max16(fmaxf(fabsf(w0), fabsf(w1)));
                amax = fmaxf(fmaxf(rdlane(amax, 0), rdlane(amax, 16)), fmaxf(rdlane(amax, 32), rdlane(amax, 48)));
                const float wsc = amax > 0.f ? 224.f * __builtin_amdgcn_rcpf(amax) : 0.f, winv = amax * (1.f / 224.f);
                {
                    const float a0 = w0 * wsc, a1 = w1 * wsc;
                    const int h8 = __builtin_amdgcn_cvt_pk_fp8_f32(a0, a1, 0, false);
                    const f32x2 hb_ = __builtin_amdgcn_cvt_pk_f32_fp8(h8, false);
                    const int l8 = __builtin_amdgcn_cvt_pk_fp8_f32(a0 - hb_[0], a1 - hb_[1], 0, false);
                    sW[rw0] = (unsigned char)(h8 & 0xff); sW[rw0 + 8] = (unsigned char)((h8 >> 8) & 0xff);
                    sW[128 + rw0] = (unsigned char)(l8 & 0xff); sW[128 + rw0 + 8] = (unsigned char)((l8 >> 8) & 0xff);
                }
#pragma unroll
                for (int i = 0; i < 16; ++i) *(LAS u32x4*)(img + i * 1024 + wofs[i & 1]) = w[i];
                const u32x2 hvc = hv;
                asm volatile("" ::: "memory"); __builtin_amdgcn_wave_barrier();
                if (t1 < T_TOK) E3_ISSUE(t1);
                if (t2 < T_TOK) E3_IW(t2);
                e3v8_t A = {0, 0, 0, 0, 0, 0, 0, 0};
                if (m < 2) {
                    const u32x4 a0 = *(const LAS u32x4*)(sW + m * 128 + kg * 16), a1 = *(const LAS u32x4*)(sW + m * 128 + 64 + kg * 16);
                    A = (e3v8_t){(int)a0.x, (int)a0.y, (int)a0.z, (int)a0.w, (int)a1.x, (int)a1.y, (int)a1.z, (int)a1.w};
                }
                e3v2_t bf0[16], bf1[16];
#pragma unroll
                for (int cb = 0; cb < 16; ++cb) {
                    const int co = (((cb >> 1) ^ (m >> 1)) * 16) + (cb & 1) * 8;
                    bf0[cb] = __builtin_amdgcn_ds_read_tr4_b64_v2i32((LAS e3v2_t*)(img + rbase + co));
                    bf1[cb] = __builtin_amdgcn_ds_read_tr4_b64_v2i32((LAS e3v2_t*)(img + rbase + 16 * 128 + co));
                }
                f32x4 accs[16];
                __builtin_amdgcn_s_setprio(1);
#pragma unroll
                for (int cb = 0; cb < 16; ++cb) {
                    const e3v8_t B = {bf0[cb].x, bf0[cb].y, bf1[cb].x, bf1[cb].y, 0, 0, 0, 0};
                    const f32x4 z = {0.f, 0.f, 0.f, 0.f};
                    accs[cb] = __builtin_amdgcn_mfma_scale_f32_16x16x128_f8f6f4(A, B, z, 0, 4, 0, 0x7F7F7F7F, 0, 0x7F7F7F7F);
                }
                __builtin_amdgcn_s_setprio(0);
                if (kg == 0) {
#pragma unroll
                    for (int cb = 0; cb < 16; ++cb) sO[cb * 16 + m] = (accs[cb][0] + accs[cb][1]) * winv;
                }
                asm volatile("" ::: "memory"); __builtin_amdgcn_wave_barrier();
                const f32x4 r4 = *(const LAS f32x4*)(sO + lane * 4);
                asm volatile("" ::: "memory"); __builtin_amdgcn_wave_barrier();
                float y[4];
                y[0] = DN_ALPHA * bflo(hvc.x) + r4[0]; y[1] = DN_ALPHA * bfhi(hvc.x) + r4[1]; y[2] = DN_ALPHA * bflo(hvc.y) + r4[2]; y[3] = DN_ALPHA * bfhi(hvc.y) + r4[3];
                u32x2 ov; ov.x = cvt_pk_bf16(y[0], y[1]); ov.y = cvt_pk_bf16(y[2], y[3]);
                *(u32x2*)((bf16_t*)(P.ws + WS_HB) + (size_t)t * DM + j * 256 + lane * 4) = ov;
                float s1 = (y[0] + y[1]) + (y[2] + y[3]), s2 = (y[0] * y[0] + y[1] * y[1]) + (y[2] * y[2] + y[3] * y[3]);
                s1 = wave_sum_dpp(s1); s2 = wave_sum_dpp(s2);
                if (lane == 0) { STAT[((size_t)t * 4 + j) * 2] = s1; STAT[((size_t)t * 4 + j) * 2 + 1] = s2; }
            }
            tq = tqn;
        }
#undef E3_IW
#undef E3_ISSUE
    }
    __syncthreads();
}
__device__ void phase_peer_e4(const Params& P, int layer) {
    ln_rows_bf16<true>((bf16_t*)(P.ws + WS_HB), P.ws + WS_MIX8, (layer == DEPTH - 1) ? P.out : nullptr, (const float*)(P.ws + WS_STAT), P.ln2_g + layer * DM, P.ln2_b + layer * DM);
}

constexpr int N_SUB = 12;
constexpr int N_PHASES = 1 + N_SUB * DEPTH;
__global__ void __launch_bounds__(NTHREADS, 2) fwd_megakernel(Params P) {
    extern __shared__ __attribute__((aligned(16))) unsigned char lds_raw[];
    LAS unsigned char* lds = (LAS unsigned char*)lds_raw;
    cg::grid_group grid = cg::this_grid();
    unsigned char* ws = P.ws;
    volatile LAS unsigned* xb_st = (volatile LAS unsigned*)(lds + LDS_BYTES - 32);
    if (otid() < 2) xb_st[otid()] = 0u;
    __syncthreads();
    const XcdBarrier xbar = xcd_barrier_post((unsigned*)(ws + WS_CTL + 4096), xb_st);
#ifdef DEBUG_COPY
    const int ph_end = P.ph_hi + 1;
#else
    const int ph_end = P.ph_hi;
#endif
    for (int ph = P.ph_lo; ph < ph_end; ++ph) {
        if (ph > P.ph_lo) {
            if (ph == 1) {
                asm volatile("s_waitcnt vmcnt(0)" ::: "memory");
                __syncthreads();
                grid.sync();
                if (otid() < 64) { __builtin_amdgcn_fence(__ATOMIC_ACQUIRE, "agent"); asm volatile("s_waitcnt vmcnt(0)" ::: "memory"); }
                __syncthreads();
            } else {
                xcd_barrier(xbar);
            }
        }
#ifdef TS_SUB
        if (obid() == 0 && otid() == 0) ((unsigned long long*)(ws + WS_CTL + 32768))[ph] = __builtin_amdgcn_s_memrealtime();
#endif
        if (ph == 0) { phase_prep(P, lds); continue; }
#ifdef DEBUG_COPY
        if (ph == P.ph_hi) {
            const bf16_t* proj = (const bf16_t*)(ws + WS_PROJ);
            const float* DTp = (const float*)(ws + WS_DT);
            for (size_t i = (size_t)obid() * NTHREADS + otid(); i < (size_t)T_TOK * 1024; i += (size_t)gridDim.x * NTHREADS) {
                const size_t t = i >> 10; const int c = (int)(i & 1023);
                float v;
                if (c < 256) v = bf2f(proj[t * PROJ_LD + C_K + c]);
                else if (c < 1008) v = bf2f(proj[t * PROJ_LD + C_XBC + (c - 256) * 2]);
                else v = DTp[t * 16 + (c - 1008)];
                P.out[i] = v;
            }
            continue;
        }
#endif
        const int layer = (ph - 1) / N_SUB, sub = (ph - 1) % N_SUB;
        if (sub == 0 || sub == 4 || sub == 6) {
            pg8::Gemm g; pg8::Epi E; int N; bool f8;
            if (sub == 0) {
                f8 = FP8_IN;
                if (FP8_IN) g = pg8::Gemm{(const bf16_t*)(ws + WS_MIX8), (const bf16_t*)(ws + WS_WIN8 + (size_t)layer * N_IN * 1024), T_TOK, N_IN, 512, 512, 1 << 30, 0};
                else g = pg8::Gemm{(const bf16_t*)(ws + WS_HB), (const bf16_t*)(ws + WS_WIN) + (size_t)layer * N_IN * 1024, T_TOK, N_IN, 1024, 1024, 1 << 30, 0};
                E.mode = 0; E.eb = pg8::EpiBf16{(bf16_t*)(ws + WS_PROJ), PROJ_LD, 0, (size_t)0, FP8_IN ? 1.f / 32.f : 1.f}; E.er = pg8::EpiResBf16{nullptr, 0, 0.f, 1.f}; N = N_IN;
            } else if (sub == 4) {
                f8 = FP8_OUT;
                if (FP8_OUT) g = pg8::Gemm{(const bf16_t*)(ws + WS_MIX8), (const bf16_t*)(ws + WS_WOUT8 + (size_t)layer * 1024 * MIXW), T_TOK, 1024, 1024, 1024, 1 << 30, 0};
                else g = pg8::Gemm{(const bf16_t*)(ws + WS_PROJ) + C_GATE, (const bf16_t*)(ws + WS_WOUT) + (size_t)layer * 1024 * MIXW, T_TOK, 1024, MIXW, PROJ_LD, 24, (C_Q - (C_GATE + 1536)) * 2};
                E.mode = 1; E.eb = pg8::EpiBf16{nullptr, 0, 0, (size_t)0, 1.f}; E.er = pg8::EpiResBf16{(bf16_t*)(ws + WS_HB), DM, DN_ALPHA, FP8_OUT ? 1.f / 64.f : 1.f}; N = 1024;
            } else {
                f8 = FP8_Q;
                if (FP8_Q) g = pg8::Gemm{(const bf16_t*)(ws + WS_MIX8), (const bf16_t*)(ws + WS_WQ8 + (size_t)layer * 1024 * 1024), T_TOK, 1024, 512, 512, 1 << 30, 0};
                else g = pg8::Gemm{(const bf16_t*)(ws + WS_HB), (const bf16_t*)(ws + WS_WQ) + (size_t)layer * 1024 * 1024, T_TOK, 1024, 1024, 1024, 1 << 30, 0};
                E.mode = 0; E.eb = pg8::EpiBf16{(bf16_t*)(ws + WS_QP), DM, 0, (size_t)0, FP8_Q ? 1.f / 32.f : 1.f}; E.er = pg8::EpiResBf16{nullptr, 0, 0.f, 1.f}; N = 1024;
            }
            pg8::StaticOrder S; S.init(T_TOK, N, (int)gridDim.x, (int)obid());
            __syncthreads();
            if (f8) pg8::gemm_phase<true>(lds, g, S, E); else pg8::gemm_phase<false>(lds, g, S, E);
#ifdef EXP_GEMM_TWICE
            if (sub == EXP_GEMM_TWICE) { xcd_barrier(xbar); __syncthreads(); if (f8) pg8::gemm_phase<true>(lds, g, S, E); else pg8::gemm_phase<false>(lds, g, S, E); }
#endif
            if (sub == 0) phase_dt(P, layer, lds);
        } else if (sub == 1) {
            phase_conv(P, layer, lds);
        } else if (sub == 2) {
#ifndef SKIP_MIX
            phase_mixers(P, layer, lds);
#endif
        } else if (sub == 3) {
            if (FP8_OUT) phase_ssdnorm(P); else phase_ssdnorm_bf16(P);
        } else if (sub == 5) {
            ln_rows_bf16<false>((bf16_t*)(ws + WS_HB), ws + WS_MIX8, nullptr, nullptr, P.ln1_g + layer * DM, P.ln1_b + layer * DM);
        } else if (sub == 7) {
            phase_peer_topk(P, layer, lds);
#ifdef EXP_TOPK_TWICE
            xcd_barrier(xbar);
            phase_peer_topk(P, layer, lds);
#endif
        } else if (sub == 8) {
            phase_peer_e1m<CTLW_QE1>(P, layer, lds);
#ifdef EXP_E1_TWICE
            xcd_barrier(xbar);
            phase_peer_e1<7168>(P, layer);
#endif
        } else if (sub == 9) {
#ifdef EXP_E2_DUMMY
            phase_peer_e2<true>(P, layer);
            xcd_barrier(xbar);
#endif
            phase_peer_e2<false>(P, layer);
        } else if (sub == 10) {
#ifdef EXP_E3_DUMMY
            phase_peer_e3<7168, true>(P, layer);
            xcd_barrier(xbar);
#endif
            phase_peer_e3m<CTLW_QE3>(P, layer, lds);
        } else {
            phase_peer_e4(P, layer);
        }
    }
#ifdef TS_SUB
    if (obid() == 0 && otid() == 0) {
        unsigned long long* ts = (unsigned long long*)(ws + WS_CTL + 32768);
        const unsigned long long now = __builtin_amdgcn_s_memrealtime();
        ts[P.ph_hi] = now;
        unsigned long long d = 0;
        for (int ph = 0; ph < P.ph_hi; ++ph) {
            const bool sel = (TS_SUB == 20) ? (ph == 0) : (ph > 0 && ((ph - 1) % N_SUB) == TS_SUB);
            if (sel) d += ts[ph + 1] - ts[ph];
        }
        if (TS_SUB == 21) d = (ts[P.ph_hi] - ts[0]) / TS_AMP;
        if (TS_SUB >= 9 && TS_SUB < 20) d = ((unsigned long long*)(ws + WS_CTL + 40960))[TS_SUB];
        d *= TS_AMP;
        while (__builtin_amdgcn_s_memrealtime() - now < d) __builtin_amdgcn_s_sleep(32);
    }
#endif
}

extern "C" void kernel_launch(void* const* d_in, const int* in_sizes, int n_in, void* d_out, int out_size, void* d_ws, size_t ws_size, hipStream_t stream) {
    static int grid_blocks = 0;
    if (grid_blocks == 0) {
        if (n_in != 27 || out_size != T_TOK * DM || ws_size < WS_END) { fprintf(stderr, "kernel_launch: unexpected shapes (n_in %d out %d ws %zu need %zu)\n", n_in, out_size, ws_size, (size_t)WS_END); grid_blocks = -1; return; }
        int dev = 0, cus = 0, per_cu = 0;
        hipGetDevice(&dev);
        hipDeviceGetAttribute(&cus, hipDeviceAttributeMultiprocessorCount, dev);
        if (hipFuncSetAttribute((const void*)fwd_megakernel, hipFuncAttributeMaxDynamicSharedMemorySize, LDS_BYTES) != hipSuccess) { fprintf(stderr, "kernel_launch: hipFuncSetAttribute failed\n"); grid_blocks = -1; return; }
        hipOccupancyMaxActiveBlocksPerMultiprocessor(&per_cu, (const void*)fwd_megakernel, NTHREADS, LDS_BYTES);
        if (per_cu < 1) { fprintf(stderr, "kernel_launch: occupancy query says %d blocks per CU\n", per_cu); grid_blocks = -1; return; }
        grid_blocks = cus;
    }
    if (grid_blocks < 0) return;
    hipMemsetAsync((char*)d_ws + WS_CTL, 0, 65536, stream);
    Params p{};
    const float** pp = (const float**)&p;
    for (int i = 0; i < 27; ++i) pp[i] = (const float*)d_in[i];
    p.out = (float*)d_out; p.ws = (unsigned char*)d_ws; p.ph_lo = 0; p.ph_hi = PH_HI;
    void* args[] = {&p};
    hipError_t e = hipLaunchCooperativeKernel((const void*)fwd_megakernel, dim3(grid_blocks), dim3(NTHREADS), args, LDS_BYTES, stream);
    if (e != hipSuccess) fprintf(stderr, "cooperative launch failed: %s (grid %d)\n", hipGetErrorString(e), grid_blocks);
}
```
